# Optimizing an MI355X kernel written in HIP

```python
import math
import jax, jax.numpy as jnp
from jax import lax
import numpy as np

D_MODEL = 1024
BATCH = 16
SEQ = 2048
DEPTH = 4

N_MIXERS = 4
D_FF = 2816
NORM_EPS = 1e-6
GN_EPS = 1e-5
ROPE_THETA = 10000.0
Q_BLOCK = 128
NEG_INF = -1e30

A_HEADS = 16
A_HEAD_DIM = 64
A_PATTERNS = ((128, 1), (512, 4), (2048, 16))
A_GROUPS = len(A_PATTERNS)
A_WIDTH = A_GROUPS * A_HEADS * A_HEAD_DIM

B_HEADS = 16
B_NOPE = 64
B_ROPE = 32
B_QK = B_NOPE + B_ROPE
B_VDIM = 64
B_Q_RANK = 384
B_KV_RANK = 256

C_HEADS = 8
C_KDIM = 128
C_VDIM = 256
C_CHUNK = 128

D_WIDTH = 1024
D_BLOCKS = 4
D_BLOCK = D_WIDTH // D_BLOCKS
D_CONV = 4
LRU_C = 8.0

kernel_name = 'hybrid_interleaved_dilated_mla_retention_rglru'

f32 = jnp.float32


def rmsnorm(x, g):
    xf = x.astype(f32)
    y = xf * lax.rsqrt(jnp.mean(xf * xf, axis=-1, keepdims=True) + NORM_EPS)
    return (y * g.astype(f32)).astype(x.dtype)


def rope(x, pos):
    d = x.shape[-1]
    half = d // 2
    inv = ROPE_THETA ** (-jnp.arange(half, dtype=f32) * 2.0 / d)
    ang = pos.astype(f32)[:, :, None, None] * inv
    cos, sin = jnp.cos(ang), jnp.sin(ang)
    xf = x.astype(f32)
    x1, x2 = xf[..., :half], xf[..., half:]
    return jnp.concatenate([x1 * cos - x2 * sin, x2 * cos + x1 * sin], axis=-1).astype(x.dtype)


def swiglu(x, w_in, w_out):
    gate, up = jnp.split(x @ w_in, 2, axis=-1)
    return (jax.nn.silu(gate) * up) @ w_out


def _dilated_band(q, k, v, window, dilation):
    B, S, H, dh = q.shape
    W = window // dilation
    L = S // dilation
    nb = -(-L // W)
    Lp = nb * W

    def by_residue(t):
        t = t.reshape(B, L, dilation, H, t.shape[-1]).transpose(0, 2, 3, 1, 4)
        return jnp.pad(t, ((0, 0), (0, 0), (0, 0), (0, Lp - L), (0, 0)))

    def band(t):
        t = jnp.pad(t, ((0, 0), (0, 0), (0, 0), (W, 0), (0, 0)))
        t = t.reshape(B, dilation, H, nb + 1, W, t.shape[-1])
        return jnp.concatenate([t[:, :, :, :-1], t[:, :, :, 1:]], axis=4)

    qb = by_residue(q).reshape(B, dilation, H, nb, W, dh)
    kb = band(by_residue(k))
    vb = band(by_residue(v))
    s = jnp.einsum('brhnqd,brhnkd->brhnqk', qb, kb).astype(f32) * (dh ** -0.5)
    u = jnp.arange(W)[None, :, None]
    c = jnp.arange(2 * W)[None, None, :]
    blk = jnp.arange(nb)[:, None, None]
    valid = (c >= u) & (c <= u + W) & (blk * W - W + c >= 0)
    s = jnp.where(valid, s, NEG_INF)
    lse = jax.nn.logsumexp(s, axis=-1)
    p = jnp.exp(s - lse[..., None]).astype(v.dtype)
    o = jnp.einsum('brhnqk,brhnkd->brhnqd', p, vb)
    o = o.reshape(B, dilation, H, Lp, dh)[:, :, :, :L].transpose(0, 3, 1, 2, 4).reshape(B, S, H, dh)
    lse = lse.reshape(B, dilation, H, Lp)[..., :L].transpose(0, 3, 1, 2).reshape(B, S, H)
    return o, lse


def dilated_window_attention(x, pos, w_in, q_gain, k_gain, w_out):
    B, S, _ = x.shape
    q, k, v = jnp.split(x @ w_in, 3, axis=-1)
    shp = (B, S, A_GROUPS * A_HEADS, A_HEAD_DIM)
    q = rope(rmsnorm(q.reshape(shp), q_gain), pos)
    k = rope(rmsnorm(k.reshape(shp), k_gain), pos)
    v = v.reshape(shp)
    outs, lses = [], []
    for g, (window, dilation) in enumerate(A_PATTERNS):
        sl = slice(g * A_HEADS, (g + 1) * A_HEADS)
        o, lse = _dilated_band(q[:, :, sl], k[:, :, sl], v[:, :, sl], window, dilation)
        outs.append(o)
        lses.append(lse)
    wts = jax.nn.softmax(jnp.stack(lses, axis=0), axis=0).astype(x.dtype)
    o = jnp.einsum('gbsh,gbshd->bshd', wts, jnp.stack(outs, axis=0))
    return o.reshape(B, S, A_HEADS * A_HEAD_DIM) @ w_out


def _causal_attention(q, k, v):
    B, S, H, dq = q.shape
    nb = S // Q_BLOCK
    scale = dq ** -0.5
    qb = q.reshape(B, nb, Q_BLOCK, H, dq).transpose(1, 0, 2, 3, 4)
    kpos = jnp.arange(S)

    def block(args):
        qblk, b = args
        s = jnp.einsum('bqhd,bkhd->bhqk', qblk, k).astype(f32) * scale
        qpos = b * Q_BLOCK + jnp.arange(Q_BLOCK)
        s = jnp.where(kpos[None, :] <= qpos[:, None], s, NEG_INF)
        p = jax.nn.softmax(s, axis=-1).astype(v.dtype)
        return jnp.einsum('bhqk,bkhd->bqhd', p, v)

    o = lax.map(block, (qb, jnp.arange(nb)))
    return o.transpose(1, 0, 2, 3, 4).reshape(B, S, H, v.shape[-1])


def latent_attention(x, pos, w_in, q_a_gain, w_q_up, kv_a_gain, w_kv_up, q_gain, k_gain, w_out):
    B, S, _ = x.shape
    h = x @ w_in
    c_q = h[..., :B_Q_RANK]
    c_kv = h[..., B_Q_RANK:B_Q_RANK + B_KV_RANK]
    k_rope = h[..., B_Q_RANK + B_KV_RANK:]
    q = (rmsnorm(c_q, q_a_gain) @ w_q_up).reshape(B, S, B_HEADS, B_QK)
    kv = (rmsnorm(c_kv, kv_a_gain) @ w_kv_up).reshape(B, S, B_HEADS, B_NOPE + B_VDIM)
    k_nope, v = kv[..., :B_NOPE], kv[..., B_NOPE:]
    k = jnp.concatenate([k_nope, jnp.broadcast_to(k_rope[:, :, None, :], (B, S, B_HEADS, B_ROPE))], axis=-1)
    q = rmsnorm(q, q_gain)
    k = rmsnorm(k, k_gain)
    q = jnp.concatenate([q[..., :B_NOPE], rope(q[..., B_NOPE:], pos)], axis=-1)
    k = jnp.concatenate([k[..., :B_NOPE], rope(k[..., B_NOPE:], pos)], axis=-1)
    o = _causal_attention(q, k, v)
    return o.reshape(B, S, B_HEADS * B_VDIM) @ w_out


def retention(x, pos, w_in, w_out):
    B, S, _ = x.shape
    h = x @ w_in
    qk_w = C_HEADS * C_KDIM
    v_w = C_HEADS * C_VDIM
    q = h[..., :qk_w].reshape(B, S, C_HEADS, C_KDIM)
    k = h[..., qk_w:2 * qk_w].reshape(B, S, C_HEADS, C_KDIM)
    v = h[..., 2 * qk_w:2 * qk_w + v_w].reshape(B, S, C_HEADS, C_VDIM)
    g = h[..., 2 * qk_w + v_w:]
    q = rope(q, pos).astype(f32)
    k = rope(k, pos).astype(f32) * (C_KDIM ** -0.5)
    v = v.astype(f32)
    log_g = jnp.log(1.0 - 2.0 ** (-5.0 - jnp.arange(C_HEADS, dtype=f32)))
    idx = jnp.arange(C_CHUNK, dtype=f32)
    diff = idx[:, None] - idx[None, :]
    causal = diff >= 0
    decay = jnp.where(causal[None], jnp.exp(jnp.where(causal, diff, 0.0)[None] * log_g[:, None, None]), 0.0)
    xi = jnp.exp((idx + 1.0)[None, :] * log_g[:, None])
    zeta = jnp.exp((C_CHUNK - 1.0 - idx)[None, :] * log_g[:, None])
    chunk_decay = jnp.exp(C_CHUNK * log_g)
    nc = S // C_CHUNK

    def to_chunks(t):
        return t.reshape(B, nc, C_CHUNK, C_HEADS, t.shape[-1]).transpose(1, 0, 3, 2, 4)

    def step(R, inp):
        qc, kc, vc = inp
        s = jnp.einsum('bhid,bhjd->bhij', qc, kc) * decay[None]
        inner = jnp.einsum('bhij,bhjv->bhiv', s, vc)
        cross = jnp.einsum('bhid,bhdv->bhiv', qc, R) * xi[None, :, :, None]
        R = chunk_decay[None, :, None, None] * R + jnp.einsum('bhjd,bhjv->bhdv', kc * zeta[None, :, :, None], vc)
        return R, inner + cross

    R0 = jnp.zeros((B, C_HEADS, C_KDIM, C_VDIM), f32)
    _, y = lax.scan(step, R0, (to_chunks(q), to_chunks(k), to_chunks(v)))
    y = y.transpose(1, 0, 3, 2, 4).reshape(B, S, C_HEADS, C_VDIM)
    mu = jnp.mean(y, axis=-1, keepdims=True)
    var = jnp.mean(jnp.square(y - mu), axis=-1, keepdims=True)
    y = ((y - mu) * lax.rsqrt(var + GN_EPS)).astype(x.dtype).reshape(B, S, v_w)
    return (jax.nn.silu(g) * y) @ w_out


def _linear_combine(c1, c2):
    a1, b1 = c1
    a2, b2 = c2
    return a1 * a2, a2 * b1 + b2


def recurrent_block(x, w_in, conv_w, conv_b, w_rg, b_rg, w_ig, b_ig, lru_param, w_out):
    B, S, _ = x.shape
    gate, u = jnp.split(x @ w_in, 2, axis=-1)
    u = lax.conv_general_dilated(u, conv_w[:, None, :], window_strides=(1,),
                                 padding=[(D_CONV - 1, 0)],
                                 dimension_numbers=('NWC', 'WIO', 'NWC'),
                                 feature_group_count=D_WIDTH) + conv_b
    ub = u.reshape(B, S, D_BLOCKS, D_BLOCK)
    r = jax.nn.sigmoid(jnp.einsum('bsnc,ncd->bsnd', ub, w_rg).reshape(B, S, D_WIDTH) + b_rg)
    ig = jax.nn.sigmoid(jnp.einsum('bsnc,ncd->bsnd', ub, w_ig).reshape(B, S, D_WIDTH) + b_ig)
    log_a = -LRU_C * r.astype(f32) * jax.nn.softplus(-lru_param.astype(f32))
    a = jnp.exp(log_a)
    b = jnp.sqrt(jnp.maximum(-jnp.expm1(2.0 * log_a), 0.0)) * (ig * u).astype(f32)
    _, hs = lax.associative_scan(_linear_combine, (a, b), axis=1)
    return (jax.nn.gelu(gate) * hs.astype(x.dtype)) @ w_out


def _layers_of(m):
    return len(range(m, DEPTH, N_MIXERS))


def setup_inputs(seed: int = 0) -> dict:
    key = jax.random.key(seed)
    kit = iter(jax.random.split(key, 40))

    def w(shape, fan_in):
        return jax.random.normal(next(kit), shape, f32) * (fan_in ** -0.5)

    def gain(shape):
        return 1.0 + 0.05 * jax.random.normal(next(kit), shape, f32)

    def bias(shape):
        return 0.01 * jax.random.normal(next(kit), shape, f32)

    nA, nB, nC, nD = (_layers_of(m) for m in range(N_MIXERS))
    x = jax.random.normal(next(kit), (BATCH, SEQ, D_MODEL), f32)
    offsets = jax.random.randint(next(kit), (BATCH, 1), 0, 1024)
    positions = (offsets + jnp.arange(SEQ)[None, :]).astype(jnp.int32)
    u = jax.random.uniform(next(kit), (nD, D_WIDTH), f32, minval=0.9, maxval=0.999)
    a0 = u ** (1.0 / LRU_C)
    lru_param = jnp.log(a0) - jnp.log1p(-a0)
    return {
        'x': x,
        'positions': positions,
        'norm_gains': gain((DEPTH, 3, D_MODEL)),
        'ffn_w_in': w((DEPTH, 2, D_MODEL, 2 * D_FF), D_MODEL),
        'ffn_w_out': w((DEPTH, 2, D_FF, D_MODEL), D_FF),
        'a_w_in': w((nA, D_MODEL, 3 * A_WIDTH), D_MODEL),
        'a_q_gain': gain((nA, A_HEAD_DIM)),
        'a_k_gain': gain((nA, A_HEAD_DIM)),
        'a_w_out': w((nA, A_HEADS * A_HEAD_DIM, D_MODEL), A_HEADS * A_HEAD_DIM),
        'b_w_in': w((nB, D_MODEL, B_Q_RANK + B_KV_RANK + B_ROPE), D_MODEL),
        'b_q_a_gain': gain((nB, B_Q_RANK)),
        'b_w_q_up': w((nB, B_Q_RANK, B_HEADS * B_QK), B_Q_RANK),
        'b_kv_a_gain': gain((nB, B_KV_RANK)),
        'b_w_kv_up': w((nB, B_KV_RANK, B_HEADS * (B_NOPE + B_VDIM)), B_KV_RANK),
        'b_q_gain': gain((nB, B_QK)),
        'b_k_gain': gain((nB, B_QK)),
        'b_w_out': w((nB, B_HEADS * B_VDIM, D_MODEL), B_HEADS * B_VDIM),
        'c_w_in': w((nC, D_MODEL, 2 * C_HEADS * C_KDIM + 2 * C_HEADS * C_VDIM), D_MODEL),
        'c_w_out': w((nC, C_HEADS * C_VDIM, D_MODEL), C_HEADS * C_VDIM),
        'd_w_in': w((nD, D_MODEL, 2 * D_WIDTH), D_MODEL),
        'd_conv_w': w((nD, D_CONV, D_WIDTH), D_CONV),
        'd_conv_b': bias((nD, D_WIDTH)),
        'd_w_rg': w((nD, D_BLOCKS, D_BLOCK, D_BLOCK), D_BLOCK),
        'd_b_rg': bias((nD, D_WIDTH)),
        'd_w_ig': w((nD, D_BLOCKS, D_BLOCK, D_BLOCK), D_BLOCK),
        'd_b_ig': bias((nD, D_WIDTH)),
        'd_lru_param': lru_param,
        'd_w_out': w((nD, D_WIDTH, D_MODEL), D_WIDTH),
    }


def reference(x, positions, norm_gains, ffn_w_in, ffn_w_out,
              a_w_in, a_q_gain, a_k_gain, a_w_out,
              b_w_in, b_q_a_gain, b_w_q_up, b_kv_a_gain, b_w_kv_up, b_q_gain, b_k_gain, b_w_out,
              c_w_in, c_w_out,
              d_w_in, d_conv_w, d_conv_b, d_w_rg, d_b_rg, d_w_ig, d_b_ig, d_lru_param, d_w_out):
    for i in range(DEPTH):
        m, j = i % N_MIXERS, i // N_MIXERS
        x = x + 0.5 * swiglu(rmsnorm(x, norm_gains[i, 0]), ffn_w_in[i, 0], ffn_w_out[i, 0])
        h = rmsnorm(x, norm_gains[i, 1])
        if m == 0:
            y = dilated_window_attention(h, positions, a_w_in[j], a_q_gain[j], a_k_gain[j], a_w_out[j])
        elif m == 1:
            y = latent_attention(h, positions, b_w_in[j], b_q_a_gain[j], b_w_q_up[j], b_kv_a_gain[j],
                                 b_w_kv_up[j], b_q_gain[j], b_k_gain[j], b_w_out[j])
        elif m == 2:
            y = retention(h, positions, c_w_in[j], c_w_out[j])
        else:
            y = recurrent_block(h, d_w_in[j], d_conv_w[j], d_conv_b[j], d_w_rg[j], d_b_rg[j],
                                d_w_ig[j], d_b_ig[j], d_lru_param[j], d_w_out[j])
        x = x + y
        x = x + 0.5 * swiglu(rmsnorm(x, norm_gains[i, 2]), ffn_w_in[i, 1], ffn_w_out[i, 1])
    return x
```

```cpp
#include <hip/hip_runtime.h>
#include <cstdio>
#include <cstdint>
#include <cmath>

#define LAS __attribute__((address_space(3)))
#define GAS __attribute__((address_space(1)))
typedef unsigned short bf16_t;
typedef short bf16x8 __attribute__((ext_vector_type(8)));
typedef float f32x4 __attribute__((ext_vector_type(4)));
typedef float f32x16 __attribute__((ext_vector_type(16)));
typedef unsigned u32x4 __attribute__((ext_vector_type(4)));
typedef unsigned u32x2 __attribute__((ext_vector_type(2)));
typedef float f32x2_t __attribute__((ext_vector_type(2)));
typedef __bf16 bf16x2_t __attribute__((ext_vector_type(2)));

constexpr int DM = 1024, NB = 16, SEQ = 2048, MTOK = NB * SEQ, DFF = 2816;
constexpr float NORM_EPS = 1e-6f, GN_EPS = 1e-5f;
constexpr float LOG2E = 1.4426950408889634f;

__device__ __forceinline__ unsigned pk2(float lo, float hi) { f32x2_t v = {lo, hi}; bf16x2_t b = __builtin_convertvector(v, bf16x2_t); return __builtin_bit_cast(unsigned, b); }
__device__ __forceinline__ float bflo(unsigned w) { return __uint_as_float(w << 16); }
__device__ __forceinline__ float bfhi(unsigned w) { return __uint_as_float(w & 0xffff0000u); }
__device__ __forceinline__ float fast_exp2(float x) { return __builtin_amdgcn_exp2f(x); }
__device__ __forceinline__ float fast_rcp(float x) { return __builtin_amdgcn_rcpf(x); }
__device__ __forceinline__ float silu_f(float g) { return g * fast_rcp(1.f + fast_exp2(-g * LOG2E)); }
__device__ __forceinline__ float sigmoid_f(float g) { return fast_rcp(1.f + fast_exp2(-g * LOG2E)); }
__device__ __forceinline__ float gelu_tanh_f(float x) {
    const float z = 0.7978845608028654f * (x + 0.044715f * x * x * x);
    const float e = fast_exp2(2.f * LOG2E * z);
    return x * (1.f - fast_rcp(1.f + e));
}
__device__ __forceinline__ float wave_sum(float v) {
#pragma unroll
    for (int o = 1; o < 64; o <<= 1) v += __shfl_xor(v, o);
    return v;
}
__device__ __forceinline__ float wave_max(float v) {
#pragma unroll
    for (int o = 1; o < 64; o <<= 1) v = fmaxf(v, __shfl_xor(v, o));
    return v;
}
__device__ __forceinline__ int opaque_tid() { int t = threadIdx.x; asm volatile("" : "+v"(t)); return t; }
__device__ __forceinline__ int crow(int r, int hi) { return (r & 3) + 8 * (r >> 2) + 4 * hi; }

namespace pg8 {
constexpr int BM = 256, BK = 64, HALF = 128, HTB = HALF * BK * 2, STAGE_BYTES = 8 * HTB, NXCD = 8, WGM = 8;
__host__ __device__ __forceinline__ int lds_byte(int r, int c) { const int st = (r >> 4) * 2 + (c >> 5), rr = r & 15, cc = c & 31, ob = rr * 64 + cc * 2; return st * 1024 + (ob ^ (((ob >> 9) & 1) << 5)); }
__host__ __device__ __forceinline__ void stage_rc(int b, int& R, int& C) { const int st = b / 1024, sb = b % 1024, swz = sb ^ (((sb >> 9) & 1) << 5); R = (st >> 1) * 16 + swz / 64; C = (st & 1) * 32 + (swz % 64) / 2; }
__host__ __device__ __forceinline__ int perm32(int rho) { const int n = rho >> 4, i = rho & 15; return 8 * (i >> 2) + 4 * n + (i & 3); }
struct Unit { int pm, pn; };
struct StaticOrder {
    int nM, nN, nwg, G, c;
    __device__ void init(int nM_, int nN_, int G_, int c_) { nM = nM_; nN = nN_; nwg = nM * nN; G = G_; c = c_; }
    __device__ bool next(int i, Unit& u) const {
        const long L = (long)i * G + c; if (L >= nwg) return false;
        int wgid = (int)L; { const int q = nwg / NXCD, r = nwg % NXCD, xcd = wgid % NXCD, off = wgid / NXCD; wgid = (xcd < r ? xcd * (q + 1) : r * (q + 1) + (xcd - r) * q) + off; }
        const int nig = WGM * nN, gid = wgid / nig, fm = gid * WGM, gsz = (nM - fm) < WGM ? (nM - fm) : WGM;
        u.pm = fm + ((wgid % nig) % gsz); u.pn = (wgid % nig) / gsz; return true;
    }
};
struct Prob {
    const char* A; const char* B; int K, lda, ldb; long hsA, hsB, tsA, tsB; int mode, dsh;
    __device__ __forceinline__ const char* a_ptr(const Unit& u) const { const char* p = A + (long)u.pm * tsA; if (mode == 2) p += (long)(u.pn >> 1) * 512; return p; }
    __device__ __forceinline__ const char* b_ptr(const Unit& u) const {
        if (mode == 1) { const int b = u.pn >> 3, tt = u.pn & 7; int tok0;
            if (dsh == 0) tok0 = 256 * tt; else if (dsh == 2) tok0 = 4 * ((tt & 1) * 256) + (tt >> 1); else tok0 = 2 * tt;
            return B + ((long)b * SEQ + tok0) * (DM * 2); }
        return B + (long)u.pn * tsB; }
};
__device__ __forceinline__ Prob make_prob(const void* A, int lda, const void* B, int ldb, int K) {
    Prob p; p.A = (const char*)A; p.B = (const char*)B; p.K = K; p.lda = lda; p.ldb = ldb; p.hsA = (long)HALF * lda * 2; p.hsB = (long)HALF * ldb * 2; p.tsA = 2 * p.hsA; p.tsB = 2 * p.hsB; p.mode = 0; p.dsh = 0; return p;
}

template <class Epi, bool ALIGN_EPI, bool SP2>
__device__ __forceinline__ void gemm_phase(LAS unsigned char* lds, const Prob g, const StaticOrder& S, const Epi& E) {
    const int tid = opaque_tid(), wid = __builtin_amdgcn_readfirstlane(tid >> 6), lane = tid & 63, wr = wid >> 2, wc = wid & 3, fr = lane & 15, fq = lane >> 4;
    const int K = g.K, nt = K / BK;
    unsigned voffA[2], voffB[2];
#pragma unroll
    for (int i = 0; i < 2; ++i) { int R, C; stage_rc(tid * 16 + i * 8192, R, C); const int Rb = Epi::PERM ? ((R & ~31) + perm32(R & 31)) : R;
        voffA[i] = (unsigned)(R * g.lda + C) * 2u; voffB[i] = (unsigned)(Rb * g.ldb + C) * 2u; }
    const size_t kstep = (size_t)(BK * 2);
    const long hsA = g.hsA, hsB = g.hsB;
    const unsigned ldsw = (unsigned)wid * 1024u;
    const int aoff = lds_byte(wr * 64 + fr, fq * 8), boff = lds_byte(wc * 32 + fr, fq * 8);
#define PG8_SA(b, h) (((b) * 2 + (h)) * HTB)
#define PG8_SB(b, h) ((4 + (b) * 2 + (h)) * HTB)
#define PG8_STAGE(bufoff, gbase, voff) do { _Pragma("unroll") for (int _i = 0; _i < 2; ++_i) \
        __builtin_amdgcn_global_load_lds((const unsigned*)((const char*)(gbase) + (voff)[_i]), (LAS unsigned*)(lds + (bufoff) + ldsw + _i * 8192), 16, 0, 0); } while (0)
#define PG8_LDA(dst, b, h) do { _Pragma("unroll") for (int m = 0; m < 4; ++m) _Pragma("unroll") for (int k = 0; k < 2; ++k) dst[m][k] = *(const LAS bf16x8*)(lds + PG8_SA(b, h) + aoff + m * 2048 + k * 1024); } while (0)
#define PG8_LDB(dst, b, h) do { _Pragma("unroll") for (int n = 0; n < 2; ++n) _Pragma("unroll") for (int k = 0; k < 2; ++k) dst[n][k] = *(const LAS bf16x8*)(lds + PG8_SB(b, h) + boff + n * 2048 + k * 1024); } while (0)
#define PG8_MMA(ai, bj, At, Bt) do { __builtin_amdgcn_s_setprio(1); _Pragma("unroll") for (int m = 0; m < 4; ++m) _Pragma("unroll") for (int n = 0; n < 2; ++n) _Pragma("unroll") for (int k = 0; k < 2; ++k) \
        acc[ai][bj][m][n] = __builtin_amdgcn_mfma_f32_16x16x32_bf16(Bt[n][k], At[m][k], acc[ai][bj][m][n], 0, 0, 0); __builtin_amdgcn_s_setprio(0); } while (0)
#define PG8_WAIT_V(n) asm volatile("s_waitcnt vmcnt(" #n ")" ::: "memory")
#define PG8_WAIT_L(n) asm volatile("s_waitcnt lgkmcnt(" #n ")" ::: "memory")
#define PG8_BAR __builtin_amdgcn_s_barrier()
#define PG8_SCHED __builtin_amdgcn_sched_barrier(0)
    Unit cur, nxt; int ui = 0;
    if (!S.next(0, cur)) return;
    f32x4 acc[2][2][4][2];
#pragma unroll
    for (int a = 0; a < 2; ++a)
#pragma unroll
        for (int b = 0; b < 2; ++b)
#pragma unroll
            for (int m = 0; m < 4; ++m)
#pragma unroll
                for (int n = 0; n < 2; ++n) acc[a][b][m][n] = (f32x4){0.f, 0.f, 0.f, 0.f};
    bf16x8 At[4][2], B0[2][2], B1[2][2];
    const char* cA = g.a_ptr(cur); const char* cB = g.b_ptr(cur);
    if constexpr (SP2) {
        PG8_STAGE(PG8_SB(0, 0), cB, voffB); PG8_STAGE(PG8_SB(0, 1), cB + hsB, voffB); PG8_STAGE(PG8_SA(0, 0), cA, voffA); PG8_STAGE(PG8_SA(0, 1), cA + hsA, voffA);
        if (wr == 1) PG8_BAR;
        PG8_WAIT_V(2); PG8_BAR;
        PG8_STAGE(PG8_SB(1, 0), cB + kstep, voffB); PG8_STAGE(PG8_SA(1, 0), cA + kstep, voffA); PG8_STAGE(PG8_SB(1, 1), cB + hsB + kstep, voffB);
        PG8_WAIT_V(6); PG8_BAR;
    } else {
        PG8_STAGE(PG8_SB(0, 0), cB, voffB); PG8_STAGE(PG8_SA(0, 0), cA, voffA); PG8_STAGE(PG8_SB(0, 1), cB + hsB, voffB); PG8_STAGE(PG8_SA(0, 1), cA + hsA, voffA);
        if (wr == 1) PG8_BAR;
        PG8_WAIT_V(4); PG8_BAR;
        PG8_STAGE(PG8_SB(1, 0), cB + kstep, voffB); PG8_STAGE(PG8_SA(1, 0), cA + kstep, voffA); PG8_STAGE(PG8_SB(1, 1), cB + hsB + kstep, voffB);
        PG8_WAIT_V(6); PG8_BAR;
    }
    for (;;) {
        const bool has_next = S.next(ui + 1, nxt);
        const char* nA = has_next ? g.a_ptr(nxt) : cA; const char* nB = has_next ? g.b_ptr(nxt) : cB;
        for (int t = 0; t < nt; t += 2) {
            const bool last = (t == nt - 2);
            const char* a1 = cA + (size_t)(t + 1) * kstep;
            const char* a2 = last ? nA : cA + (size_t)(t + 2) * kstep; const char* b2 = last ? nB : cB + (size_t)(t + 2) * kstep;
            const char* a3 = a2 + kstep; const char* b3 = b2 + kstep;
            if constexpr (SP2) {
            PG8_LDB(B0, 0, 0); PG8_LDB(B1, 0, 1); PG8_SCHED; PG8_LDA(At, 0, 0); PG8_STAGE(PG8_SA(1, 1), a1 + hsA, voffA);
            PG8_WAIT_V(8); PG8_WAIT_L(0); PG8_BAR; PG8_MMA(0, 0, At, B0); PG8_MMA(0, 1, At, B1); PG8_BAR; PG8_SCHED;
            PG8_LDA(At, 0, 1); PG8_STAGE(PG8_SB(0, 0), b2, voffB); PG8_STAGE(PG8_SB(0, 1), b2 + hsB, voffB); PG8_STAGE(PG8_SA(0, 0), a2, voffA);
            PG8_WAIT_V(8); PG8_WAIT_L(0); PG8_BAR; PG8_MMA(1, 0, At, B0); PG8_MMA(1, 1, At, B1); PG8_BAR; PG8_SCHED;
            PG8_LDB(B0, 1, 0); PG8_LDB(B1, 1, 1); PG8_SCHED; PG8_LDA(At, 1, 0); PG8_STAGE(PG8_SA(0, 1), a2 + hsA, voffA);
            PG8_WAIT_V(8); PG8_WAIT_L(0); PG8_BAR; PG8_MMA(0, 0, At, B0); PG8_MMA(0, 1, At, B1); PG8_BAR; PG8_SCHED;
            PG8_LDA(At, 1, 1); PG8_STAGE(PG8_SB(1, 0), b3, voffB); PG8_STAGE(PG8_SB(1, 1), b3 + hsB, voffB); PG8_STAGE(PG8_SA(1, 0), a3, voffA);
            PG8_WAIT_V(8); PG8_WAIT_L(0); PG8_BAR; PG8_MMA(1, 0, At, B0); PG8_MMA(1, 1, At, B1); PG8_BAR; PG8_SCHED;
            } else {
            PG8_LDB(B0, 0, 0); PG8_SCHED; PG8_LDA(At, 0, 0); PG8_STAGE(PG8_SA(1, 1), a1 + hsA, voffA);
            PG8_WAIT_L(8); PG8_BAR; PG8_WAIT_L(0); PG8_MMA(0, 0, At, B0); PG8_BAR; PG8_SCHED;
            PG8_LDB(B1, 0, 1); PG8_STAGE(PG8_SB(0, 0), b2, voffB);
            PG8_BAR; PG8_WAIT_L(0); PG8_MMA(0, 1, At, B1); PG8_BAR;
            PG8_LDA(At, 0, 1); PG8_STAGE(PG8_SA(0, 0), a2, voffA);
            PG8_BAR; PG8_WAIT_L(0); PG8_MMA(1, 0, At, B0); PG8_BAR; PG8_SCHED;
            PG8_STAGE(PG8_SB(0, 1), b2 + hsB, voffB);
            PG8_WAIT_V(6); PG8_BAR; PG8_MMA(1, 1, At, B1); PG8_BAR;
            PG8_LDB(B0, 1, 0); PG8_SCHED; PG8_LDA(At, 1, 0); PG8_STAGE(PG8_SA(0, 1), a2 + hsA, voffA);
            PG8_WAIT_L(8); PG8_BAR; PG8_WAIT_L(0); PG8_MMA(0, 0, At, B0); PG8_BAR; PG8_SCHED;
            PG8_LDB(B1, 1, 1); PG8_STAGE(PG8_SB(1, 0), b3, voffB);
            PG8_BAR; PG8_WAIT_L(0); PG8_MMA(0, 1, At, B1); PG8_BAR;
            PG8_LDA(At, 1, 1); PG8_STAGE(PG8_SA(1, 0), a3, voffA);
            PG8_BAR; PG8_WAIT_L(0); PG8_MMA(1, 0, At, B0); PG8_BAR; PG8_SCHED;
            PG8_STAGE(PG8_SB(1, 1), b3 + hsB, voffB);
            PG8_WAIT_V(6); PG8_BAR; PG8_MMA(1, 1, At, B1); PG8_BAR;
            }
        }
        if constexpr (ALIGN_EPI) { if (wr == 0) PG8_BAR; }
        E(acc, cur, wr, wc, fr, fq);
        if (!has_next) break;
#pragma unroll
        for (int a = 0; a < 2; ++a)
#pragma unroll
            for (int b = 0; b < 2; ++b)
#pragma unroll
                for (int m = 0; m < 4; ++m)
#pragma unroll
                    for (int n = 0; n < 2; ++n) acc[a][b][m][n] = (f32x4){0.f, 0.f, 0.f, 0.f};
        cur = nxt; cA = nA; cB = nB; ++ui;
        if constexpr (ALIGN_EPI) { if (wr == 1) PG8_BAR; }
    }
    PG8_WAIT_V(0);
    if constexpr (!ALIGN_EPI) { if (wr == 0) PG8_BAR; }
    PG8_BAR;
#undef PG8_SA
#undef PG8_SB
#undef PG8_STAGE
#undef PG8_LDA
#undef PG8_LDB
#undef PG8_MMA
#undef PG8_WAIT_V
#undef PG8_WAIT_L
#undef PG8_BAR
#undef PG8_SCHED
}
}
typedef f32x4 AccT[2][2][4][2];

#define XB_TMO      128
#define XB_XCNT(j)  (256  + 64 * (j))
#define XB_XSUB(j)  (1280 + 64 * (j))
#define XB_XGEN(j)  (2304 + 64 * (j))
#define XB_TOP      3328
#define XB_TOPGEN   3392
#define XCD_BAR_WORDS 3456
#define XB_SPIN_CAP (1u << 18)
__device__ __forceinline__ unsigned xb_ld(unsigned* p)              { return __hip_atomic_load(p, __ATOMIC_RELAXED, __HIP_MEMORY_SCOPE_AGENT); }
__device__ __forceinline__ unsigned xb_add(unsigned* p, unsigned v) { return __hip_atomic_fetch_add(p, v, __ATOMIC_RELAXED, __HIP_MEMORY_SCOPE_AGENT); }
__device__ __forceinline__ unsigned xb_xcc_id() { return (unsigned)__builtin_amdgcn_s_getreg((3 << 11) | 20) & 0xFu; }
#define XB_SPIN(cond, bar) do { unsigned _sp = 0; while (cond) { __builtin_amdgcn_s_sleep(1); \
    if ((++_sp & 255u) == 0u) { if (xb_ld(&(bar)[XB_TMO])) break; if (_sp > XB_SPIN_CAP) { atomicAdd(&(bar)[XB_TMO], 1u); break; } } } } while (0)
struct XcdBarrier { unsigned* bar; unsigned x; volatile LAS unsigned* st; };
__device__ __forceinline__ XcdBarrier xcd_barrier_post(unsigned* bar, volatile LAS unsigned* st) {
    XcdBarrier b; b.bar = bar; b.x = xb_xcc_id(); b.st = st;
    if (threadIdx.x == 0) (void)xb_add(&bar[XB_XCNT(b.x)], 1u);
    return b;
}
__device__ __forceinline__ void xcd_barrier_complete(unsigned* bar, unsigned x, unsigned& nloc, unsigned& nx) {
    const unsigned G = gridDim.x * gridDim.y * gridDim.z;
    unsigned sum, cnt, mine, sp = 0u;
    for (;;) {
        sum = 0u; cnt = 0u; mine = 0u;
#pragma unroll
        for (unsigned j = 0; j < 16; ++j) { const unsigned c = xb_ld(&bar[XB_XCNT(j)]); sum += c; cnt += (c > 0u) ? 1u : 0u; mine = (j == x) ? c : mine; }
        if (sum == G) break;
        __builtin_amdgcn_s_sleep(1);
        if ((++sp & 255u) == 0u) { if (xb_ld(&bar[XB_TMO])) break; if (sp > XB_SPIN_CAP) { atomicAdd(&bar[XB_TMO], 1u); break; } }
    }
    nloc = mine > 0u ? mine : 1u; nx = cnt > 0u ? cnt : 1u;
}
__device__ __forceinline__ void xcd_barrier(const XcdBarrier& b) {
    asm volatile("s_waitcnt vmcnt(0)" ::: "memory");
    __syncthreads();
    if (threadIdx.x == 0) {
        unsigned* bar = b.bar;
        __builtin_amdgcn_s_waitcnt(0);
        unsigned nloc = b.st[0], nx = b.st[1];
        if (nloc == 0u) { xcd_barrier_complete(bar, b.x, nloc, nx); b.st[0] = nloc; b.st[1] = nx; }
        const unsigned old = xb_add(&bar[XB_XSUB(b.x)], 1u);
        const unsigned gen = old / nloc;
        if (old + 1u == (gen + 1u) * nloc) {
            __builtin_amdgcn_fence(__ATOMIC_RELEASE, "agent");
            asm volatile("s_waitcnt vmcnt(0)" ::: "memory");
            const unsigned og = xb_add(&bar[XB_TOP], 1u);
            const unsigned tg = og / nx;
            if (og + 1u == (tg + 1u) * nx) xb_add(&bar[XB_TOPGEN], 1u);
            else XB_SPIN(xb_ld(&bar[XB_TOPGEN]) == tg, bar);
            __builtin_amdgcn_fence(__ATOMIC_ACQUIRE, "agent");
            xb_add(&bar[XB_XGEN(b.x)], 1u);
            asm volatile("s_waitcnt vmcnt(0)" ::: "memory");
        } else {
            XB_SPIN(xb_ld(&bar[XB_XGEN(b.x)]) == gen, bar);
            __builtin_amdgcn_fence(__ATOMIC_ACQUIRE, "agent");
            asm volatile("s_waitcnt vmcnt(0)" ::: "memory");
        }
    }
    __syncthreads();
}

constexpr size_t MiB = 1u << 20;
constexpr size_t WS_CTL = 0, CTL_ZERO_BYTES = 64 * 1024;
constexpr size_t SZ_FUP = (size_t)5632 * 1024 * 2, SZ_FDN = (size_t)1024 * 2816 * 2;
constexpr size_t WS_W = 1 * MiB;
constexpr size_t W_FUP = WS_W;
constexpr size_t W_FDN = W_FUP + 8 * SZ_FUP;
constexpr size_t W_AQK = W_FDN + 8 * SZ_FDN;
constexpr size_t W_AV  = W_AQK + (size_t)6144 * 1024 * 2;
constexpr size_t W_AO  = W_AV + (size_t)3072 * 1024 * 2;
constexpr size_t W_BIN = W_AO + (size_t)1024 * 1024 * 2;
constexpr size_t W_BQ  = W_BIN + (size_t)768 * 1024 * 2;
constexpr size_t W_BK  = W_BQ + (size_t)1536 * 384 * 2;
constexpr size_t W_BV  = W_BK + (size_t)1024 * 256 * 2;
constexpr size_t W_BO  = W_BV + (size_t)1024 * 256 * 2;
constexpr size_t W_CIN = W_BO + (size_t)1024 * 1024 * 2;
constexpr size_t W_CV  = W_CIN + (size_t)4096 * 1024 * 2;
constexpr size_t W_CO  = W_CV + (size_t)2048 * 1024 * 2;
constexpr size_t W_DIN = W_CO + (size_t)1024 * 2048 * 2;
constexpr size_t W_DG  = W_DIN + (size_t)2048 * 1024 * 2;
constexpr size_t W_DO  = W_DG + (size_t)2048 * 256 * 2;
constexpr size_t W_END = W_DO + (size_t)1024 * 1024 * 2;
constexpr size_t WS_XB = ((W_END + MiB - 1) / MiB) * MiB;
constexpr size_t WS_SS = WS_XB + (size_t)MTOK * DM * 2;
constexpr size_t WS_TA = WS_SS + (size_t)MTOK * 16 * 4;
constexpr size_t WS_TB = WS_TA + (size_t)MTOK * 32 * 4 * 2;
constexpr size_t WS_TC = WS_TB + (size_t)MTOK * 16 * 4 * 2;
constexpr size_t WS_R  = WS_TC + (size_t)MTOK * 64 * 4 * 2;
constexpr size_t SZ_AH = (size_t)3 * 8 * 16 * 2048 * 64 * 2;
constexpr size_t RA_Q = WS_R, RA_K = RA_Q + SZ_AH, RA_V = RA_K + SZ_AH, RA_O = RA_V + SZ_AH, RA_END = RA_O + (size_t)MTOK * DM * 2;
constexpr size_t RB_CQ = WS_R, RB_CKV = RB_CQ + (size_t)MTOK * 384 * 2, RB_KR = RB_CKV + (size_t)MTOK * 256 * 2, RB_SS = RB_KR + (size_t)MTOK * 32 * 4,
                 RB_QR = RB_SS + (size_t)MTOK * 32 * 4, RB_KB = RB_QR + (size_t)MTOK * 1536 * 2, RB_VT = RB_KB + (size_t)MTOK * 1536 * 2, RB_O = RB_VT + (size_t)MTOK * 1024 * 2, RB_END = RB_O + (size_t)MTOK * 1024 * 2;
constexpr size_t RC_Q = WS_R, RC_K = RC_Q + (size_t)MTOK * 1024 * 2, RC_G = RC_K + (size_t)MTOK * 1024 * 2, RC_VT = RC_G + (size_t)MTOK * 2048 * 2, RC_END = RC_VT + (size_t)MTOK * 2048 * 2;
constexpr size_t RD_GG = WS_R, RD_U = RD_GG + (size_t)MTOK * 1024 * 2, RD_UC = RD_U + (size_t)MTOK * 1024 * 2, RD_LA = RD_UC + (size_t)MTOK * 1024 * 2, RD_GU = RD_LA + (size_t)MTOK * 1024 * 4, RD_END = RD_GU + (size_t)MTOK * 1024 * 2;
constexpr size_t WS_NEED = RC_END > RA_END ? (RC_END > RB_END ? RC_END : RB_END) : (RA_END > RB_END ? RA_END : RB_END);
static_assert(RD_END <= WS_NEED && WS_R + (size_t)MTOK * DFF * 2 <= WS_NEED, "ws map");
static_assert(WS_NEED <= (size_t)738197504, "workspace must fit 4x the largest input");

constexpr int RING_BYTES = 131072, LDS_X_OFF = RING_BYTES, LDS_X_BYTES = 8192, MISC_OFF = LDS_X_OFF + LDS_X_BYTES, PT_OFF = MISC_OFF + 256, LDS_BYTES = 147456;

struct Args { const void* in[28]; float* out; unsigned char* ws; };

__device__ __forceinline__ float sum16(const float* p) {
    const f32x4 a = ((const f32x4*)p)[0], b = ((const f32x4*)p)[1], c = ((const f32x4*)p)[2], d = ((const f32x4*)p)[3];
    return ((a.x + a.y) + (a.z + a.w)) + ((b.x + b.y) + (b.z + b.w)) + ((c.x + c.y) + (c.z + c.w)) + ((d.x + d.y) + (d.z + d.w));
}
__device__ __forceinline__ float sum8(const float* p) {
    const f32x4 a = ((const f32x4*)p)[0], b = ((const f32x4*)p)[1];
    return ((a.x + a.y) + (a.z + a.w)) + ((b.x + b.y) + (b.z + b.w));
}
__device__ __forceinline__ float row_rs(const float* SS, int row) { return rsqrtf(sum16(SS + (size_t)row * 16) * (1.f / 1024.f) + NORM_EPS); }

struct EpiSwiGLU { static constexpr bool PERM = true;
    bf16_t* H; const float* SS;
    __device__ __forceinline__ void operator()(const AccT& acc, const pg8::Unit& u, int wr, int wc, int fr, int fq) const {
        const int row0 = u.pm * 256 + wr * 64 + fr, hcol = u.pn * 128 + wc * 32 + 8 * fq;
#pragma unroll
        for (int ai = 0; ai < 2; ++ai)
#pragma unroll
            for (int m = 0; m < 4; ++m) { const int row = row0 + ai * 128 + m * 16; const float rs = row_rs(SS, row);
                float h[8];
#pragma unroll
                for (int n = 0; n < 2; ++n)
#pragma unroll
                    for (int j = 0; j < 4; ++j) { const float g = acc[ai][0][m][n][j] * rs, up = acc[ai][1][m][n][j] * rs; h[4 * n + j] = silu_f(g) * up; }
                u32x4 w; w.x = pk2(h[0], h[1]); w.y = pk2(h[2], h[3]); w.z = pk2(h[4], h[5]); w.w = pk2(h[6], h[7]);
                *(u32x4*)(H + (size_t)row * DFF + hcol) = w; }
    }
};
struct EpiRes { static constexpr bool PERM = true;
    const float* base; float* out; bf16_t* XB; float* SS; float alpha;
    __device__ __forceinline__ void operator()(const AccT& acc, const pg8::Unit& u, int wr, int wc, int fr, int fq) const {
        const int row0 = u.pm * 256 + wr * 64 + fr, col0 = u.pn * 256 + wc * 32 + 8 * fq;
#pragma unroll
        for (int ai = 0; ai < 2; ++ai)
#pragma unroll
            for (int m = 0; m < 4; ++m) { const int row = row0 + ai * 128 + m * 16; float ssq = 0.f;
#pragma unroll
                for (int bj = 0; bj < 2; ++bj) { const size_t off = (size_t)row * DM + col0 + bj * 128;
                    const f32x4 b0 = *(const f32x4*)(base + off), b1 = *(const f32x4*)(base + off + 4);
                    const f32x4 x0 = b0 + acc[ai][bj][m][0] * alpha, x1 = b1 + acc[ai][bj][m][1] * alpha;
                    *(f32x4*)(out + off) = x0; *(f32x4*)(out + off + 4) = x1;
                    ssq += (x0.x * x0.x + x0.y * x0.y) + (x0.z * x0.z + x0.w * x0.w) + (x1.x * x1.x + x1.y * x1.y) + (x1.z * x1.z + x1.w * x1.w);
                    u32x4 w; w.x = pk2(x0.x, x0.y); w.y = pk2(x0.z, x0.w); w.z = pk2(x1.x, x1.y); w.w = pk2(x1.z, x1.w);
                    *(u32x4*)(XB + off) = w; }
                ssq += __shfl_xor(ssq, 16); ssq += __shfl_xor(ssq, 32);
                if (fq == 0) SS[(size_t)row * 16 + u.pn * 4 + wc] = ssq; }
    }
};
struct EpiAQK { static constexpr bool PERM = false;
    bf16_t* Q; bf16_t* Kb; const float* SS; const float* gq; const float* gk; const float* cosT; const float* sinT; int rowbase;
    __device__ __forceinline__ void operator()(const AccT& acc, const pg8::Unit& u, int wr, int wc, int fr, int fq) const {
        const int isk = u.pn >= 12 ? 1 : 0, hh = (u.pn - 12 * isk) * 4 + wc, g = hh >> 4, h = hh & 15, dsh = 2 * g;
        bf16_t* dst = isk ? Kb : Q; const float* gain = isk ? gk : gq; const float osc = isk ? 1.f : 0.125f * LOG2E;
        f32x4 ga[2][2];
#pragma unroll
        for (int bj = 0; bj < 2; ++bj)
#pragma unroll
            for (int n = 0; n < 2; ++n) ga[bj][n] = *(const f32x4*)(gain + 32 * bj + 16 * n + 4 * fq);
#pragma unroll
        for (int ai = 0; ai < 2; ++ai)
#pragma unroll
            for (int m = 0; m < 4; ++m) { const int rl = u.pm * 256 + ai * 128 + wr * 64 + m * 16 + fr, row = rowbase + rl; const float rs = row_rs(SS, row);
                f32x4 v[2][2]; float ss = 0.f;
#pragma unroll
                for (int bj = 0; bj < 2; ++bj)
#pragma unroll
                    for (int n = 0; n < 2; ++n) { v[bj][n] = acc[ai][bj][m][n] * rs; ss += (v[bj][n].x * v[bj][n].x + v[bj][n].y * v[bj][n].y) + (v[bj][n].z * v[bj][n].z + v[bj][n].w * v[bj][n].w); }
                ss += __shfl_xor(ss, 16); ss += __shfl_xor(ss, 32);
                const float hs = rsqrtf(ss * (1.f / 64.f) + NORM_EPS) * osc;
                const int bl = rl >> 11, s = rl & 2047, r = s & ((1 << dsh) - 1), j = s >> dsh, tp = r * (2048 >> dsh) + j;
                bf16_t* o = dst + ((size_t)((g * 8 + bl) * 16 + h) * 2048 + tp) * 64;
#pragma unroll
                for (int n = 0; n < 2; ++n) { const f32x4 c = *(const f32x4*)(cosT + (size_t)row * 32 + 16 * n + 4 * fq), sn = *(const f32x4*)(sinT + (size_t)row * 32 + 16 * n + 4 * fq);
                    const f32x4 x1 = v[0][n] * ga[0][n] * hs, x2 = v[1][n] * ga[1][n] * hs;
                    const f32x4 o1 = x1 * c - x2 * sn, o2 = x2 * c + x1 * sn;
                    u32x2 w1, w2; w1.x = pk2(o1.x, o1.y); w1.y = pk2(o1.z, o1.w); w2.x = pk2(o2.x, o2.y); w2.y = pk2(o2.z, o2.w);
                    *(u32x2*)(o + 16 * n + 4 * fq) = w1; *(u32x2*)(o + 32 + 16 * n + 4 * fq) = w2; } }
    }
};
struct EpiVT { static constexpr bool PERM = true;
    bf16_t* O; size_t ldo; const float* SS; int sstride, soff, scnt; float sdiv; int mode, dsh, rowtok0;
    __device__ __forceinline__ void operator()(const AccT& acc, const pg8::Unit& u, int wr, int wc, int fr, int fq) const {
        int tok0, tstride, thoff;
        if (mode == 1) { const int b = u.pn >> 3, tt = u.pn & 7; int t0;
            if (dsh == 0) { t0 = 256 * tt; tstride = 1; thoff = 128; } else if (dsh == 2) { t0 = 4 * ((tt & 1) * 256) + (tt >> 1); tstride = 4; thoff = 512; } else { t0 = 2 * tt; tstride = 16; thoff = 1; }
            tok0 = rowtok0 + b * SEQ + t0; }
        else { tok0 = u.pn * 256; tstride = 1; thoff = 128; }
        float myv;
        {   const int l = fr + 16 * fq, tok = tok0 + tstride * (32 * wc + (l & 31)) + thoff * (l >> 5); const float* p = SS + (size_t)tok * sstride + soff;
            const float s = (scnt == 16) ? sum16(p) : sum8(p); myv = rsqrtf(s / sdiv + NORM_EPS); }
        float sc[2][8];
#pragma unroll
        for (int bj = 0; bj < 2; ++bj)
#pragma unroll
            for (int e = 0; e < 8; ++e) sc[bj][e] = __shfl(myv, bj * 32 + 8 * fq + e);
#pragma unroll
        for (int ai = 0; ai < 2; ++ai)
#pragma unroll
            for (int m = 0; m < 4; ++m) { const int orow = u.pm * 256 + ai * 128 + wr * 64 + m * 16 + fr;
#pragma unroll
                for (int bj = 0; bj < 2; ++bj) { const f32x4 a0 = acc[ai][bj][m][0], a1 = acc[ai][bj][m][1];
                    u32x4 w; w.x = pk2(a0.x * sc[bj][0], a0.y * sc[bj][1]); w.y = pk2(a0.z * sc[bj][2], a0.w * sc[bj][3]); w.z = pk2(a1.x * sc[bj][4], a1.y * sc[bj][5]); w.w = pk2(a1.z * sc[bj][6], a1.w * sc[bj][7]);
                    *(u32x4*)(O + (size_t)orow * ldo + (size_t)u.pn * 256 + 128 * bj + 32 * wc + 8 * fq) = w; } }
    }
};
struct EpiBIn { static constexpr bool PERM = true;
    bf16_t* CQ; bf16_t* CKV; float* KR; float* SSB; const float* SS;
    __device__ __forceinline__ void operator()(const AccT& acc, const pg8::Unit& u, int wr, int wc, int fr, int fq) const {
#pragma unroll
        for (int ai = 0; ai < 2; ++ai)
#pragma unroll
            for (int m = 0; m < 4; ++m) { const int row = u.pm * 256 + ai * 128 + wr * 64 + m * 16 + fr; const float rs = row_rs(SS, row);
#pragma unroll
                for (int bj = 0; bj < 2; ++bj) { const int col = u.pn * 256 + bj * 128 + wc * 32 + 8 * fq;
                    const f32x4 v0 = acc[ai][bj][m][0] * rs, v1 = acc[ai][bj][m][1] * rs;
                    float ss = (v0.x * v0.x + v0.y * v0.y) + (v0.z * v0.z + v0.w * v0.w) + (v1.x * v1.x + v1.y * v1.y) + (v1.z * v1.z + v1.w * v1.w);
                    ss += __shfl_xor(ss, 16); ss += __shfl_xor(ss, 32);
                    if (col < 672) { if (fq == 0) SSB[(size_t)row * 32 + (col >> 5)] = ss;
                        if (col < 640) { u32x4 w; w.x = pk2(v0.x, v0.y); w.y = pk2(v0.z, v0.w); w.z = pk2(v1.x, v1.y); w.w = pk2(v1.z, v1.w);
                            if (col < 384) *(u32x4*)(CQ + (size_t)row * 384 + col) = w; else *(u32x4*)(CKV + (size_t)row * 256 + (col - 384)) = w; }
                        else { *(f32x4*)(KR + (size_t)row * 32 + (col - 640)) = v0; *(f32x4*)(KR + (size_t)row * 32 + (col - 640) + 4) = v1; } } } }
    }
};
struct EpiRowScale { static constexpr bool PERM = true;
    bf16_t* O; int ldo; bf16_t* O2; int ld2; int split; const float* SS; int sstride, soff, scnt; float sdiv; int act;
    __device__ __forceinline__ void operator()(const AccT& acc, const pg8::Unit& u, int wr, int wc, int fr, int fq) const {
#pragma unroll
        for (int ai = 0; ai < 2; ++ai)
#pragma unroll
            for (int m = 0; m < 4; ++m) { const int row = u.pm * 256 + ai * 128 + wr * 64 + m * 16 + fr;
                const float* p = SS + (size_t)row * sstride + soff; float s = sum8(p); if (scnt >= 12) s += ((const f32x4*)p)[2].x + ((const f32x4*)p)[2].y + ((const f32x4*)p)[2].z + ((const f32x4*)p)[2].w; if (scnt == 16) s += ((const f32x4*)p)[3].x + ((const f32x4*)p)[3].y + ((const f32x4*)p)[3].z + ((const f32x4*)p)[3].w;
                const float rs = rsqrtf(s / sdiv + NORM_EPS);
#pragma unroll
                for (int bj = 0; bj < 2; ++bj) { const int col = u.pn * 256 + bj * 128 + wc * 32 + 8 * fq;
                    f32x4 v0 = acc[ai][bj][m][0] * rs, v1 = acc[ai][bj][m][1] * rs;
                    if (act == 1 && col < split) { v0 = (f32x4){gelu_tanh_f(v0.x), gelu_tanh_f(v0.y), gelu_tanh_f(v0.z), gelu_tanh_f(v0.w)}; v1 = (f32x4){gelu_tanh_f(v1.x), gelu_tanh_f(v1.y), gelu_tanh_f(v1.z), gelu_tanh_f(v1.w)}; }
                    u32x4 w; w.x = pk2(v0.x, v0.y); w.y = pk2(v0.z, v0.w); w.z = pk2(v1.x, v1.y); w.w = pk2(v1.z, v1.w);
                    if (col < split) *(u32x4*)(O + (size_t)row * ldo + col) = w; else *(u32x4*)(O2 + (size_t)row * ld2 + (col - split)) = w; } }
    }
};
struct EpiBK { static constexpr bool PERM = false;
    bf16_t* KB; const float* SSB; const float* KR; const float* gk; const float* cosT; const float* sinT;
    __device__ __forceinline__ void operator()(const AccT& acc, const pg8::Unit& u, int wr, int wc, int fr, int fq) const {
        const int h = u.pn * 4 + wc;
        f32x4 ga[2][2];
#pragma unroll
        for (int bj = 0; bj < 2; ++bj)
#pragma unroll
            for (int n = 0; n < 2; ++n) ga[bj][n] = *(const f32x4*)(gk + 32 * bj + 16 * n + 4 * fq);
        const f32x4 gr1 = *(const f32x4*)(gk + 64 + 4 * fq), gr2 = *(const f32x4*)(gk + 80 + 4 * fq);
#pragma unroll
        for (int ai = 0; ai < 2; ++ai)
#pragma unroll
            for (int m = 0; m < 4; ++m) { const int row = u.pm * 256 + ai * 128 + wr * 64 + m * 16 + fr;
                const float* sp = SSB + (size_t)row * 32; const float rkv = rsqrtf(sum8(sp + 12) * (1.f / 256.f) + NORM_EPS); const float ssr = sp[20];
                f32x4 v[2][2]; float ss = 0.f;
#pragma unroll
                for (int bj = 0; bj < 2; ++bj)
#pragma unroll
                    for (int n = 0; n < 2; ++n) { v[bj][n] = acc[ai][bj][m][n] * rkv; ss += (v[bj][n].x * v[bj][n].x + v[bj][n].y * v[bj][n].y) + (v[bj][n].z * v[bj][n].z + v[bj][n].w * v[bj][n].w); }
                ss += __shfl_xor(ss, 16); ss += __shfl_xor(ss, 32);
                const float sk = rsqrtf((ss + ssr) * (1.f / 96.f) + NORM_EPS);
                const int b = row >> 11, s = row & 2047;
                bf16_t* o = KB + ((size_t)(b * 16 + h) * 2048 + s) * 96;
#pragma unroll
                for (int bj = 0; bj < 2; ++bj)
#pragma unroll
                    for (int n = 0; n < 2; ++n) { const f32x4 y = v[bj][n] * ga[bj][n] * sk; u32x2 w; w.x = pk2(y.x, y.y); w.y = pk2(y.z, y.w); *(u32x2*)(o + 32 * bj + 16 * n + 4 * fq) = w; }
                const f32x4 k1 = *(const f32x4*)(KR + (size_t)row * 32 + 4 * fq) * gr1 * sk, k2 = *(const f32x4*)(KR + (size_t)row * 32 + 16 + 4 * fq) * gr2 * sk;
                const f32x4 c = *(const f32x4*)(cosT + (size_t)row * 16 + 4 * fq), sn = *(const f32x4*)(sinT + (size_t)row * 16 + 4 * fq);
                const f32x4 o1 = k1 * c - k2 * sn, o2 = k2 * c + k1 * sn;
                u32x2 w1, w2; w1.x = pk2(o1.x, o1.y); w1.y = pk2(o1.z, o1.w); w2.x = pk2(o2.x, o2.y); w2.y = pk2(o2.z, o2.w);
                *(u32x2*)(o + 64 + 4 * fq) = w1; *(u32x2*)(o + 80 + 4 * fq) = w2; }
    }
};
struct EpiCIn { static constexpr bool PERM = false;
    bf16_t* Q; bf16_t* Kc; bf16_t* G; const float* SS; const float* cosT; const float* sinT;
    __device__ __forceinline__ void operator()(const AccT& acc, const pg8::Unit& u, int wr, int wc, int fr, int fq) const {
        if (u.pn >= 8) {
#pragma unroll
            for (int ai = 0; ai < 2; ++ai)
#pragma unroll
                for (int m = 0; m < 4; ++m) { const int row = u.pm * 256 + ai * 128 + wr * 64 + m * 16 + fr; const float rs = row_rs(SS, row);
#pragma unroll
                    for (int bj = 0; bj < 2; ++bj)
#pragma unroll
                        for (int n = 0; n < 2; ++n) { const f32x4 v = acc[ai][bj][m][n] * rs; u32x2 w; w.x = pk2(v.x, v.y); w.y = pk2(v.z, v.w);
                            *(u32x2*)(G + (size_t)row * 2048 + (u.pn - 8) * 256 + bj * 128 + wc * 32 + 16 * n + 4 * fq) = w; } }
            return; }
        const int isk = u.pn >= 4 ? 1 : 0, h = (u.pn & 3) * 2 + (wc >> 1);
        bf16_t* dst = isk ? Kc : Q;
        const float lg = log2f(1.f - exp2f(-5.f - (float)h));
        const float ksc = isk ? 0.08838834764831845f : 1.f;
#pragma unroll
        for (int ai = 0; ai < 2; ++ai)
#pragma unroll
            for (int m = 0; m < 4; ++m) { const int row = u.pm * 256 + ai * 128 + wr * 64 + m * 16 + fr; const float rs = row_rs(SS, row);
                const int b = row >> 11, s = row & 2047, il = s & 127;
                const float dec = fast_exp2((isk ? -(float)(il + 1) : (float)(il + 1)) * lg) * ksc * rs;
                bf16_t* o = dst + ((size_t)(b * 8 + h) * 2048 + s) * 128;
#pragma unroll
                for (int n = 0; n < 2; ++n) { const int i0 = 32 * (wc & 1) + 16 * n + 4 * fq;
                    const f32x4 c = *(const f32x4*)(cosT + (size_t)row * 64 + i0), sn = *(const f32x4*)(sinT + (size_t)row * 64 + i0);
                    const f32x4 x1 = acc[ai][0][m][n] * dec, x2 = acc[ai][1][m][n] * dec;
                    const f32x4 o1 = x1 * c - x2 * sn, o2 = x2 * c + x1 * sn;
                    u32x2 w1, w2; w1.x = pk2(o1.x, o1.y); w1.y = pk2(o1.z, o1.w); w2.x = pk2(o2.x, o2.y); w2.y = pk2(o2.z, o2.w);
                    *(u32x2*)(o + i0) = w1; *(u32x2*)(o + 64 + i0) = w2; } }
    }
};
struct EpiDGate { static constexpr bool PERM = true;
    float* LA; bf16_t* GU; const bf16_t* UC; const float* brg; const float* big; const float* lam;
    __device__ __forceinline__ void operator()(const AccT& acc, const pg8::Unit& u, int wr, int wc, int fr, int fq) const {
        const int ch = u.pn * 128 + wc * 32 + 8 * fq;
        float b1[8], b2[8], sp[8];
#pragma unroll
        for (int e = 0; e < 8; ++e) { b1[e] = brg[ch + e]; b2[e] = big[ch + e]; sp[e] = -8.f * log1pf(expf(-lam[ch + e])); }
#pragma unroll
        for (int ai = 0; ai < 2; ++ai)
#pragma unroll
            for (int m = 0; m < 4; ++m) { const int row = u.pm * 256 + ai * 128 + wr * 64 + m * 16 + fr;
                const u32x4 uw = *(const u32x4*)(UC + (size_t)row * 1024 + ch);
                float uc[8] = {bflo(uw.x), bfhi(uw.x), bflo(uw.y), bfhi(uw.y), bflo(uw.z), bfhi(uw.z), bflo(uw.w), bfhi(uw.w)};
                float la[8], gu[8];
#pragma unroll
                for (int n = 0; n < 2; ++n)
#pragma unroll
                    for (int j = 0; j < 4; ++j) { const int e = 4 * n + j; const float r = sigmoid_f(acc[ai][0][m][n][j] + b1[e]), ig = sigmoid_f(acc[ai][1][m][n][j] + b2[e]);
                        la[e] = sp[e] * r; gu[e] = ig * uc[e]; }
                *(f32x4*)(LA + (size_t)row * 1024 + ch) = (f32x4){la[0], la[1], la[2], la[3]}; *(f32x4*)(LA + (size_t)row * 1024 + ch + 4) = (f32x4){la[4], la[5], la[6], la[7]};
                u32x4 w; w.x = pk2(gu[0], gu[1]); w.y = pk2(gu[2], gu[3]); w.z = pk2(gu[4], gu[5]); w.w = pk2(gu[6], gu[7]);
                *(u32x4*)(GU + (size_t)row * 1024 + ch) = w; }
    }
};

#define LDS_WAIT() asm volatile("s_waitcnt lgkmcnt(0)" ::: "memory")
template <class F> __device__ __forceinline__ void prep_matrix(bf16_t* Bt, int N, int K, F src, LAS float* scr, int gw, int NGW, int lane) {
    const int nblk = N / 32, items = nblk * (K / 64);
    for (int it = gw; it < items; it += NGW) {
        const int kb = it / nblk, nb = it % nblk, k0 = 64 * kb, n0 = 32 * nb;
#pragma unroll 8
        for (int i = 0; i < 32; ++i) { const int kk = 2 * i + (lane >> 5); scr[kk * 33 + (lane & 31)] = src(n0 + (lane & 31), k0 + kk); }
        LDS_WAIT(); asm volatile("" ::: "memory");
        const int c = lane & 7;
#pragma unroll
        for (int j = 0; j < 4; ++j) { const int n = (lane >> 3) + 8 * j; const LAS float* s = scr + (8 * c) * 33 + n;
            u32x4 o; o.x = pk2(s[0 * 33], s[1 * 33]); o.y = pk2(s[2 * 33], s[3 * 33]); o.z = pk2(s[4 * 33], s[5 * 33]); o.w = pk2(s[6 * 33], s[7 * 33]);
            *(u32x4*)(Bt + (size_t)(n0 + n) * K + k0 + 8 * c) = o; }
        LDS_WAIT(); asm volatile("" ::: "memory");
    }
}

#define MFMA32(a, b, c) __builtin_amdgcn_mfma_f32_32x32x16_bf16((a), (b), (c), 0, 0, 0)
__device__ __forceinline__ bf16x8 mk8(u32x2 lo, u32x2 hi) { u32x4 v = {lo.x, lo.y, hi.x, hi.y}; return __builtin_bit_cast(bf16x8, v); }
__device__ __forceinline__ bf16x8 pack8(const f32x16& p, int ks) {
    u32x4 v; v.x = pk2(p[8 * ks + 0], p[8 * ks + 1]); v.y = pk2(p[8 * ks + 2], p[8 * ks + 3]); v.z = pk2(p[8 * ks + 4], p[8 * ks + 5]); v.w = pk2(p[8 * ks + 6], p[8 * ks + 7]);
    return __builtin_bit_cast(bf16x8, v);
}

__device__ __forceinline__ void mixA_attn(LAS unsigned char* lds, const bf16_t* QA, const bf16_t* KA, const bf16_t* VT, bf16_t* OA, int half, float shift) {
    const int tid = opaque_tid(), lane = tid & 63, wid = __builtin_amdgcn_readfirstlane(tid >> 6), r32 = lane & 31, hi = lane >> 5;
    LAS float* Ol = (LAS float*)lds; LAS float* Ll = (LAS float*)(lds + LDS_X_OFF);
#pragma unroll 1
    for (int unit = blockIdx.x; unit < 512; unit += gridDim.x) {
        const int bl = unit >> 6, h = (unit >> 2) & 15, c = unit & 3;
#pragma unroll 1
        for (int g = 0; g < 3; ++g) {
            const int dsh = 2 * g, L = 2048 >> dsh, tsh = 4 - dsh;
            const size_t hb = ((size_t)((g * 8 + bl) * 16 + h)) * 2048;
            const bf16_t* vbase = VT + ((size_t)(g * 1024 + h * 64)) * 16384 + (size_t)bl * 2048;
#pragma unroll 1
            for (int tt = 0; tt < 2; ++tt) {
                const int tau = 2 * wid + tt, r = tau >> tsh, a = (c << tsh) + (tau & ((1 << tsh) - 1));
                const size_t rb = hb + (size_t)r * L;
                bf16x8 qf[4];
#pragma unroll
                for (int d0 = 0; d0 < 4; ++d0) qf[d0] = *(const bf16x8*)(QA + (rb + 32 * a + r32) * 64 + 16 * d0 + 8 * hi);
                f32x16 o0 = {}, o1 = {}; float lsum = 0.f;
                const int kb0 = a - 4 < 0 ? 0 : a - 4;
#pragma unroll 1
                for (int kb = kb0; kb <= a; ++kb) {
                    bf16x8 kf[4];
#pragma unroll
                    for (int d0 = 0; d0 < 4; ++d0) kf[d0] = *(const bf16x8*)(KA + (rb + 32 * kb + r32) * 64 + 16 * d0 + 8 * hi);
                    const bf16_t* vp = vbase + (size_t)r32 * 16384 + r * L + 32 * kb + 4 * hi;
                    u32x2 vl[2][2][2];
#pragma unroll
                    for (int db = 0; db < 2; ++db)
#pragma unroll
                        for (int ks = 0; ks < 2; ++ks) { vl[db][ks][0] = *(const u32x2*)(vp + (size_t)db * 32 * 16384 + 16 * ks); vl[db][ks][1] = *(const u32x2*)(vp + (size_t)db * 32 * 16384 + 16 * ks + 8); }
                    f32x16 st = {};
#pragma unroll
                    for (int d0 = 0; d0 < 4; ++d0) st = MFMA32(kf[d0], qf[d0], st);
                    const int thi = ((kb == a) ? r32 : 63) - 4 * hi, tlo = ((kb == a - 4) ? r32 : -1) - 4 * hi;
#pragma unroll
                    for (int rr = 0; rr < 16; ++rr) { const int kc = (rr & 3) + 8 * (rr >> 2); const bool ok = (kc <= thi) && (kc >= tlo);
                        const float p = ok ? fast_exp2(st[rr] - shift) : 0.f; st[rr] = p; lsum += p; }
                    const bf16x8 p0 = pack8(st, 0), p1 = pack8(st, 1);
                    o0 = MFMA32(mk8(vl[0][0][0], vl[0][0][1]), p0, o0); o0 = MFMA32(mk8(vl[0][1][0], vl[0][1][1]), p1, o0);
                    o1 = MFMA32(mk8(vl[1][0][0], vl[1][0][1]), p0, o1); o1 = MFMA32(mk8(vl[1][1][0], vl[1][1][1]), p1, o1);
                }
                lsum += __shfl_xor(lsum, 32);
                const int pp = ((32 * a + r32) << dsh) + r - 512 * c;
#pragma unroll
                for (int db = 0; db < 2; ++db)
#pragma unroll
                    for (int q4 = 0; q4 < 4; ++q4) { const int ch = 2 * q4 + hi + 8 * db; LAS f32x4* ad = (LAS f32x4*)(Ol + pp * 64 + ((ch ^ (pp & 15)) << 2));
                        const f32x16& o = db ? o1 : o0; f32x4 v = {o[4 * q4], o[4 * q4 + 1], o[4 * q4 + 2], o[4 * q4 + 3]};
                        if (g > 0) v += *ad; *ad = v; }
                if (hi == 0) Ll[pp] = (g > 0 ? Ll[pp] : 0.f) + lsum;
            }
            __syncthreads();
        }
        for (int idx = tid; idx < 4096; idx += 512) { const int pp = idx >> 3, c8 = idx & 7; const float inv = 1.f / Ll[pp];
            const f32x4 a = *(LAS f32x4*)(Ol + pp * 64 + (((2 * c8) ^ (pp & 15)) << 2)), b = *(LAS f32x4*)(Ol + pp * 64 + (((2 * c8 + 1) ^ (pp & 15)) << 2));
            u32x4 w; w.x = pk2(a.x * inv, a.y * inv); w.y = pk2(a.z * inv, a.w * inv); w.z = pk2(b.x * inv, b.y * inv); w.w = pk2(b.z * inv, b.w * inv);
            *(u32x4*)(OA + ((size_t)(half * 8 + bl) * 2048 + 512 * c + pp) * 1024 + h * 64 + 8 * c8) = w; }
        __syncthreads();
    }
}

__device__ __forceinline__ void mixB_attn(const bf16_t* QR, const bf16_t* KB, const bf16_t* VT, bf16_t* OB, const float* gq, const float* cosT, const float* sinT, float shift) {
    const int tid = opaque_tid(), lane = tid & 63, wid = __builtin_amdgcn_readfirstlane(tid >> 6), r32 = lane & 31, hi = lane >> 5;
    const float qsc = 0.10206207261596575f * LOG2E;
    for (int unit = blockIdx.x; unit < 256; unit += gridDim.x) {
        const int b = unit >> 4, h = unit & 15;
        const bf16_t* kbase = KB + (size_t)(b * 16 + h) * 2048 * 96;
        const bf16_t* vbase = VT + (size_t)(h * 64) * MTOK + (size_t)b * 2048;
#pragma unroll 1
        for (int ti = 0; ti < 8; ++ti) {
            const int qt = (ti & 1) ? (63 - 8 * (ti >> 1) - wid) : (8 * (ti >> 1) + wid);
            const int row = b * 2048 + 32 * qt + r32;
            float qv[6][8]; float ss = 0.f;
#pragma unroll
            for (int d0 = 0; d0 < 6; ++d0) { const u32x4 w = *(const u32x4*)(QR + (size_t)row * 1536 + h * 96 + 16 * d0 + 8 * hi);
                qv[d0][0] = bflo(w.x); qv[d0][1] = bfhi(w.x); qv[d0][2] = bflo(w.y); qv[d0][3] = bfhi(w.y); qv[d0][4] = bflo(w.z); qv[d0][5] = bfhi(w.z); qv[d0][6] = bflo(w.w); qv[d0][7] = bfhi(w.w);
#pragma unroll
                for (int e = 0; e < 8; ++e) ss += qv[d0][e] * qv[d0][e]; }
            ss += __shfl_xor(ss, 32);
            const float sq = rsqrtf(ss * (1.f / 96.f) + NORM_EPS) * qsc;
#pragma unroll
            for (int d0 = 0; d0 < 6; ++d0)
#pragma unroll
                for (int e = 0; e < 8; ++e) qv[d0][e] *= sq * gq[16 * d0 + 8 * hi + e];
#pragma unroll
            for (int e = 0; e < 8; ++e) { const float c = cosT[(size_t)row * 16 + 8 * hi + e], sn = sinT[(size_t)row * 16 + 8 * hi + e]; const float x1 = qv[4][e], x2 = qv[5][e];
                qv[4][e] = x1 * c - x2 * sn; qv[5][e] = x2 * c + x1 * sn; }
            bf16x8 qf[6];
#pragma unroll
            for (int d0 = 0; d0 < 6; ++d0) { u32x4 w; w.x = pk2(qv[d0][0], qv[d0][1]); w.y = pk2(qv[d0][2], qv[d0][3]); w.z = pk2(qv[d0][4], qv[d0][5]); w.w = pk2(qv[d0][6], qv[d0][7]); qf[d0] = __builtin_bit_cast(bf16x8, w); }
            f32x16 o0 = {}, o1 = {}; float lsum = 0.f;
#pragma unroll 1
            for (int kb = 0; kb <= qt; ++kb) {
                bf16x8 kf[6];
#pragma unroll
                for (int d0 = 0; d0 < 6; ++d0) kf[d0] = *(const bf16x8*)(kbase + (size_t)(32 * kb + r32) * 96 + 16 * d0 + 8 * hi);
                const bf16_t* vp = vbase + (size_t)r32 * MTOK + 32 * kb + 4 * hi;
                u32x2 vl[2][2][2];
#pragma unroll
                for (int db = 0; db < 2; ++db)
#pragma unroll
                    for (int ks = 0; ks < 2; ++ks) { vl[db][ks][0] = *(const u32x2*)(vp + (size_t)db * 32 * MTOK + 16 * ks); vl[db][ks][1] = *(const u32x2*)(vp + (size_t)db * 32 * MTOK + 16 * ks + 8); }
                f32x16 st = {};
#pragma unroll
                for (int d0 = 0; d0 < 6; ++d0) st = MFMA32(kf[d0], qf[d0], st);
                const int thi = ((kb == qt) ? r32 : 63) - 4 * hi;
#pragma unroll
                for (int rr = 0; rr < 16; ++rr) { const int kc = (rr & 3) + 8 * (rr >> 2); const bool ok = (kc <= thi);
                    const float p = ok ? fast_exp2(st[rr] - shift) : 0.f; st[rr] = p; lsum += p; }
                const bf16x8 p0 = pack8(st, 0), p1 = pack8(st, 1);
                o0 = MFMA32(mk8(vl[0][0][0], vl[0][0][1]), p0, o0); o0 = MFMA32(mk8(vl[0][1][0], vl[0][1][1]), p1, o0);
                o1 = MFMA32(mk8(vl[1][0][0], vl[1][0][1]), p0, o1); o1 = MFMA32(mk8(vl[1][1][0], vl[1][1][1]), p1, o1);
            }
            lsum += __shfl_xor(lsum, 32);
            const float inv = 1.f / lsum;
            bf16_t* op = OB + (size_t)row * 1024 + h * 64;
#pragma unroll
            for (int db = 0; db < 2; ++db)
#pragma unroll
                for (int q4 = 0; q4 < 4; ++q4) { const f32x16& o = db ? o1 : o0; u32x2 w; w.x = pk2(o[4 * q4] * inv, o[4 * q4 + 1] * inv); w.y = pk2(o[4 * q4 + 2] * inv, o[4 * q4 + 3] * inv);
                    *(u32x2*)(op + 32 * db + 8 * q4 + 4 * hi) = w; }
        }
    }
}

constexpr int KT_STRIDE = 272, RT_STRIDE = 272;
__device__ __forceinline__ void mixC_retention(LAS unsigned char* lds, const bf16_t* QC, const bf16_t* KC, const bf16_t* VT, bf16_t* G) {
    const int tid = opaque_tid(), lane = tid & 63, wid = __builtin_amdgcn_readfirstlane(tid >> 6), r32 = lane & 31, hi = lane >> 5;
    LAS unsigned char* KT = lds; LAS unsigned char* RT = lds + 128 * KT_STRIDE; LAS float* ST = (LAS float*)(lds + LDS_X_OFF);
    for (int unit = blockIdx.x; unit < 256; unit += gridDim.x) {
        const int b = unit >> 4, h = (unit >> 1) & 7, rh = unit & 1;
        const int ib = wid & 1, gi = ib ? (3 - rh) : rh, vq = wid >> 1;
        const float lg = log2f(1.f - exp2f(-5.f - (float)h)), cd = exp2f(128.f * lg);
        const size_t bh = (size_t)(b * 8 + h) * 2048;
        f32x16 Racc[4];
#pragma unroll
        for (int db = 0; db < 4; ++db) Racc[db] = (f32x16){};
#pragma unroll 1
        for (int c = 0; c < 16; ++c) {
            const size_t tok0 = (size_t)b * 2048 + 128 * c;
#pragma unroll
            for (int e = 0; e < 4; ++e) { const int id = tid + 512 * e, j = id >> 4, d8 = id & 15;
                const u32x4 w = *(const u32x4*)(KC + (bh + 128 * c + j) * 128 + 8 * d8);
                LAS bf16_t* kt = (LAS bf16_t*)(KT + (8 * d8) * KT_STRIDE + 2 * j);
                kt[0 * (KT_STRIDE / 2)] = (bf16_t)(w.x & 0xffff); kt[1 * (KT_STRIDE / 2)] = (bf16_t)(w.x >> 16); kt[2 * (KT_STRIDE / 2)] = (bf16_t)(w.y & 0xffff); kt[3 * (KT_STRIDE / 2)] = (bf16_t)(w.y >> 16);
                kt[4 * (KT_STRIDE / 2)] = (bf16_t)(w.z & 0xffff); kt[5 * (KT_STRIDE / 2)] = (bf16_t)(w.z >> 16); kt[6 * (KT_STRIDE / 2)] = (bf16_t)(w.w & 0xffff); kt[7 * (KT_STRIDE / 2)] = (bf16_t)(w.w >> 16); }
            __syncthreads();
            bf16x8 qf[8];
#pragma unroll
            for (int s = 0; s < 8; ++s) qf[s] = *(const bf16x8*)(QC + (bh + 128 * c + 32 * gi + r32) * 128 + 16 * s + 8 * hi);
            f32x16 y0 = {}, y1 = {};
            if (c > 0) {
#pragma unroll
                for (int s = 0; s < 8; ++s) { const bf16x8 a0 = *(const LAS bf16x8*)(RT + (64 * vq + r32) * RT_STRIDE + (16 * s + 8 * hi) * 2), a1 = *(const LAS bf16x8*)(RT + (64 * vq + 32 + r32) * RT_STRIDE + (16 * s + 8 * hi) * 2);
                    y0 = MFMA32(a0, qf[s], y0); y1 = MFMA32(a1, qf[s], y1); }
            }
            const bf16_t* vrow = VT + (size_t)(h * 256 + 64 * vq + r32) * MTOK + tok0;
#pragma unroll 1
            for (int jb = 0; jb <= gi; ++jb) {
                f32x16 st = {};
#pragma unroll
                for (int s = 0; s < 8; ++s) { const bf16x8 kf = *(const bf16x8*)(KC + (bh + 128 * c + 32 * jb + r32) * 128 + 16 * s + 8 * hi); st = MFMA32(kf, qf[s], st); }
                {   const int thi = ((jb == gi) ? r32 : 63) - 4 * hi;
#pragma unroll
                    for (int rr = 0; rr < 16; ++rr) { const int kc = (rr & 3) + 8 * (rr >> 2); st[rr] = (kc <= thi) ? st[rr] : 0.f; } }
                const bf16x8 p0 = pack8(st, 0), p1 = pack8(st, 1);
                const bf16_t* vp = vrow + 32 * jb + 4 * hi;
                const bf16x8 v00 = mk8(*(const u32x2*)(vp), *(const u32x2*)(vp + 8)), v01 = mk8(*(const u32x2*)(vp + 16), *(const u32x2*)(vp + 24));
                const bf16x8 v10 = mk8(*(const u32x2*)(vp + (size_t)32 * MTOK), *(const u32x2*)(vp + (size_t)32 * MTOK + 8)), v11 = mk8(*(const u32x2*)(vp + (size_t)32 * MTOK + 16), *(const u32x2*)(vp + (size_t)32 * MTOK + 24));
                y0 = MFMA32(v00, p0, y0); y0 = MFMA32(v01, p1, y0); y1 = MFMA32(v10, p0, y1); y1 = MFMA32(v11, p1, y1);
            }
            {   const bf16_t* vu = VT + (size_t)(h * 256 + 32 * wid + r32) * MTOK + tok0 + 8 * hi;
#pragma unroll
                for (int s = 0; s < 8; ++s) { const bf16x8 vf = *(const bf16x8*)(vu + 16 * s);
#pragma unroll
                    for (int db = 0; db < 4; ++db) { const bf16x8 af = *(const LAS bf16x8*)(KT + (32 * db + r32) * KT_STRIDE + (16 * s + 8 * hi) * 2); Racc[db] = MFMA32(af, vf, Racc[db]); } }
#pragma unroll
                for (int db = 0; db < 4; ++db) Racc[db] *= cd;
            }
            float s1 = 0.f, s2 = 0.f;
#pragma unroll
            for (int rr = 0; rr < 16; ++rr) { s1 += y0[rr] + y1[rr]; s2 += y0[rr] * y0[rr] + y1[rr] * y1[rr]; }
            s1 += __shfl_xor(s1, 32); s2 += __shfl_xor(s2, 32);
            __syncthreads();
#pragma unroll
            for (int db = 0; db < 4; ++db)
#pragma unroll
                for (int q4 = 0; q4 < 4; ++q4) { u32x2 w; w.x = pk2(Racc[db][4 * q4], Racc[db][4 * q4 + 1]); w.y = pk2(Racc[db][4 * q4 + 2], Racc[db][4 * q4 + 3]);
                    *(LAS u32x2*)(RT + (32 * wid + r32) * RT_STRIDE + (32 * db + 8 * q4 + 4 * hi) * 2) = w; }
            if (hi == 0) { ST[((ib * 4 + vq) * 32 + r32) * 2] = s1; ST[((ib * 4 + vq) * 32 + r32) * 2 + 1] = s2; }
            __syncthreads();
            float t1 = 0.f, t2 = 0.f;
#pragma unroll
            for (int q = 0; q < 4; ++q) { t1 += ST[((ib * 4 + q) * 32 + r32) * 2]; t2 += ST[((ib * 4 + q) * 32 + r32) * 2 + 1]; }
            const float mu = t1 * (1.f / 256.f), var = fmaxf(t2 * (1.f / 256.f) - mu * mu, 0.f), rstd = rsqrtf(var + GN_EPS);
            bf16_t* gp = G + (tok0 + 32 * gi + r32) * 2048 + h * 256 + 64 * vq + 4 * hi;
#pragma unroll
            for (int vb = 0; vb < 2; ++vb)
#pragma unroll
                for (int q4 = 0; q4 < 4; ++q4) { const f32x16& y = vb ? y1 : y0; bf16_t* p = gp + 32 * vb + 8 * q4; const u32x2 gw = *(const u32x2*)p;
                    const float g0 = bflo(gw.x), g1 = bfhi(gw.x), g2 = bflo(gw.y), g3 = bfhi(gw.y);
                    u32x2 w; w.x = pk2(silu_f(g0) * (y[4 * q4] - mu) * rstd, silu_f(g1) * (y[4 * q4 + 1] - mu) * rstd); w.y = pk2(silu_f(g2) * (y[4 * q4 + 2] - mu) * rstd, silu_f(g3) * (y[4 * q4 + 3] - mu) * rstd);
                    *(u32x2*)p = w; }
        }
        __syncthreads();
    }
}

__device__ __forceinline__ void mixD_conv(const bf16_t* U, bf16_t* UC, const float* cw, const float* cb) {
    const int gt = blockIdx.x * 512 + opaque_tid(), NT = gridDim.x * 512;
    for (int idx = gt; idx < MTOK * 128; idx += NT) { const int row = idx >> 7, c0 = (idx & 127) * 8, s = row & 2047;
        float acc[8];
#pragma unroll
        for (int e = 0; e < 8; ++e) acc[e] = cb[c0 + e];
#pragma unroll
        for (int w = 0; w < 4; ++w) { if (s - 3 + w >= 0) { const u32x4 uw = *(const u32x4*)(U + (size_t)(row - 3 + w) * 1024 + c0);
                const float uv[8] = {bflo(uw.x), bfhi(uw.x), bflo(uw.y), bfhi(uw.y), bflo(uw.z), bfhi(uw.z), bflo(uw.w), bfhi(uw.w)};
#pragma unroll
                for (int e = 0; e < 8; ++e) acc[e] += cw[w * 1024 + c0 + e] * uv[e]; } }
        u32x4 o; o.x = pk2(acc[0], acc[1]); o.y = pk2(acc[2], acc[3]); o.z = pk2(acc[4], acc[5]); o.w = pk2(acc[6], acc[7]);
        *(u32x4*)(UC + (size_t)row * 1024 + c0) = o; }
}
__device__ __forceinline__ void mixD_scan(LAS unsigned char* lds, const float* LA, const bf16_t* GU, bf16_t* GG) {
    const int tid = opaque_tid(), lane = tid & 63, wid = __builtin_amdgcn_readfirstlane(tid >> 6);
    LAS float* CP = (LAS float*)(lds + LDS_X_OFF); LAS float* CH = CP + 512;
    for (int unit = blockIdx.x; unit < 256; unit += gridDim.x) {
        const int b = unit >> 4, ch = (unit & 15) * 64 + lane;
        const size_t base = ((size_t)b * 2048 + 256 * wid) * 1024 + ch;
        float P = 1.f, H = 0.f;
#pragma unroll 8
        for (int s = 0; s < 256; ++s) { const float la = LA[base + (size_t)s * 1024]; const float gu = __uint_as_float((unsigned)GU[base + (size_t)s * 1024] << 16);
            const float a = fast_exp2(la * LOG2E), mult = sqrtf(fmaxf(1.f - a * a, 0.f)); H = a * H + mult * gu; P *= a; }
        CP[wid * 64 + lane] = P; CH[wid * 64 + lane] = H;
        __syncthreads();
        float hin = 0.f;
        for (int w = 0; w < wid; ++w) hin = CP[w * 64 + lane] * hin + CH[w * 64 + lane];
        float hcur = hin;
#pragma unroll 8
        for (int s = 0; s < 256; ++s) { const float la = LA[base + (size_t)s * 1024]; const float gu = __uint_as_float((unsigned)GU[base + (size_t)s * 1024] << 16);
            const float a = fast_exp2(la * LOG2E), mult = sqrtf(fmaxf(1.f - a * a, 0.f)); hcur = a * hcur + mult * gu;
            const float gg = __uint_as_float((unsigned)GG[base + (size_t)s * 1024] << 16);
            GG[base + (size_t)s * 1024] = (bf16_t)(pk2(gg * hcur, 0.f) & 0xffff); }
        __syncthreads();
    }
}

constexpr int NWAVES = 8;
#define LDS_BASE() ((LAS unsigned char*)lds_dyn)
extern __shared__ __attribute__((aligned(16))) unsigned char lds_dyn[];
__device__ __forceinline__ const void* ldptr(int i) {
    const unsigned long long v = ((volatile LAS unsigned long long*)(LDS_BASE() + PT_OFF))[i];
    const unsigned lo = __builtin_amdgcn_readfirstlane((unsigned)v), hi = __builtin_amdgcn_readfirstlane((unsigned)(v >> 32));
    return (const void*)(((unsigned long long)hi << 32) | lo);
}
#define INF(i) ((const float*)ldptr(i))
#define WSP() ((unsigned char*)ldptr(29))
#define XOUT() ((float*)ldptr(28))
#define GSZ ((int)gridDim.x)
#define BX ((int)blockIdx.x)
__device__ __forceinline__ void grid_bar() {
    XcdBarrier b; b.bar = (unsigned*)(WSP() + WS_CTL) + 1024; b.x = xb_xcc_id(); b.st = (volatile LAS unsigned*)(LDS_BASE() + MISC_OFF) + 8;
    xcd_barrier(b);
}
#define GRID_BAR() grid_bar()

__device__ __forceinline__ void phase_prologue() {
    LAS unsigned char* lds = LDS_BASE();
    const int tid = opaque_tid(), lane = tid & 63, wave = __builtin_amdgcn_readfirstlane(tid >> 6);
    const int gw = BX * NWAVES + wave, NGW = GSZ * NWAVES;
    unsigned char* ws = WSP();
    const float* norm_g = INF(2);
    LAS float* scr = (LAS float*)(lds + wave * 16384);
    {   const float* ffn_w_in = INF(3); const float* ffn_w_out = INF(4);
        for (int lw = 0; lw < 8; ++lw) {
            const float* g = norm_g + (size_t)((lw >> 1) * 3 + ((lw & 1) ? 2 : 0)) * 1024;
            const float* wi = ffn_w_in + (size_t)lw * 1024 * 5632; const float* wo = ffn_w_out + (size_t)lw * 2816 * 1024;
            prep_matrix((bf16_t*)(ws + W_FUP + lw * SZ_FUP), 5632, 1024, [=](int n, int k) { const int p = n & 255, col = (p >> 7) * 2816 + (n >> 8) * 128 + (p & 127); return g[k] * wi[(size_t)k * 5632 + col]; }, scr, gw, NGW, lane);
            prep_matrix((bf16_t*)(ws + W_FDN + lw * SZ_FDN), 1024, 2816, [=](int n, int k) { return wo[(size_t)k * 1024 + n]; }, scr, gw, NGW, lane);
        } }
    {
        const float* g = norm_g + (size_t)(0 * 3 + 1) * 1024; const float* w = INF(5); const float* wo = INF(8);
        prep_matrix((bf16_t*)(ws + W_AQK), 6144, 1024, [=](int n, int k) { const int pn = n >> 8, p = n & 255, bj = p >> 7, wc = (p >> 5) & 3, dd = p & 31, isk = pn >= 12 ? 1 : 0;
            const int col = isk * 3072 + (((pn - 12 * isk) * 4 + wc) * 64) + dd + 32 * bj; return g[k] * w[(size_t)k * 9216 + col]; }, scr, gw, NGW, lane);
        prep_matrix((bf16_t*)(ws + W_AV), 3072, 1024, [=](int n, int k) { return g[k] * w[(size_t)k * 9216 + 6144 + n]; }, scr, gw, NGW, lane);
        prep_matrix((bf16_t*)(ws + W_AO), 1024, 1024, [=](int n, int k) { return wo[(size_t)k * 1024 + n]; }, scr, gw, NGW, lane);
    }
    {
        const float* g = norm_g + (size_t)(1 * 3 + 1) * 1024; const float* w = INF(9); const float* qag = INF(10); const float* wq = INF(11);
        const float* kvg = INF(12); const float* wkv = INF(13); const float* wo = INF(16);
        prep_matrix((bf16_t*)(ws + W_BIN), 768, 1024, [=](int n, int k) { return n < 672 ? g[k] * w[(size_t)k * 672 + n] : 0.f; }, scr, gw, NGW, lane);
        prep_matrix((bf16_t*)(ws + W_BQ), 1536, 384, [=](int n, int k) { return qag[k] * wq[(size_t)k * 1536 + n]; }, scr, gw, NGW, lane);
        prep_matrix((bf16_t*)(ws + W_BK), 1024, 256, [=](int n, int k) { const int pn = n >> 8, p = n & 255, bj = p >> 7, wc = (p >> 5) & 3, dd = p & 31;
            return kvg[k] * wkv[(size_t)k * 2048 + (pn * 4 + wc) * 128 + dd + 32 * bj]; }, scr, gw, NGW, lane);
        prep_matrix((bf16_t*)(ws + W_BV), 1024, 256, [=](int n, int k) { return kvg[k] * wkv[(size_t)k * 2048 + (n >> 6) * 128 + 64 + (n & 63)]; }, scr, gw, NGW, lane);
        prep_matrix((bf16_t*)(ws + W_BO), 1024, 1024, [=](int n, int k) { return wo[(size_t)k * 1024 + n]; }, scr, gw, NGW, lane);
    }
    {
        const float* g = norm_g + (size_t)(2 * 3 + 1) * 1024; const float* w = INF(17); const float* wo = INF(18);
        prep_matrix((bf16_t*)(ws + W_CIN), 4096, 1024, [=](int n, int k) { const int pn = n >> 8, p = n & 255; int col;
            if (pn >= 8) col = 4096 + (n - 2048);
            else { const int bj = p >> 7, wc = (p >> 5) & 3, dd = p & 31, isk = pn >> 2, hd = (pn & 3) * 2 + (wc >> 1); col = isk * 1024 + hd * 128 + 32 * (wc & 1) + dd + 64 * bj; }
            return g[k] * w[(size_t)k * 6144 + col]; }, scr, gw, NGW, lane);
        prep_matrix((bf16_t*)(ws + W_CV), 2048, 1024, [=](int n, int k) { return g[k] * w[(size_t)k * 6144 + 2048 + n]; }, scr, gw, NGW, lane);
        prep_matrix((bf16_t*)(ws + W_CO), 1024, 2048, [=](int n, int k) { return wo[(size_t)k * 1024 + n]; }, scr, gw, NGW, lane);
    }
    {
        const float* g = norm_g + (size_t)(3 * 3 + 1) * 1024; const float* w = INF(19); const float* wrg = INF(22); const float* wig = INF(24); const float* wo = INF(27);
        prep_matrix((bf16_t*)(ws + W_DIN), 2048, 1024, [=](int n, int k) { return g[k] * w[(size_t)k * 2048 + n]; }, scr, gw, NGW, lane);
        prep_matrix((bf16_t*)(ws + W_DG), 2048, 256, [=](int n, int k) { const int pn = n >> 8, p = n & 255, bj = p >> 7, chn = pn * 128 + (p & 127), blk = chn >> 8, d = chn & 255;
            const float* src = bj ? wig : wrg; return src[((size_t)blk * 256 + k) * 256 + d]; }, scr, gw, NGW, lane);
        prep_matrix((bf16_t*)(ws + W_DO), 1024, 1024, [=](int n, int k) { return wo[(size_t)k * 1024 + n]; }, scr, gw, NGW, lane);
    }
    {
        const float* x_in = INF(0); bf16_t* XB = (bf16_t*)(ws + WS_XB); float* SS = (float*)(ws + WS_SS);
        for (int m = gw; m < MTOK; m += NGW) { const f32x4* xr = (const f32x4*)(x_in + (size_t)m * DM) + lane; float s = 0.f;
            unsigned long long* o8 = (unsigned long long*)(XB + (size_t)m * DM) + lane;
#pragma unroll
            for (int j = 0; j < 4; ++j) { const f32x4 v = xr[64 * j]; s += (v.x * v.x + v.y * v.y) + (v.z * v.z + v.w * v.w); o8[64 * j] = (unsigned long long)pk2(v.x, v.y) | ((unsigned long long)pk2(v.z, v.w) << 32); }
            s = wave_sum(s);
            if (lane < 16) SS[(size_t)m * 16 + lane] = (lane == 0) ? s : 0.f; } }
    {
        const int* positions = (const int*)ldptr(1);
        float* TAc = (float*)(ws + WS_TA); float* TAs = TAc + (size_t)MTOK * 32;
        float* TBc = (float*)(ws + WS_TB); float* TBs = TBc + (size_t)MTOK * 16;
        float* TCc = (float*)(ws + WS_TC); float* TCs = TCc + (size_t)MTOK * 64;
        for (int idx = BX * 512 + tid; idx < MTOK * 64; idx += GSZ * 512) { const int row = idx >> 6, i = idx & 63; const float pos = (float)positions[row];
            { const float inv = exp2f(-(float)i * (13.287712379549449f / 64.f)); const float a = pos * inv; TCc[(size_t)row * 64 + i] = cosf(a); TCs[(size_t)row * 64 + i] = sinf(a); }
            if (i < 32) { const float inv = exp2f(-(float)i * (13.287712379549449f / 32.f)); const float a = pos * inv; TAc[(size_t)row * 32 + i] = cosf(a); TAs[(size_t)row * 32 + i] = sinf(a); }
            if (i < 16) { const float inv = exp2f(-(float)i * (13.287712379549449f / 16.f)); const float a = pos * inv; TBc[(size_t)row * 16 + i] = cosf(a); TBs[(size_t)row * 16 + i] = sinf(a); } } }
}

__device__ __forceinline__ void phase_ffn(int lw, bool from_input) {
    {   unsigned char* ws = WSP();
        pg8::Prob g = pg8::make_prob(ws + WS_XB, 1024, ws + W_FUP + (size_t)lw * SZ_FUP, 1024, 1024); pg8::StaticOrder SO; SO.init(MTOK / 256, 22, GSZ, BX);
        EpiSwiGLU E{(bf16_t*)(ws + WS_R), (const float*)(ws + WS_SS)};
        pg8::gemm_phase<EpiSwiGLU, true, true>(LDS_BASE(), g, SO, E); }
    GRID_BAR();
    {   unsigned char* ws = WSP(); float* X = XOUT();
        pg8::Prob g = pg8::make_prob(ws + WS_R, DFF, ws + W_FDN + (size_t)lw * SZ_FDN, DFF, DFF); pg8::StaticOrder SO; SO.init(MTOK / 256, 4, GSZ, BX);
        EpiRes E{from_input ? INF(0) : (const float*)X, X, (bf16_t*)(ws + WS_XB), (float*)(ws + WS_SS), 0.5f};
        pg8::gemm_phase<EpiRes, true, true>(LDS_BASE(), g, SO, E); }
    GRID_BAR();
}
__device__ __forceinline__ void phase_outproj(size_t a_off, int Kdim, size_t w_off) {
    {   unsigned char* ws = WSP(); float* X = XOUT();
        pg8::Prob g = pg8::make_prob(ws + a_off, Kdim, ws + w_off, Kdim, Kdim); pg8::StaticOrder SO; SO.init(MTOK / 256, 4, GSZ, BX);
        EpiRes E{X, X, (bf16_t*)(ws + WS_XB), (float*)(ws + WS_SS), 1.0f};
        pg8::gemm_phase<EpiRes, true, true>(LDS_BASE(), g, SO, E); }
    GRID_BAR();
}

#ifndef TS
#define TS 0
#endif
#define SUBOK(n) (TS == 0 || TS == (n))
__device__ __forceinline__ void phase_mixA() {
    for (int half = 0; half < 2; ++half) {
        const int rowbase = half * 16384;
        if (SUBOK(1)) {   unsigned char* ws = WSP();
            pg8::Prob g = pg8::make_prob(ws + WS_XB + (size_t)rowbase * 2048, 1024, ws + W_AQK, 1024, 1024); pg8::StaticOrder SO; SO.init(64, 24, GSZ, BX);
            EpiAQK E{(bf16_t*)(ws + RA_Q), (bf16_t*)(ws + RA_K), (const float*)(ws + WS_SS), INF(6), INF(7), (const float*)(ws + WS_TA), (const float*)(ws + WS_TA) + (size_t)MTOK * 32, rowbase};
            pg8::gemm_phase<EpiAQK, true, true>(LDS_BASE(), g, SO, E); }
        if (SUBOK(2)) for (int gI = 0; gI < 3; ++gI) {
            unsigned char* ws = WSP();
            const int dsh = 2 * gI, dil = 1 << dsh;
            pg8::Prob g = pg8::make_prob(ws + W_AV + (size_t)gI * 1024 * 1024 * 2, 1024, ws + WS_XB + (size_t)rowbase * 2048, dil * 1024, 1024);
            g.mode = 1; g.dsh = dsh; g.hsB = (dsh == 4) ? (long)1024 * 2 : (long)128 * dil * 1024 * 2;
            pg8::StaticOrder SO; SO.init(4, 64, GSZ, BX);
            EpiVT E{(bf16_t*)(ws + RA_V) + (size_t)gI * 1024 * 16384, (size_t)16384, (const float*)(ws + WS_SS), 16, 0, 16, 1024.f, 1, dsh, rowbase};
            pg8::gemm_phase<EpiVT, true, true>(LDS_BASE(), g, SO, E);
        }
        GRID_BAR();
        if (SUBOK(3)) {   unsigned char* ws = WSP(); const float* gq = INF(6); const float* gk = INF(7); const int lane = opaque_tid() & 63;
            const float shift = 11.541560327111707f * wave_max(fabsf(gq[lane])) * wave_max(fabsf(gk[lane]));
            mixA_attn(LDS_BASE(), (const bf16_t*)(ws + RA_Q), (const bf16_t*)(ws + RA_K), (const bf16_t*)(ws + RA_V), (bf16_t*)(ws + RA_O), half, shift); }
        GRID_BAR();
    }
    phase_outproj(RA_O, 1024, W_AO);
}

__device__ __forceinline__ void phase_mixB() {
    if (SUBOK(1)) {   unsigned char* ws = WSP();
        pg8::Prob g = pg8::make_prob(ws + WS_XB, 1024, ws + W_BIN, 1024, 1024); pg8::StaticOrder SO; SO.init(MTOK / 256, 3, GSZ, BX);
        EpiBIn E{(bf16_t*)(ws + RB_CQ), (bf16_t*)(ws + RB_CKV), (float*)(ws + RB_KR), (float*)(ws + RB_SS), (const float*)(ws + WS_SS)};
        pg8::gemm_phase<EpiBIn, true, true>(LDS_BASE(), g, SO, E); }
    GRID_BAR();
    if (SUBOK(2)) {   unsigned char* ws = WSP();
        pg8::Prob g = pg8::make_prob(ws + RB_CQ, 384, ws + W_BQ, 384, 384); pg8::StaticOrder SO; SO.init(MTOK / 256, 6, GSZ, BX);
        EpiRowScale E{(bf16_t*)(ws + RB_QR), 1536, (bf16_t*)(ws + RB_QR), 1536, 1 << 30, (const float*)(ws + RB_SS), 32, 0, 12, 384.f, 0};
        pg8::gemm_phase<EpiRowScale, true, true>(LDS_BASE(), g, SO, E); }
    if (SUBOK(3)) {   unsigned char* ws = WSP();
        pg8::Prob g = pg8::make_prob(ws + RB_CKV, 256, ws + W_BK, 256, 256); pg8::StaticOrder SO; SO.init(MTOK / 256, 4, GSZ, BX);
        EpiBK E{(bf16_t*)(ws + RB_KB), (const float*)(ws + RB_SS), (const float*)(ws + RB_KR), INF(15), (const float*)(ws + WS_TB), (const float*)(ws + WS_TB) + (size_t)MTOK * 16};
        pg8::gemm_phase<EpiBK, true, true>(LDS_BASE(), g, SO, E); }
    if (SUBOK(4)) {   unsigned char* ws = WSP();
        pg8::Prob g = pg8::make_prob(ws + W_BV, 256, ws + RB_CKV, 256, 256); pg8::StaticOrder SO; SO.init(4, MTOK / 256, GSZ, BX);
        EpiVT E{(bf16_t*)(ws + RB_VT), (size_t)MTOK, (const float*)(ws + RB_SS), 32, 12, 8, 256.f, 0, 0, 0};
        pg8::gemm_phase<EpiVT, true, true>(LDS_BASE(), g, SO, E); }
    GRID_BAR();
    if (SUBOK(5)) {   unsigned char* ws = WSP(); const float* gq = INF(14); const float* gk = INF(15); const int lane = opaque_tid() & 63;
        const float mq = wave_max(fmaxf(fabsf(gq[lane]), fabsf(gq[64 + (lane & 31)]))), mk = wave_max(fmaxf(fabsf(gk[lane]), fabsf(gk[64 + (lane & 31)])));
        const float shift = 14.134834215227234f * mq * mk;
        mixB_attn((const bf16_t*)(ws + RB_QR), (const bf16_t*)(ws + RB_KB), (const bf16_t*)(ws + RB_VT), (bf16_t*)(ws + RB_O), gq, (const float*)(ws + WS_TB), (const float*)(ws + WS_TB) + (size_t)MTOK * 16, shift); }
    GRID_BAR();
    phase_outproj(RB_O, 1024, W_BO);
}

__device__ __forceinline__ void phase_mixC() {
    if (SUBOK(1)) {   unsigned char* ws = WSP();
        pg8::Prob g = pg8::make_prob(ws + WS_XB, 1024, ws + W_CIN, 1024, 1024); pg8::StaticOrder SO; SO.init(MTOK / 256, 16, GSZ, BX);
        EpiCIn E{(bf16_t*)(ws + RC_Q), (bf16_t*)(ws + RC_K), (bf16_t*)(ws + RC_G), (const float*)(ws + WS_SS), (const float*)(ws + WS_TC), (const float*)(ws + WS_TC) + (size_t)MTOK * 64};
        pg8::gemm_phase<EpiCIn, true, true>(LDS_BASE(), g, SO, E); }
    if (SUBOK(2)) {   unsigned char* ws = WSP();
        pg8::Prob g = pg8::make_prob(ws + W_CV, 1024, ws + WS_XB, 1024, 1024); pg8::StaticOrder SO; SO.init(8, MTOK / 256, GSZ, BX);
        EpiVT E{(bf16_t*)(ws + RC_VT), (size_t)MTOK, (const float*)(ws + WS_SS), 16, 0, 16, 1024.f, 0, 0, 0};
        pg8::gemm_phase<EpiVT, true, true>(LDS_BASE(), g, SO, E); }
    GRID_BAR();
    if (SUBOK(3)) {   unsigned char* ws = WSP();
        mixC_retention(LDS_BASE(), (const bf16_t*)(ws + RC_Q), (const bf16_t*)(ws + RC_K), (const bf16_t*)(ws + RC_VT), (bf16_t*)(ws + RC_G)); }
    GRID_BAR();
    phase_outproj(RC_G, 2048, W_CO);
}

__device__ __forceinline__ void phase_mixD() {
    {   unsigned char* ws = WSP();
        pg8::Prob g = pg8::make_prob(ws + WS_XB, 1024, ws + W_DIN, 1024, 1024); pg8::StaticOrder SO; SO.init(MTOK / 256, 8, GSZ, BX);
        EpiRowScale E{(bf16_t*)(ws + RD_GG), 1024, (bf16_t*)(ws + RD_U), 1024, 1024, (const float*)(ws + WS_SS), 16, 0, 16, 1024.f, 1};
        pg8::gemm_phase<EpiRowScale, true, true>(LDS_BASE(), g, SO, E); }
    GRID_BAR();
    {   unsigned char* ws = WSP(); mixD_conv((const bf16_t*)(ws + RD_U), (bf16_t*)(ws + RD_UC), INF(20), INF(21)); }
    GRID_BAR();
    {   unsigned char* ws = WSP();
        pg8::Prob g = pg8::make_prob(ws + RD_UC, 1024, ws + W_DG, 256, 256); g.mode = 2; pg8::StaticOrder SO; SO.init(MTOK / 256, 8, GSZ, BX);
        EpiDGate E{(float*)(ws + RD_LA), (bf16_t*)(ws + RD_GU), (const bf16_t*)(ws + RD_UC), INF(23), INF(25), INF(26)};
        pg8::gemm_phase<EpiDGate, true, true>(LDS_BASE(), g, SO, E); }
    GRID_BAR();
    {   unsigned char* ws = WSP(); mixD_scan(LDS_BASE(), (const float*)(ws + RD_LA), (const bf16_t*)(ws + RD_GU), (bf16_t*)(ws + RD_GG)); }
    GRID_BAR();
    phase_outproj(RD_GG, 1024, W_DO);
}

__global__ void __launch_bounds__(NWAVES * 64, 2) fwd_kernel(Args args) {
    {
        LAS unsigned char* lds = LDS_BASE();
        const int tid = threadIdx.x;
        for (int u = tid; u < (LDS_BYTES - MISC_OFF) / 4; u += NWAVES * 64) ((LAS unsigned*)(lds + MISC_OFF))[u] = 0u;
        __syncthreads();
        const unsigned long long* ka = (const unsigned long long*)__builtin_amdgcn_kernarg_segment_ptr();
        if (tid < 30) ((LAS unsigned long long*)(lds + PT_OFF))[tid] = ka[tid];
        __syncthreads();
        (void)xcd_barrier_post((unsigned*)(WSP() + WS_CTL) + 1024, (volatile LAS unsigned*)(lds + MISC_OFF) + 8);
    }
#ifndef TP
#define TP 0
#endif
    if (TP == 0 || TP == 1) { phase_prologue(); GRID_BAR(); }
    if (TP == 0 || TP == 2) phase_ffn(0, true);
    if (TP == 0 || TP == 3) phase_mixA();
    if (TP == 0) { phase_ffn(1, false); phase_ffn(2, false); }
    if (TP == 0 || TP == 4) phase_mixB();
    if (TP == 0) { phase_ffn(3, false); phase_ffn(4, false); }
    if (TP == 0 || TP == 5) phase_mixC();
    if (TP == 0) { phase_ffn(5, false); phase_ffn(6, false); }
    if (TP == 0 || TP == 6) phase_mixD();
    if (TP == 0) phase_ffn(7, false);
}

extern "C" void kernel_launch(void* const* d_in, const int* in_sizes, int n_in, void* d_out, int out_size, void* d_ws, size_t ws_size, hipStream_t stream) {
    static int grid = 0;
    if (grid == 0) {
        if (n_in != 28 || out_size != MTOK * DM || ws_size < WS_NEED) { fprintf(stderr, "kernel_launch: unexpected shapes: n_in %d out %d ws %zu (need %zu)\n", n_in, out_size, ws_size, (size_t)WS_NEED); grid = -1; return; }
        int dev = 0, cus = 0, per_cu = 0;
        if (hipGetDevice(&dev) != hipSuccess || hipDeviceGetAttribute(&cus, hipDeviceAttributeMultiprocessorCount, dev) != hipSuccess) { grid = -1; return; }
        if (hipFuncSetAttribute((const void*)fwd_kernel, hipFuncAttributeMaxDynamicSharedMemorySize, LDS_BYTES) != hipSuccess) { fprintf(stderr, "kernel_launch: hipFuncSetAttribute failed\n"); grid = -1; return; }
        if (hipOccupancyMaxActiveBlocksPerMultiprocessor(&per_cu, (const void*)fwd_kernel, NWAVES * 64, LDS_BYTES) != hipSuccess || per_cu < 1) fprintf(stderr, "kernel_launch: occupancy query says %d\n", per_cu);
        (void)hipGetLastError();
        grid = cus;
    }
    if (grid < 0) return;
    (void)hipMemsetAsync((char*)d_ws + WS_CTL, 0, CTL_ZERO_BYTES, stream);
    Args a{};
    for (int i = 0; i < 28; ++i) a.in[i] = d_in[i];
    a.out = (float*)d_out; a.ws = (unsigned char*)d_ws;
    hipLaunchKernelGGL(fwd_kernel, dim3(grid), dim3(NWAVES * 64), LDS_BYTES, stream, a);
    const hipError_t le = hipPeekAtLastError();
    if (le != hipSuccess) fprintf(stderr, "kernel_launch: launch failed: %s\n", hipGetErrorName(le));
}
```

```cpp
#include <hip/hip_runtime.h>
#include <cstdio>
#include <cstdint>
#include <cmath>

#define LAS __attribute__((address_space(3)))
#define GAS __attribute__((address_space(1)))
typedef unsigned short bf16_t;
typedef short bf16x8 __attribute__((ext_vector_type(8)));
typedef float f32x4 __attribute__((ext_vector_type(4)));
typedef float f32x16 __attribute__((ext_vector_type(16)));
typedef unsigned u32x4 __attribute__((ext_vector_type(4)));
typedef unsigned u32x2 __attribute__((ext_vector_type(2)));
typedef float f32x2_t __attribute__((ext_vector_type(2)));
typedef __bf16 bf16x2_t __attribute__((ext_vector_type(2)));

constexpr int DM = 1024, NB = 16, SEQ = 2048, MTOK = NB * SEQ, DFF = 2816;
constexpr float NORM_EPS = 1e-6f, GN_EPS = 1e-5f;
constexpr float LOG2E = 1.4426950408889634f;

__device__ __forceinline__ unsigned pk2(float lo, float hi) { f32x2_t v = {lo, hi}; bf16x2_t b = __builtin_convertvector(v, bf16x2_t); return __builtin_bit_cast(unsigned, b); }
__device__ __forceinline__ float bflo(unsigned w) { return __uint_as_float(w << 16); }
__device__ __forceinline__ float bfhi(unsigned w) { return __uint_as_float(w & 0xffff0000u); }
__device__ __forceinline__ float fast_exp2(float x) { return __builtin_amdgcn_exp2f(x); }
__device__ __forceinline__ float fast_rcp(float x) { return __builtin_amdgcn_rcpf(x); }
__device__ __forceinline__ float silu_f(float g) { return g * fast_rcp(1.f + fast_exp2(-g * LOG2E)); }
__device__ __forceinline__ float sigmoid_f(float g) { return fast_rcp(1.f + fast_exp2(-g * LOG2E)); }
__device__ __forceinline__ float gelu_tanh_f(float x) {
    const float z = 0.7978845608028654f * (x + 0.044715f * x * x * x);
    const float e = fast_exp2(2.f * LOG2E * z);
    return x * (1.f - fast_rcp(1.f + e));
}
__device__ __forceinline__ float wave_sum(float v) {
#pragma unroll
    for (int o = 1; o < 64; o <<= 1) v += __shfl_xor(v, o);
    return v;
}
__device__ __forceinline__ float wave_max(float v) {
#pragma unroll
    for (int o = 1; o < 64; o <<= 1) v = fmaxf(v, __shfl_xor(v, o));
    return v;
}
__device__ __forceinline__ int opaque_tid() { int t = threadIdx.x; asm volatile("" : "+v"(t)); return t; }
__device__ __forceinline__ void lds_barrier() { asm volatile("s_waitcnt lgkmcnt(0)\n\ts_barrier" ::: "memory"); }
__device__ __forceinline__ int crow(int r, int hi) { return (r & 3) + 8 * (r >> 2) + 4 * hi; }

namespace pg8 {
constexpr int BM = 256, BK = 64, HALF = 128, HTB = HALF * BK * 2, STAGE_BYTES = 8 * HTB, NXCD = 8, WGM = 8;
__host__ __device__ __forceinline__ int lds_byte(int r, int c) { const int st = (r >> 4) * 2 + (c >> 5), rr = r & 15, cc = c & 31, ob = rr * 64 + cc * 2; return st * 1024 + (ob ^ (((ob >> 9) & 1) << 5)); }
__host__ __device__ __forceinline__ void stage_rc(int b, int& R, int& C) { const int st = b / 1024, sb = b % 1024, swz = sb ^ (((sb >> 9) & 1) << 5); R = (st >> 1) * 16 + swz / 64; C = (st & 1) * 32 + (swz % 64) / 2; }
__host__ __device__ __forceinline__ int perm32(int rho) { const int n = rho >> 4, i = rho & 15; return 8 * (i >> 2) + 4 * n + (i & 3); }
struct Unit { int pm, pn; };
struct StaticOrder {
    int nM, nN, nwg, G, c;
    __device__ void init(int nM_, int nN_, int G_, int c_) { nM = nM_; nN = nN_; nwg = nM * nN; G = G_; c = c_; }
    __device__ bool next(int i, Unit& u) const {
        const long L = (long)i * G + c; if (L >= nwg) return false;
        int wgid = (int)L; { const int q = nwg / NXCD, r = nwg % NXCD, xcd = wgid % NXCD, off = wgid / NXCD; wgid = (xcd < r ? xcd * (q + 1) : r * (q + 1) + (xcd - r) * q) + off; }
        const int nig = WGM * nN, gid = wgid / nig, fm = gid * WGM, gsz = (nM - fm) < WGM ? (nM - fm) : WGM;
        u.pm = fm + ((wgid % nig) % gsz); u.pn = (wgid % nig) / gsz; return true;
    }
};
struct Prob {
    const char* A; const char* B; int K, lda, ldb; long hsA, hsB, tsA, tsB; int mode, dsh;
    __device__ __forceinline__ const char* a_ptr(const Unit& u) const { const char* p = A + (long)u.pm * tsA; if (mode == 2) p += (long)(u.pn >> 1) * 512; return p; }
    __device__ __forceinline__ const char* b_ptr(const Unit& u) const {
        if (mode == 1) { const int b = u.pn >> 3, tt = u.pn & 7; int tok0;
            if (dsh == 0) tok0 = 256 * tt; else if (dsh == 2) tok0 = 4 * ((tt & 1) * 256) + (tt >> 1); else tok0 = 2 * tt;
            return B + ((long)b * SEQ + tok0) * (DM * 2); }
        return B + (long)u.pn * tsB; }
};
__device__ __forceinline__ Prob make_prob(const void* A, int lda, const void* B, int ldb, int K) {
    Prob p; p.A = (const char*)A; p.B = (const char*)B; p.K = K; p.lda = lda; p.ldb = ldb; p.hsA = (long)HALF * lda * 2; p.hsB = (long)HALF * ldb * 2; p.tsA = 2 * p.hsA; p.tsB = 2 * p.hsB; p.mode = 0; p.dsh = 0; return p;
}

template <class Epi, bool ALIGN_EPI, bool SP2>
__device__ __forceinline__ void gemm_phase(LAS unsigned char* lds, const Prob g, const StaticOrder& S, const Epi& E) {
    const int tid = opaque_tid(), wid = __builtin_amdgcn_readfirstlane(tid >> 6), lane = tid & 63, wr = wid >> 2, wc = wid & 3, fr = lane & 15, fq = lane >> 4;
    const int K = g.K, nt = K / BK;
    unsigned voffA[2], voffB[2];
#pragma unroll
    for (int i = 0; i < 2; ++i) { int R, C; stage_rc(tid * 16 + i * 8192, R, C); const int Rb = Epi::PERM ? ((R & ~31) + perm32(R & 31)) : R;
        voffA[i] = (unsigned)(R * g.lda + C) * 2u; voffB[i] = (unsigned)(Rb * g.ldb + C) * 2u; }
    const size_t kstep = (size_t)(BK * 2);
    const long hsA = g.hsA, hsB = g.hsB;
    const unsigned ldsw = (unsigned)wid * 1024u;
    const int aoff = lds_byte(wr * 64 + fr, fq * 8), boff = lds_byte(wc * 32 + fr, fq * 8);
#define PG8_SA(b, h) (((b) * 2 + (h)) * HTB)
#define PG8_SB(b, h) ((4 + (b) * 2 + (h)) * HTB)
#define PG8_STAGE(bufoff, gbase, voff) do { _Pragma("unroll") for (int _i = 0; _i < 2; ++_i) \
        __builtin_amdgcn_global_load_lds((const unsigned*)((const char*)(gbase) + (voff)[_i]), (LAS unsigned*)(lds + (bufoff) + ldsw + _i * 8192), 16, 0, 0); } while (0)
#define PG8_LDA(dst, b, h) do { _Pragma("unroll") for (int m = 0; m < 4; ++m) _Pragma("unroll") for (int k = 0; k < 2; ++k) dst[m][k] = *(const LAS bf16x8*)(lds + PG8_SA(b, h) + aoff + m * 2048 + k * 1024); } while (0)
#define PG8_LDB(dst, b, h) do { _Pragma("unroll") for (int n = 0; n < 2; ++n) _Pragma("unroll") for (int k = 0; k < 2; ++k) dst[n][k] = *(const LAS bf16x8*)(lds + PG8_SB(b, h) + boff + n * 2048 + k * 1024); } while (0)
#define PG8_MMA(ai, bj, At, Bt) do { __builtin_amdgcn_s_setprio(1); _Pragma("unroll") for (int m = 0; m < 4; ++m) _Pragma("unroll") for (int n = 0; n < 2; ++n) _Pragma("unroll") for (int k = 0; k < 2; ++k) \
        acc[ai][bj][m][n] = __builtin_amdgcn_mfma_f32_16x16x32_bf16(Bt[n][k], At[m][k], acc[ai][bj][m][n], 0, 0, 0); __builtin_amdgcn_s_setprio(0); } while (0)
#define PG8_WAIT_V(n) asm volatile("s_waitcnt vmcnt(" #n ")" ::: "memory")
#define PG8_WAIT_L(n) asm volatile("s_waitcnt lgkmcnt(" #n ")" ::: "memory")
#define PG8_BAR __builtin_amdgcn_s_barrier()
#define PG8_SCHED __builtin_amdgcn_sched_barrier(0)
    Unit cur, nxt; int ui = 0;
    if (!S.next(0, cur)) return;
    f32x4 acc[2][2][4][2];
#pragma unroll
    for (int a = 0; a < 2; ++a)
#pragma unroll
        for (int b = 0; b < 2; ++b)
#pragma unroll
            for (int m = 0; m < 4; ++m)
#pragma unroll
                for (int n = 0; n < 2; ++n) acc[a][b][m][n] = (f32x4){0.f, 0.f, 0.f, 0.f};
    bf16x8 At[4][2], B0[2][2], B1[2][2];
    const char* cA = g.a_ptr(cur); const char* cB = g.b_ptr(cur);
    if constexpr (SP2) {
        PG8_STAGE(PG8_SB(0, 0), cB, voffB); PG8_STAGE(PG8_SB(0, 1), cB + hsB, voffB); PG8_STAGE(PG8_SA(0, 0), cA, voffA); PG8_STAGE(PG8_SA(0, 1), cA + hsA, voffA);
        if (wr == 1) PG8_BAR;
        PG8_WAIT_V(2); PG8_BAR;
        PG8_STAGE(PG8_SB(1, 0), cB + kstep, voffB); PG8_STAGE(PG8_SA(1, 0), cA + kstep, voffA); PG8_STAGE(PG8_SB(1, 1), cB + hsB + kstep, voffB);
        PG8_WAIT_V(6); PG8_BAR;
    } else {
        PG8_STAGE(PG8_SB(0, 0), cB, voffB); PG8_STAGE(PG8_SA(0, 0), cA, voffA); PG8_STAGE(PG8_SB(0, 1), cB + hsB, voffB); PG8_STAGE(PG8_SA(0, 1), cA + hsA, voffA);
        if (wr == 1) PG8_BAR;
        PG8_WAIT_V(4); PG8_BAR;
        PG8_STAGE(PG8_SB(1, 0), cB + kstep, voffB); PG8_STAGE(PG8_SA(1, 0), cA + kstep, voffA); PG8_STAGE(PG8_SB(1, 1), cB + hsB + kstep, voffB);
        PG8_WAIT_V(6); PG8_BAR;
    }
    for (;;) {
        const bool has_next = S.next(ui + 1, nxt);
        const char* nA = has_next ? g.a_ptr(nxt) : cA; const char* nB = has_next ? g.b_ptr(nxt) : cB;
        for (int t = 0; t < nt; t += 2) {
            const bool last = (t == nt - 2);
            const char* a1 = cA + (size_t)(t + 1) * kstep;
            const char* a2 = last ? nA : cA + (size_t)(t + 2) * kstep; const char* b2 = last ? nB : cB + (size_t)(t + 2) * kstep;
            const char* a3 = a2 + kstep; const char* b3 = b2 + kstep;
            if constexpr (SP2) {
            PG8_LDB(B0, 0, 0); PG8_LDB(B1, 0, 1); PG8_SCHED; PG8_LDA(At, 0, 0); PG8_STAGE(PG8_SA(1, 1), a1 + hsA, voffA);
            PG8_WAIT_V(8); PG8_WAIT_L(0); PG8_BAR; PG8_MMA(0, 0, At, B0); PG8_MMA(0, 1, At, B1); PG8_BAR; PG8_SCHED;
            PG8_LDA(At, 0, 1); PG8_STAGE(PG8_SB(0, 0), b2, voffB); PG8_STAGE(PG8_SB(0, 1), b2 + hsB, voffB); PG8_STAGE(PG8_SA(0, 0), a2, voffA);
            PG8_WAIT_V(8); PG8_WAIT_L(0); PG8_BAR; PG8_MMA(1, 0, At, B0); PG8_MMA(1, 1, At, B1); PG8_BAR; PG8_SCHED;
            PG8_LDB(B0, 1, 0); PG8_LDB(B1, 1, 1); PG8_SCHED; PG8_LDA(At, 1, 0); PG8_STAGE(PG8_SA(0, 1), a2 + hsA, voffA);
            PG8_WAIT_V(8); PG8_WAIT_L(0); PG8_BAR; PG8_MMA(0, 0, At, B0); PG8_MMA(0, 1, At, B1); PG8_BAR; PG8_SCHED;
            PG8_LDA(At, 1, 1); PG8_STAGE(PG8_SB(1, 0), b3, voffB); PG8_STAGE(PG8_SB(1, 1), b3 + hsB, voffB); PG8_STAGE(PG8_SA(1, 0), a3, voffA);
            PG8_WAIT_V(8); PG8_WAIT_L(0); PG8_BAR; PG8_MMA(1, 0, At, B0); PG8_MMA(1, 1, At, B1); PG8_BAR; PG8_SCHED;
            } else {
            PG8_LDB(B0, 0, 0); PG8_SCHED; PG8_LDA(At, 0, 0); PG8_STAGE(PG8_SA(1, 1), a1 + hsA, voffA);
            PG8_WAIT_L(8); PG8_BAR; PG8_WAIT_L(0); PG8_MMA(0, 0, At, B0); PG8_BAR; PG8_SCHED;
            PG8_LDB(B1, 0, 1); PG8_STAGE(PG8_SB(0, 0), b2, voffB);
            PG8_BAR; PG8_WAIT_L(0); PG8_MMA(0, 1, At, B1); PG8_BAR;
            PG8_LDA(At, 0, 1); PG8_STAGE(PG8_SA(0, 0), a2, voffA);
            PG8_BAR; PG8_WAIT_L(0); PG8_MMA(1, 0, At, B0); PG8_BAR; PG8_SCHED;
            PG8_STAGE(PG8_SB(0, 1), b2 + hsB, voffB);
            PG8_WAIT_V(6); PG8_BAR; PG8_MMA(1, 1, At, B1); PG8_BAR;
            PG8_LDB(B0, 1, 0); PG8_SCHED; PG8_LDA(At, 1, 0); PG8_STAGE(PG8_SA(0, 1), a2 + hsA, voffA);
            PG8_WAIT_L(8); PG8_BAR; PG8_WAIT_L(0); PG8_MMA(0, 0, At, B0); PG8_BAR; PG8_SCHED;
            PG8_LDB(B1, 1, 1); PG8_STAGE(PG8_SB(1, 0), b3, voffB);
            PG8_BAR; PG8_WAIT_L(0); PG8_MMA(0, 1, At, B1); PG8_BAR;
            PG8_LDA(At, 1, 1); PG8_STAGE(PG8_SA(1, 0), a3, voffA);
            PG8_BAR; PG8_WAIT_L(0); PG8_MMA(1, 0, At, B0); PG8_BAR; PG8_SCHED;
            PG8_STAGE(PG8_SB(1, 1), b3 + hsB, voffB);
            PG8_WAIT_V(6); PG8_BAR; PG8_MMA(1, 1, At, B1); PG8_BAR;
            }
        }
        if constexpr (ALIGN_EPI) { if (wr == 0) PG8_BAR; }
        E(acc, cur, wr, wc, fr, fq);
        if (!has_next) break;
#pragma unroll
        for (int a = 0; a < 2; ++a)
#pragma unroll
            for (int b = 0; b < 2; ++b)
#pragma unroll
                for (int m = 0; m < 4; ++m)
#pragma unroll
                    for (int n = 0; n < 2; ++n) acc[a][b][m][n] = (f32x4){0.f, 0.f, 0.f, 0.f};
        cur = nxt; cA = nA; cB = nB; ++ui;
        if constexpr (ALIGN_EPI) { if (wr == 1) PG8_BAR; }
    }
    PG8_WAIT_V(0);
    if constexpr (!ALIGN_EPI) { if (wr == 0) PG8_BAR; }
    PG8_BAR;
#undef PG8_SA
#undef PG8_SB
#undef PG8_STAGE
#undef PG8_LDA
#undef PG8_LDB
#undef PG8_MMA
#undef PG8_WAIT_V
#undef PG8_WAIT_L
#undef PG8_BAR
#undef PG8_SCHED
}
}
typedef f32x4 AccT[2][2][4][2];

#define XB_TMO      128
#define XB_XCNT(j)  (256  + 64 * (j))
#define XB_XSUB(j)  (1280 + 64 * (j))
#define XB_XGEN(j)  (2304 + 64 * (j))
#define XB_TOP      3328
#define XB_TOPGEN   3392
#define XCD_BAR_WORDS 3456
#define XB_SPIN_CAP (1u << 18)
__device__ __forceinline__ unsigned xb_ld(unsigned* p)              { return __hip_atomic_load(p, __ATOMIC_RELAXED, __HIP_MEMORY_SCOPE_AGENT); }
__device__ __forceinline__ unsigned xb_add(unsigned* p, unsigned v) { return __hip_atomic_fetch_add(p, v, __ATOMIC_RELAXED, __HIP_MEMORY_SCOPE_AGENT); }
__device__ __forceinline__ unsigned xb_xcc_id() { return (unsigned)__builtin_amdgcn_s_getreg((3 << 11) | 20) & 0xFu; }
#define XB_SPIN(cond, bar) do { unsigned _sp = 0; while (cond) { __builtin_amdgcn_s_sleep(1); \
    if ((++_sp & 255u) == 0u) { if (xb_ld(&(bar)[XB_TMO])) break; if (_sp > XB_SPIN_CAP) { atomicAdd(&(bar)[XB_TMO], 1u); break; } } } } while (0)
struct XcdBarrier { unsigned* bar; unsigned x; volatile LAS unsigned* st; };
__device__ __forceinline__ XcdBarrier xcd_barrier_post(unsigned* bar, volatile LAS unsigned* st) {
    XcdBarrier b; b.bar = bar; b.x = xb_xcc_id(); b.st = st;
    if (threadIdx.x == 0) (void)xb_add(&bar[XB_XCNT(b.x)], 1u);
    return b;
}
__device__ __forceinline__ void xcd_barrier_complete(unsigned* bar, unsigned x, unsigned& nloc, unsigned& nx) {
    const unsigned G = gridDim.x * gridDim.y * gridDim.z;
    unsigned sum, cnt, mine, sp = 0u;
    for (;;) {
        sum = 0u; cnt = 0u; mine = 0u;
#pragma unroll
        for (unsigned j = 0; j < 16; ++j) { const unsigned c = xb_ld(&bar[XB_XCNT(j)]); sum += c; cnt += (c > 0u) ? 1u : 0u; mine = (j == x) ? c : mine; }
        if (sum == G) break;
        __builtin_amdgcn_s_sleep(1);
        if ((++sp & 255u) == 0u) { if (xb_ld(&bar[XB_TMO])) break; if (sp > XB_SPIN_CAP) { atomicAdd(&bar[XB_TMO], 1u); break; } }
    }
    nloc = mine > 0u ? mine : 1u; nx = cnt > 0u ? cnt : 1u;
}
__device__ __forceinline__ void xcd_barrier(const XcdBarrier& b) {
    asm volatile("s_waitcnt vmcnt(0)" ::: "memory");
    __syncthreads();
    if (threadIdx.x == 0) {
        unsigned* bar = b.bar;
        __builtin_amdgcn_s_waitcnt(0);
        unsigned nloc = b.st[0], nx = b.st[1];
        if (nloc == 0u) { xcd_barrier_complete(bar, b.x, nloc, nx); b.st[0] = nloc; b.st[1] = nx; }
        const unsigned old = xb_add(&bar[XB_XSUB(b.x)], 1u);
        const unsigned gen = old / nloc;
        if (old + 1u == (gen + 1u) * nloc) {
            __builtin_amdgcn_fence(__ATOMIC_RELEASE, "agent");
            asm volatile("s_waitcnt vmcnt(0)" ::: "memory");
            const unsigned og = xb_add(&bar[XB_TOP], 1u);
            const unsigned tg = og / nx;
            if (og + 1u == (tg + 1u) * nx) xb_add(&bar[XB_TOPGEN], 1u);
            else XB_SPIN(xb_ld(&bar[XB_TOPGEN]) == tg, bar);
            __builtin_amdgcn_fence(__ATOMIC_ACQUIRE, "agent");
            xb_add(&bar[XB_XGEN(b.x)], 1u);
            asm volatile("s_waitcnt vmcnt(0)" ::: "memory");
        } else {
            XB_SPIN(xb_ld(&bar[XB_XGEN(b.x)]) == gen, bar);
            __builtin_amdgcn_fence(__ATOMIC_ACQUIRE, "agent");
            asm volatile("s_waitcnt vmcnt(0)" ::: "memory");
        }
    }
    __syncthreads();
}

constexpr size_t MiB = 1u << 20;
constexpr size_t WS_CTL = 0, CTL_ZERO_BYTES = 64 * 1024, WS_SPD = 128 * 1024;
constexpr size_t SZ_FUP = (size_t)5632 * 1024 * 2, SZ_FDN = (size_t)1024 * 2816 * 2;
constexpr size_t WS_W = 1 * MiB;
constexpr size_t W_FUP = WS_W;
constexpr size_t W_FDN = W_FUP + 8 * SZ_FUP;
constexpr size_t W_AQK = W_FDN + 8 * SZ_FDN;
constexpr size_t W_AV  = W_AQK + (size_t)6144 * 1024 * 2;
constexpr size_t W_AO  = W_AV + (size_t)3072 * 1024 * 2;
constexpr size_t W_BIN = W_AO + (size_t)1024 * 1024 * 2;
constexpr size_t W_BQ  = W_BIN + (size_t)768 * 1024 * 2;
constexpr size_t W_BK  = W_BQ + (size_t)1536 * 384 * 2;
constexpr size_t W_BV  = W_BK + (size_t)1024 * 256 * 2;
constexpr size_t W_BO  = W_BV + (size_t)1024 * 256 * 2;
constexpr size_t W_CIN = W_BO + (size_t)1024 * 1024 * 2;
constexpr size_t W_CV  = W_CIN + (size_t)4096 * 1024 * 2;
constexpr size_t W_CO  = W_CV + (size_t)2048 * 1024 * 2;
constexpr size_t W_DIN = W_CO + (size_t)1024 * 2048 * 2;
constexpr size_t W_DG  = W_DIN + (size_t)2048 * 1024 * 2;
constexpr size_t W_DO  = W_DG + (size_t)2048 * 256 * 2;
constexpr size_t W_END = W_DO + (size_t)1024 * 1024 * 2;
constexpr size_t WS_XB = ((W_END + MiB - 1) / MiB) * MiB;
constexpr size_t WS_SS = WS_XB + (size_t)MTOK * DM * 2;
constexpr size_t WS_TA = WS_SS + (size_t)MTOK * 16 * 4;
constexpr size_t WS_TB = WS_TA + (size_t)MTOK * 32 * 4 * 2;
constexpr size_t WS_TC = WS_TB + (size_t)MTOK * 16 * 4 * 2;
constexpr size_t WS_R  = WS_TC + (size_t)MTOK * 64 * 4 * 2;
constexpr size_t SZ_AH = (size_t)3 * 8 * 16 * 2048 * 64 * 2;
constexpr size_t RA_Q = WS_R, RA_K = RA_Q + SZ_AH, RA_V = RA_K + SZ_AH, RA_O = RA_V + SZ_AH, RA_END = RA_O + (size_t)MTOK * DM * 2;
constexpr size_t RB_CQ = WS_R, RB_CKV = RB_CQ + (size_t)MTOK * 384 * 2, RB_KR = RB_CKV + (size_t)MTOK * 256 * 2, RB_SS = RB_KR + (size_t)MTOK * 32 * 4,
                 RB_QR = RB_SS + (size_t)MTOK * 32 * 4, RB_KB = RB_QR + (size_t)MTOK * 1536 * 2, RB_VT = RB_KB + (size_t)MTOK * 1536 * 2, RB_O = RB_VT + (size_t)MTOK * 1024 * 2, RB_END = RB_O + (size_t)MTOK * 1024 * 2;
constexpr size_t RC_Q = WS_R, RC_K = RC_Q + (size_t)MTOK * 1024 * 2, RC_G = RC_K + (size_t)MTOK * 1024 * 2, RC_VT = RC_G + (size_t)MTOK * 2048 * 2, RC_END = RC_VT + (size_t)MTOK * 2048 * 2;
constexpr size_t RD_GG = WS_R, RD_U = RD_GG + (size_t)MTOK * 1024 * 2, RD_UC = RD_U + (size_t)MTOK * 1024 * 2, RD_LA = RD_UC + (size_t)MTOK * 1024 * 2, RD_GU = RD_LA + (size_t)MTOK * 1024 * 4, RD_END = RD_GU + (size_t)MTOK * 1024 * 2;
constexpr size_t WS_NEED = RC_END > RA_END ? (RC_END > RB_END ? RC_END : RB_END) : (RA_END > RB_END ? RA_END : RB_END);
static_assert(RD_END <= WS_NEED && WS_R + (size_t)MTOK * DFF * 2 <= WS_NEED, "ws map");
static_assert(WS_NEED <= (size_t)738197504, "workspace must fit 4x the largest input");

constexpr int RING_BYTES = 131072, LDS_X_OFF = RING_BYTES, LDS_X_BYTES = 8192, MISC_OFF = LDS_X_OFF + LDS_X_BYTES, PT_OFF = MISC_OFF + 256, LDS_BYTES = 147456;

struct Args { const void* in[28]; float* out; unsigned char* ws; };

extern __shared__ __attribute__((aligned(16))) unsigned char lds_dyn[];
#define LDS_BASE() ((LAS unsigned char*)lds_dyn)
__device__ __forceinline__ float sum16(const float* p) {
    const f32x4 a = ((const GAS f32x4*)p)[0], b = ((const GAS f32x4*)p)[1], c = ((const GAS f32x4*)p)[2], d = ((const GAS f32x4*)p)[3];
    return ((a.x + a.y) + (a.z + a.w)) + ((b.x + b.y) + (b.z + b.w)) + ((c.x + c.y) + (c.z + c.w)) + ((d.x + d.y) + (d.z + d.w));
}
__device__ __forceinline__ float sum8(const float* p) {
    const f32x4 a = ((const GAS f32x4*)p)[0], b = ((const GAS f32x4*)p)[1];
    return ((a.x + a.y) + (a.z + a.w)) + ((b.x + b.y) + (b.z + b.w));
}
__device__ __forceinline__ float rs_of(const f32x4 s) { return rsqrtf(((s.x + s.y) + (s.z + s.w)) * (1.f / 1024.f) + NORM_EPS); }
__device__ __forceinline__ float row_rs(const float* SS, int row) { return rs_of(*(const GAS f32x4*)(SS + (size_t)row * 4)); }

struct EpiSwiGLU { static constexpr bool PERM = true;
    bf16_t* H; const float* SS;
    __device__ __forceinline__ void operator()(const AccT& acc, const pg8::Unit& u, int wr, int wc, int fr, int fq) const {
        const int row0 = u.pm * 256 + wr * 64 + fr, hcol = u.pn * 128 + wc * 32 + 8 * fq;
        f32x4 ssv[2][4];
#pragma unroll
        for (int ai = 0; ai < 2; ++ai)
#pragma unroll
            for (int m = 0; m < 4; ++m) ssv[ai][m] = *(const GAS f32x4*)(SS + (size_t)(row0 + ai * 128 + m * 16) * 4);
#pragma unroll
        for (int ai = 0; ai < 2; ++ai)
#pragma unroll
            for (int m = 0; m < 4; ++m) { const int row = row0 + ai * 128 + m * 16; const float rs = rs_of(ssv[ai][m]);
                float h[8];
#pragma unroll
                for (int n = 0; n < 2; ++n)
#pragma unroll
                    for (int j = 0; j < 4; ++j) { const float g = acc[ai][0][m][n][j] * rs, up = acc[ai][1][m][n][j] * rs; h[4 * n + j] = silu_f(g) * up; }
                u32x4 w; w.x = pk2(h[0], h[1]); w.y = pk2(h[2], h[3]); w.z = pk2(h[4], h[5]); w.w = pk2(h[6], h[7]);
                *(GAS u32x4*)(H + (size_t)row * DFF + hcol) = w; }
    }
};
struct EpiRes { static constexpr bool PERM = true;
    const float* base32; float* out32; bf16_t* XB; float* SS; float alpha;
    __device__ __forceinline__ void operator()(const AccT& acc, const pg8::Unit& u, int wr, int wc, int fr, int fq) const {
        const int row0 = u.pm * 256 + wr * 64 + fr, col0 = u.pn * 256 + wc * 32 + 8 * fq;
        LAS float* P = (LAS float*)(LDS_BASE() + LDS_X_OFF);
#pragma unroll
        for (int ai = 0; ai < 2; ++ai) {
            u32x4 xw[4][2];
            if (!base32) {
#pragma unroll
                for (int m = 0; m < 4; ++m)
#pragma unroll
                    for (int bj = 0; bj < 2; ++bj) xw[m][bj] = *(const GAS u32x4*)(XB + (size_t)(row0 + ai * 128 + m * 16) * DM + col0 + bj * 128);
            }
#pragma unroll
            for (int m = 0; m < 4; ++m) { const int row = row0 + ai * 128 + m * 16; float ssq = 0.f;
#pragma unroll
                for (int bj = 0; bj < 2; ++bj) { const size_t off = (size_t)row * DM + col0 + bj * 128;
                    f32x4 b0, b1;
                    if (base32) { b0 = *(const GAS f32x4*)(base32 + off); b1 = *(const GAS f32x4*)(base32 + off + 4); }
                    else { const u32x4 x_ = xw[m][bj]; b0 = (f32x4){bflo(x_.x), bfhi(x_.x), bflo(x_.y), bfhi(x_.y)}; b1 = (f32x4){bflo(x_.z), bfhi(x_.z), bflo(x_.w), bfhi(x_.w)}; }
                    const f32x4 x0 = b0 + acc[ai][bj][m][0] * alpha, x1 = b1 + acc[ai][bj][m][1] * alpha;
                    if (out32) { *(GAS f32x4*)(out32 + off) = x0; *(GAS f32x4*)(out32 + off + 4) = x1; }
                    ssq += (x0.x * x0.x + x0.y * x0.y) + (x0.z * x0.z + x0.w * x0.w) + (x1.x * x1.x + x1.y * x1.y) + (x1.z * x1.z + x1.w * x1.w);
                    u32x4 w; w.x = pk2(x0.x, x0.y); w.y = pk2(x0.z, x0.w); w.z = pk2(x1.x, x1.y); w.w = pk2(x1.z, x1.w);
                    *(GAS u32x4*)(XB + off) = w; }
                ssq += __shfl_xor(ssq, 16); ssq += __shfl_xor(ssq, 32);
                if (fq == 0) P[(ai * 128 + wr * 64 + m * 16 + fr) * 4 + wc] = ssq; }
        }
        lds_barrier();
        if (wc == 0 && fq == 0) {
#pragma unroll
            for (int ai = 0; ai < 2; ++ai)
#pragma unroll
                for (int m = 0; m < 4; ++m) { const int rl = ai * 128 + wr * 64 + m * 16 + fr; const f32x4 s = *(const LAS f32x4*)(P + rl * 4);
                    ((GAS float*)SS)[(size_t)(u.pm * 256 + rl) * 4 + u.pn] = (s.x + s.y) + (s.z + s.w); }
        }
    }
};
__device__ __forceinline__ void rope4(float pos, const f32x4 inv, f32x4& c, f32x4& s) {
#pragma unroll
    for (int j = 0; j < 4; ++j) { const float rv = (pos * inv[j]) * 0.15915494309189535f; const float fr = rv - floorf(rv); c[j] = __builtin_amdgcn_cosf(fr); s[j] = __builtin_amdgcn_sinf(fr); }
}
struct EpiAQK { static constexpr bool PERM = false;
    bf16_t* Q; bf16_t* Kb; const float* SS; const float* gq; const float* gk; const int* pos; int rowbase;
    __device__ __forceinline__ void operator()(const AccT& acc, const pg8::Unit& u, int wr, int wc, int fr, int fq) const {
        const int isk = u.pn >= 12 ? 1 : 0, hh = (u.pn - 12 * isk) * 4 + wc, g = hh >> 4, h = hh & 15, dsh = 2 * g;
        bf16_t* dst = isk ? Kb : Q; const float* gain = isk ? gk : gq; const float osc = isk ? 1.f : 0.125f * LOG2E;
        f32x4 ga[2][2], inv[2];
#pragma unroll
        for (int bj = 0; bj < 2; ++bj)
#pragma unroll
            for (int n = 0; n < 2; ++n) ga[bj][n] = *(const GAS f32x4*)(gain + 32 * bj + 16 * n + 4 * fq);
#pragma unroll
        for (int n = 0; n < 2; ++n)
#pragma unroll
            for (int j = 0; j < 4; ++j) inv[n][j] = exp2f(-(float)(16 * n + 4 * fq + j) * (13.287712379549449f / 32.f));
        f32x4 ssv[2][4]; float pv[2][4];
#pragma unroll
        for (int ai = 0; ai < 2; ++ai)
#pragma unroll
            for (int m = 0; m < 4; ++m) { const int row = rowbase + u.pm * 256 + ai * 128 + wr * 64 + m * 16 + fr; ssv[ai][m] = *(const GAS f32x4*)(SS + (size_t)row * 4); pv[ai][m] = (float)((const GAS int*)pos)[row]; }
#pragma unroll
        for (int ai = 0; ai < 2; ++ai)
#pragma unroll
            for (int m = 0; m < 4; ++m) { const int rl = u.pm * 256 + ai * 128 + wr * 64 + m * 16 + fr; const float rs = rs_of(ssv[ai][m]);
                f32x4 v[2][2]; float ss = 0.f;
#pragma unroll
                for (int bj = 0; bj < 2; ++bj)
#pragma unroll
                    for (int n = 0; n < 2; ++n) { v[bj][n] = acc[ai][bj][m][n] * rs; ss += (v[bj][n].x * v[bj][n].x + v[bj][n].y * v[bj][n].y) + (v[bj][n].z * v[bj][n].z + v[bj][n].w * v[bj][n].w); }
                ss += __shfl_xor(ss, 16); ss += __shfl_xor(ss, 32);
                const float hs = rsqrtf(ss * (1.f / 64.f) + NORM_EPS) * osc;
                const int bl = rl >> 11, s = rl & 2047, r = s & ((1 << dsh) - 1), j = s >> dsh, tp = r * (2048 >> dsh) + j;
                bf16_t* o = dst + ((size_t)((g * 8 + bl) * 16 + h) * 2048 + tp) * 64;
#pragma unroll
                for (int n = 0; n < 2; ++n) { f32x4 c, sn; rope4(pv[ai][m], inv[n], c, sn);
                    const f32x4 x1 = v[0][n] * ga[0][n] * hs, x2 = v[1][n] * ga[1][n] * hs;
                    const f32x4 o1 = x1 * c - x2 * sn, o2 = x2 * c + x1 * sn;
                    u32x2 w1, w2; w1.x = pk2(o1.x, o1.y); w1.y = pk2(o1.z, o1.w); w2.x = pk2(o2.x, o2.y); w2.y = pk2(o2.z, o2.w);
                    *(GAS u32x2*)(o + 16 * n + 4 * fq) = w1; *(GAS u32x2*)(o + 32 + 16 * n + 4 * fq) = w2; } }
    }
};
struct EpiVT { static constexpr bool PERM = true;
    bf16_t* O; size_t ldo; const float* SS; int sstride, soff, scnt; float sdiv; int mode, dsh, rowtok0; int tiled;
    __device__ __forceinline__ void operator()(const AccT& acc, const pg8::Unit& u, int wr, int wc, int fr, int fq) const {
        int tok0, tstride, thoff;
        if (mode == 1) { const int b = u.pn >> 3, tt = u.pn & 7; int t0;
            if (dsh == 0) { t0 = 256 * tt; tstride = 1; thoff = 128; } else if (dsh == 2) { t0 = 4 * ((tt & 1) * 256) + (tt >> 1); tstride = 4; thoff = 512; } else { t0 = 2 * tt; tstride = 16; thoff = 1; }
            tok0 = rowtok0 + b * SEQ + t0; }
        else { tok0 = u.pn * 256; tstride = 1; thoff = 128; }
        float myv;
        {   const int l = fr + 16 * fq, tok = tok0 + tstride * (32 * wc + (l & 31)) + thoff * (l >> 5); const float* p = SS + (size_t)tok * sstride + soff;
            float s; if (scnt == 4) { const f32x4 q = *(const f32x4*)p; s = (q.x + q.y) + (q.z + q.w); } else s = sum8(p); myv = rsqrtf(s / sdiv + NORM_EPS); }
        float sc[2][8];
#pragma unroll
        for (int bj = 0; bj < 2; ++bj)
#pragma unroll
            for (int e = 0; e < 8; ++e) sc[bj][e] = __shfl(myv, bj * 32 + 8 * fq + e);
#pragma unroll
        for (int ai = 0; ai < 2; ++ai)
#pragma unroll
            for (int m = 0; m < 4; ++m) { const int orow = u.pm * 256 + ai * 128 + wr * 64 + m * 16 + fr;
#pragma unroll
                for (int bj = 0; bj < 2; ++bj) { const f32x4 a0 = acc[ai][bj][m][0], a1 = acc[ai][bj][m][1];
                    u32x4 w; w.x = pk2(a0.x * sc[bj][0], a0.y * sc[bj][1]); w.y = pk2(a0.z * sc[bj][2], a0.w * sc[bj][3]); w.z = pk2(a1.x * sc[bj][4], a1.y * sc[bj][5]); w.w = pk2(a1.z * sc[bj][6], a1.w * sc[bj][7]);
                    const size_t col0 = (size_t)u.pn * 256 + 128 * bj + 32 * wc + 8 * fq;
                    if (tiled) *(GAS u32x4*)(O + ((size_t)(orow >> 5) * (ldo >> 4) + (col0 >> 4)) * 512 + ((((int)col0 >> 3) & 1) * 32 + (orow & 31)) * 8) = w;
                    else *(GAS u32x4*)(O + (size_t)orow * ldo + col0) = w; } }
    }
};
struct EpiBIn { static constexpr bool PERM = true;
    bf16_t* CQ; bf16_t* CKV; float* KR; float* SSB; const float* SS;
    __device__ __forceinline__ void operator()(const AccT& acc, const pg8::Unit& u, int wr, int wc, int fr, int fq) const {
        f32x4 ssv[2][4];
#pragma unroll
        for (int ai = 0; ai < 2; ++ai)
#pragma unroll
            for (int m = 0; m < 4; ++m) ssv[ai][m] = *(const GAS f32x4*)(SS + (size_t)(u.pm * 256 + ai * 128 + wr * 64 + m * 16 + fr) * 4);
#pragma unroll
        for (int ai = 0; ai < 2; ++ai)
#pragma unroll
            for (int m = 0; m < 4; ++m) { const int row = u.pm * 256 + ai * 128 + wr * 64 + m * 16 + fr; const float rs = rs_of(ssv[ai][m]);
#pragma unroll
                for (int bj = 0; bj < 2; ++bj) { const int col = u.pn * 256 + bj * 128 + wc * 32 + 8 * fq;
                    const f32x4 v0 = acc[ai][bj][m][0] * rs, v1 = acc[ai][bj][m][1] * rs;
                    float ss = (v0.x * v0.x + v0.y * v0.y) + (v0.z * v0.z + v0.w * v0.w) + (v1.x * v1.x + v1.y * v1.y) + (v1.z * v1.z + v1.w * v1.w);
                    ss += __shfl_xor(ss, 16); ss += __shfl_xor(ss, 32);
                    if (col < 672) { if (fq == 0) ((GAS float*)SSB)[(size_t)row * 32 + (col >> 5)] = ss;
                        if (col < 640) { u32x4 w; w.x = pk2(v0.x, v0.y); w.y = pk2(v0.z, v0.w); w.z = pk2(v1.x, v1.y); w.w = pk2(v1.z, v1.w);
                            if (col < 384) *(GAS u32x4*)(CQ + (size_t)row * 384 + col) = w; else *(GAS u32x4*)(CKV + (size_t)row * 256 + (col - 384)) = w; }
                        else { *(GAS f32x4*)(KR + (size_t)row * 32 + (col - 640)) = v0; *(GAS f32x4*)(KR + (size_t)row * 32 + (col - 640) + 4) = v1; } } } }
    }
};
struct EpiRowScale { static constexpr bool PERM = true;
    bf16_t* O; int ldo; bf16_t* O2; int ld2; int split; const float* SS; int sstride, soff, scnt; float sdiv; int act;
    __device__ __forceinline__ void operator()(const AccT& acc, const pg8::Unit& u, int wr, int wc, int fr, int fq) const {
#pragma unroll
        for (int ai = 0; ai < 2; ++ai) {
            float rsv[4];
#pragma unroll
            for (int m = 0; m < 4; ++m) { const int row = u.pm * 256 + ai * 128 + wr * 64 + m * 16 + fr;
                const float* p = SS + (size_t)row * sstride + soff; float s; if (scnt == 4) { const f32x4 q = *(const f32x4*)p; s = (q.x + q.y) + (q.z + q.w); } else { s = sum8(p); if (scnt >= 12) s += ((const GAS f32x4*)p)[2].x + ((const GAS f32x4*)p)[2].y + ((const GAS f32x4*)p)[2].z + ((const GAS f32x4*)p)[2].w; }
                rsv[m] = s; }
#pragma unroll
            for (int m = 0; m < 4; ++m) { const int row = u.pm * 256 + ai * 128 + wr * 64 + m * 16 + fr;
                const float rs = rsqrtf(rsv[m] / sdiv + NORM_EPS);
#pragma unroll
                for (int bj = 0; bj < 2; ++bj) { const int col = u.pn * 256 + bj * 128 + wc * 32 + 8 * fq;
                    f32x4 v0 = acc[ai][bj][m][0] * rs, v1 = acc[ai][bj][m][1] * rs;
                    if (act == 1 && col < split) { v0 = (f32x4){gelu_tanh_f(v0.x), gelu_tanh_f(v0.y), gelu_tanh_f(v0.z), gelu_tanh_f(v0.w)}; v1 = (f32x4){gelu_tanh_f(v1.x), gelu_tanh_f(v1.y), gelu_tanh_f(v1.z), gelu_tanh_f(v1.w)}; }
                    u32x4 w; w.x = pk2(v0.x, v0.y); w.y = pk2(v0.z, v0.w); w.z = pk2(v1.x, v1.y); w.w = pk2(v1.z, v1.w);
                    if (col < split) *(GAS u32x4*)(O + (size_t)row * ldo + col) = w; else *(GAS u32x4*)(O2 + (size_t)row * ld2 + (col - split)) = w; } }
        }
    }
};
struct EpiBK { static constexpr bool PERM = false;
    bf16_t* KB; const float* SSB; const float* KR; const float* gk; const float* cosT; const float* sinT;
    __device__ __forceinline__ void operator()(const AccT& acc, const pg8::Unit& u, int wr, int wc, int fr, int fq) const {
        const int h = u.pn * 4 + wc;
        f32x4 ga[2][2];
#pragma unroll
        for (int bj = 0; bj < 2; ++bj)
#pragma unroll
            for (int n = 0; n < 2; ++n) ga[bj][n] = *(const GAS f32x4*)(gk + 32 * bj + 16 * n + 4 * fq);
        const f32x4 gr1 = *(const GAS f32x4*)(gk + 64 + 4 * fq), gr2 = *(const GAS f32x4*)(gk + 80 + 4 * fq);
#pragma unroll
        for (int ai = 0; ai < 2; ++ai)
#pragma unroll
            for (int mh = 0; mh < 2; ++mh) {
                f32x4 s0[2], s1[2], kr1[2], kr2[2], cs[2], sv[2]; float ssr[2];
#pragma unroll
                for (int mm = 0; mm < 2; ++mm) { const int row = u.pm * 256 + ai * 128 + wr * 64 + (2 * mh + mm) * 16 + fr; const float* sp = SSB + (size_t)row * 32;
                    s0[mm] = *(const GAS f32x4*)(sp + 12); s1[mm] = *(const GAS f32x4*)(sp + 16); ssr[mm] = ((const GAS float*)sp)[20];
                    kr1[mm] = *(const GAS f32x4*)(KR + (size_t)row * 32 + 4 * fq); kr2[mm] = *(const GAS f32x4*)(KR + (size_t)row * 32 + 16 + 4 * fq);
                    cs[mm] = *(const GAS f32x4*)(cosT + (size_t)row * 16 + 4 * fq); sv[mm] = *(const GAS f32x4*)(sinT + (size_t)row * 16 + 4 * fq); }
#pragma unroll
                for (int mm = 0; mm < 2; ++mm) { const int m = 2 * mh + mm; const int row = u.pm * 256 + ai * 128 + wr * 64 + m * 16 + fr;
                    const float rkv = rsqrtf((((s0[mm].x + s0[mm].y) + (s0[mm].z + s0[mm].w)) + ((s1[mm].x + s1[mm].y) + (s1[mm].z + s1[mm].w))) * (1.f / 256.f) + NORM_EPS);
                    f32x4 v[2][2]; float ss = 0.f;
#pragma unroll
                    for (int bj = 0; bj < 2; ++bj)
#pragma unroll
                        for (int n = 0; n < 2; ++n) { v[bj][n] = acc[ai][bj][m][n] * rkv; ss += (v[bj][n].x * v[bj][n].x + v[bj][n].y * v[bj][n].y) + (v[bj][n].z * v[bj][n].z + v[bj][n].w * v[bj][n].w); }
                    ss += __shfl_xor(ss, 16); ss += __shfl_xor(ss, 32);
                    const float sk = rsqrtf((ss + ssr[mm]) * (1.f / 96.f) + NORM_EPS);
                    const int b = row >> 11, s = row & 2047;
                    bf16_t* o = KB + ((size_t)(b * 16 + h) * 2048 + s) * 96;
#pragma unroll
                    for (int bj = 0; bj < 2; ++bj)
#pragma unroll
                        for (int n = 0; n < 2; ++n) { const f32x4 y = v[bj][n] * ga[bj][n] * sk; u32x2 w; w.x = pk2(y.x, y.y); w.y = pk2(y.z, y.w); *(GAS u32x2*)(o + 32 * bj + 16 * n + 4 * fq) = w; }
                    const f32x4 k1 = kr1[mm] * gr1 * sk, k2 = kr2[mm] * gr2 * sk;
                    const f32x4 o1 = k1 * cs[mm] - k2 * sv[mm], o2 = k2 * cs[mm] + k1 * sv[mm];
                    u32x2 w1, w2; w1.x = pk2(o1.x, o1.y); w1.y = pk2(o1.z, o1.w); w2.x = pk2(o2.x, o2.y); w2.y = pk2(o2.z, o2.w);
                    *(GAS u32x2*)(o + 64 + 4 * fq) = w1; *(GAS u32x2*)(o + 80 + 4 * fq) = w2; }
            }
    }
};
struct EpiCIn { static constexpr bool PERM = false;
    bf16_t* Q; bf16_t* Kc; bf16_t* G; const float* SS; const int* pos;
    __device__ __forceinline__ void operator()(const AccT& acc, const pg8::Unit& u, int wr, int wc, int fr, int fq) const {
        f32x4 ssv[2][4];
#pragma unroll
        for (int ai = 0; ai < 2; ++ai)
#pragma unroll
            for (int m = 0; m < 4; ++m) ssv[ai][m] = *(const GAS f32x4*)(SS + (size_t)(u.pm * 256 + ai * 128 + wr * 64 + m * 16 + fr) * 4);
        if (u.pn >= 8) {
#pragma unroll
            for (int ai = 0; ai < 2; ++ai)
#pragma unroll
                for (int m = 0; m < 4; ++m) { const int row = u.pm * 256 + ai * 128 + wr * 64 + m * 16 + fr; const float rs = rs_of(ssv[ai][m]);
#pragma unroll
                    for (int bj = 0; bj < 2; ++bj)
#pragma unroll
                        for (int n = 0; n < 2; ++n) { const f32x4 v = acc[ai][bj][m][n] * rs; u32x2 w; w.x = pk2(v.x, v.y); w.y = pk2(v.z, v.w);
                            *(GAS u32x2*)(G + (size_t)row * 2048 + (u.pn - 8) * 256 + bj * 128 + wc * 32 + 16 * n + 4 * fq) = w; } }
            return; }
        const int isk = u.pn >= 4 ? 1 : 0, h = (u.pn & 3) * 2 + (wc >> 1);
        bf16_t* dst = isk ? Kc : Q;
        const float lg = log2f(1.f - exp2f(-5.f - (float)h));
        const float ksc = isk ? 0.08838834764831845f : 1.f;
        float pv[2][4]; f32x4 inv[2];
#pragma unroll
        for (int ai = 0; ai < 2; ++ai)
#pragma unroll
            for (int m = 0; m < 4; ++m) pv[ai][m] = (float)((const GAS int*)pos)[u.pm * 256 + ai * 128 + wr * 64 + m * 16 + fr];
#pragma unroll
        for (int n = 0; n < 2; ++n)
#pragma unroll
            for (int j = 0; j < 4; ++j) inv[n][j] = exp2f(-(float)(32 * (wc & 1) + 16 * n + 4 * fq + j) * (13.287712379549449f / 64.f));
#pragma unroll
        for (int ai = 0; ai < 2; ++ai)
#pragma unroll
            for (int m = 0; m < 4; ++m) { const int row = u.pm * 256 + ai * 128 + wr * 64 + m * 16 + fr; const float rs = rs_of(ssv[ai][m]);
                const int b = row >> 11, s = row & 2047, il = s & 127;
                const float dec = fast_exp2((isk ? -(float)(il + 1) : (float)(il + 1)) * lg) * ksc * rs;
                bf16_t* o = dst + ((size_t)(b * 8 + h) * 2048 + s) * 128;
#pragma unroll
                for (int n = 0; n < 2; ++n) { const int i0 = 32 * (wc & 1) + 16 * n + 4 * fq; f32x4 c, sn; rope4(pv[ai][m], inv[n], c, sn);
                    const f32x4 x1 = acc[ai][0][m][n] * dec, x2 = acc[ai][1][m][n] * dec;
                    const f32x4 o1 = x1 * c - x2 * sn, o2 = x2 * c + x1 * sn;
                    u32x2 w1, w2; w1.x = pk2(o1.x, o1.y); w1.y = pk2(o1.z, o1.w); w2.x = pk2(o2.x, o2.y); w2.y = pk2(o2.z, o2.w);
                    *(GAS u32x2*)(o + i0) = w1; *(GAS u32x2*)(o + 64 + i0) = w2; } }
    }
};
struct EpiDGate { static constexpr bool PERM = true;
    bf16_t* LA; bf16_t* GU; const bf16_t* UC; const float* brg; const float* big; const float* lam;
    __device__ __forceinline__ void operator()(const AccT& acc, const pg8::Unit& u, int wr, int wc, int fr, int fq) const {
        const int ch = u.pn * 128 + wc * 32 + 8 * fq;
        u32x4 ucv[2][4];
#pragma unroll
        for (int ai = 0; ai < 2; ++ai)
#pragma unroll
            for (int m = 0; m < 4; ++m) ucv[ai][m] = *(const GAS u32x4*)(UC + (size_t)(u.pm * 256 + ai * 128 + wr * 64 + m * 16 + fr) * 1024 + ch);
        float b1[8], b2[8], sp[8];
#pragma unroll
        for (int e = 0; e < 8; ++e) { b1[e] = ((const GAS float*)brg)[ch + e]; b2[e] = ((const GAS float*)big)[ch + e]; sp[e] = ((const GAS float*)lam)[ch + e]; }
#pragma unroll
        for (int ai = 0; ai < 2; ++ai)
#pragma unroll
            for (int m = 0; m < 4; ++m) { const int row = u.pm * 256 + ai * 128 + wr * 64 + m * 16 + fr;
                const u32x4 uw = ucv[ai][m];
                float uc[8] = {bflo(uw.x), bfhi(uw.x), bflo(uw.y), bfhi(uw.y), bflo(uw.z), bfhi(uw.z), bflo(uw.w), bfhi(uw.w)};
                float la[8], gu[8];
#pragma unroll
                for (int n = 0; n < 2; ++n)
#pragma unroll
                    for (int j = 0; j < 4; ++j) { const int e = 4 * n + j; const float r = sigmoid_f(acc[ai][0][m][n][j] + b1[e]), ig = sigmoid_f(acc[ai][1][m][n][j] + b2[e]);
                        la[e] = sp[e] * r; gu[e] = ig * uc[e]; }
                { u32x4 wl; wl.x = pk2(la[0], la[1]); wl.y = pk2(la[2], la[3]); wl.z = pk2(la[4], la[5]); wl.w = pk2(la[6], la[7]); *(GAS u32x4*)(LA + (size_t)row * 1024 + ch) = wl; }
                u32x4 w; w.x = pk2(gu[0], gu[1]); w.y = pk2(gu[2], gu[3]); w.z = pk2(gu[4], gu[5]); w.w = pk2(gu[6], gu[7]);
                *(GAS u32x4*)(GU + (size_t)row * 1024 + ch) = w; }
    }
};

#define LDS_WAIT() asm volatile("s_waitcnt lgkmcnt(0)" ::: "memory")
template <class F> __device__ __forceinline__ void prep_matrix(bf16_t* Bt, int N, int K, F src4, LAS float* scr, int gw, int NGW, int lane, int& off) {
    const int nblk = N / 32, items = nblk * (K / 64);
    int first = gw - off; if (first < 0) first += NGW;
    off = (off + items) % NGW;
    for (int it = first; it < items; it += NGW) {
        const int kb = it / nblk, nb = it % nblk, k0 = 64 * kb, n0 = 32 * nb;
        const int n4 = (lane & 7) * 4;
#pragma unroll
        for (int i = 0; i < 8; ++i) { const int kk = (lane >> 3) + 8 * i; const f32x4 v = src4(n0 + n4, k0 + kk); LAS float* d = scr + kk * 33 + n4; d[0] = v.x; d[1] = v.y; d[2] = v.z; d[3] = v.w; }
        LDS_WAIT(); asm volatile("" ::: "memory");
        const int c = lane & 7;
#pragma unroll
        for (int j = 0; j < 4; ++j) { const int n = (lane >> 3) + 8 * j; const LAS float* s = scr + (8 * c) * 33 + n;
            u32x4 o; o.x = pk2(s[0 * 33], s[1 * 33]); o.y = pk2(s[2 * 33], s[3 * 33]); o.z = pk2(s[4 * 33], s[5 * 33]); o.w = pk2(s[6 * 33], s[7 * 33]);
            *(u32x4*)(Bt + (size_t)(n0 + n) * K + k0 + 8 * c) = o; }
        LDS_WAIT(); asm volatile("" ::: "memory");
    }
}
#define LD4(p) (*(const f32x4*)(p))

#define MFMA32(a, b, c) __builtin_amdgcn_mfma_f32_32x32x16_bf16((a), (b), (c), 0, 0, 0)
__device__ __forceinline__ bf16x8 mk8(u32x2 lo, u32x2 hi) { u32x4 v = {lo.x, lo.y, hi.x, hi.y}; return __builtin_bit_cast(bf16x8, v); }
__device__ __forceinline__ bf16x8 pack8(const f32x16& p, int ks) {
    u32x4 v; v.x = pk2(p[8 * ks + 0], p[8 * ks + 1]); v.y = pk2(p[8 * ks + 2], p[8 * ks + 3]); v.z = pk2(p[8 * ks + 4], p[8 * ks + 5]); v.w = pk2(p[8 * ks + 6], p[8 * ks + 7]);
    return __builtin_bit_cast(bf16x8, v);
}

__device__ __forceinline__ void mixA_attn(LAS unsigned char* lds, const bf16_t* QA, const bf16_t* KA, const bf16_t* VT, bf16_t* OA, int half, float shift) {
    const int tid = opaque_tid(), lane = tid & 63, wid = __builtin_amdgcn_readfirstlane(tid >> 6), r32 = lane & 31, hi = lane >> 5;
    LAS float* Ol = (LAS float*)lds; LAS float* Ll = (LAS float*)(lds + LDS_X_OFF);
#pragma unroll 1
    for (int unit = blockIdx.x; unit < 512; unit += gridDim.x) {
        const int bl = unit >> 6, h = (unit >> 2) & 15, c = unit & 3;
#pragma unroll 1
        for (int g = 0; g < 3; ++g) {
            const int dsh = 2 * g, L = 2048 >> dsh, tsh = 4 - dsh;
            const size_t hb = ((size_t)((g * 8 + bl) * 16 + h)) * 2048;
            const bf16_t* vbase = VT + ((size_t)(g * 1024 + h * 64)) * 16384 + (size_t)bl * 2048;
#pragma unroll 1
            for (int tt = 0; tt < 2; ++tt) {
                const int tau = 2 * wid + tt, r = tau >> tsh, a = (c << tsh) + (tau & ((1 << tsh) - 1));
                const size_t rb = hb + (size_t)r * L;
                bf16x8 qf[4];
#pragma unroll
                for (int d0 = 0; d0 < 4; ++d0) qf[d0] = *(const bf16x8*)(QA + (rb + 32 * a + r32) * 64 + 16 * d0 + 8 * hi);
                f32x16 o0 = {}, o1 = {}; float lsum = 0.f;
                const int kb0 = a - 4 < 0 ? 0 : a - 4;
                const bf16_t* kp0 = KA + (rb + r32) * 64 + 8 * hi;
                const bf16_t* vp0 = VT + ((size_t)(g * 32 + 2 * h) * 1024 + (size_t)((bl * 2048 + r * L) >> 4)) * 512 + r32 * 8 + 4 * hi;
                bf16x8 kf[4]; u32x2 vl[2][2][2];
#define A_LOAD(KF, VL, kb_) do { _Pragma("unroll") for (int d0 = 0; d0 < 4; ++d0) KF[d0] = *(const bf16x8*)(kp0 + (size_t)(32 * (kb_)) * 64 + 16 * d0); \
                    _Pragma("unroll") for (int db = 0; db < 2; ++db) _Pragma("unroll") for (int ks = 0; ks < 2; ++ks) { const bf16_t* f_ = vp0 + ((size_t)db * 1024 + 2 * (kb_) + ks) * 512; VL[db][ks][0] = *(const u32x2*)(f_); VL[db][ks][1] = *(const u32x2*)(f_ + 256); } } while (0)
                A_LOAD(kf, vl, kb0);
#pragma unroll 1
                for (int kb = kb0; kb <= a; ++kb) {
                    bf16x8 kfn[4]; u32x2 vln[2][2][2];
                    const int kbn = kb < a ? kb + 1 : kb;
                    A_LOAD(kfn, vln, kbn);
                    f32x16 st = {};
#pragma unroll
                    for (int d0 = 0; d0 < 4; ++d0) st = MFMA32(kf[d0], qf[d0], st);
                    const int thi = ((kb == a) ? r32 : 63) - 4 * hi, tlo = ((kb == a - 4) ? r32 : -1) - 4 * hi;
#pragma unroll
                    for (int rr = 0; rr < 16; ++rr) { const int kc = (rr & 3) + 8 * (rr >> 2); const bool ok = (kc <= thi) && (kc >= tlo);
                        const float p = ok ? fast_exp2(st[rr] - shift) : 0.f; st[rr] = p; lsum += p; }
                    const bf16x8 p0 = pack8(st, 0), p1 = pack8(st, 1);
                    o0 = MFMA32(mk8(vl[0][0][0], vl[0][0][1]), p0, o0); o0 = MFMA32(mk8(vl[0][1][0], vl[0][1][1]), p1, o0);
                    o1 = MFMA32(mk8(vl[1][0][0], vl[1][0][1]), p0, o1); o1 = MFMA32(mk8(vl[1][1][0], vl[1][1][1]), p1, o1);
#pragma unroll
                    for (int d0 = 0; d0 < 4; ++d0) kf[d0] = kfn[d0];
#pragma unroll
                    for (int db = 0; db < 2; ++db)
#pragma unroll
                        for (int ks = 0; ks < 2; ++ks) { vl[db][ks][0] = vln[db][ks][0]; vl[db][ks][1] = vln[db][ks][1]; }
                }
#undef A_LOAD
                lsum += __shfl_xor(lsum, 32);
                const int pp = ((32 * a + r32) << dsh) + r - 512 * c;
#pragma unroll
                for (int db = 0; db < 2; ++db)
#pragma unroll
                    for (int q4 = 0; q4 < 4; ++q4) { const int ch = 2 * q4 + hi + 8 * db; LAS f32x4* ad = (LAS f32x4*)(Ol + pp * 64 + ((ch ^ (pp & 15)) << 2));
                        const f32x16& o = db ? o1 : o0; f32x4 v = {o[4 * q4], o[4 * q4 + 1], o[4 * q4 + 2], o[4 * q4 + 3]};
                        if (g > 0) v += *ad; *ad = v; }
                if (hi == 0) Ll[pp] = (g > 0 ? Ll[pp] : 0.f) + lsum;
            }
            __syncthreads();
        }
        for (int idx = tid; idx < 4096; idx += 512) { const int pp = idx >> 3, c8 = idx & 7; const float inv = 1.f / Ll[pp];
            const f32x4 a = *(LAS f32x4*)(Ol + pp * 64 + (((2 * c8) ^ (pp & 15)) << 2)), b = *(LAS f32x4*)(Ol + pp * 64 + (((2 * c8 + 1) ^ (pp & 15)) << 2));
            u32x4 w; w.x = pk2(a.x * inv, a.y * inv); w.y = pk2(a.z * inv, a.w * inv); w.z = pk2(b.x * inv, b.y * inv); w.w = pk2(b.z * inv, b.w * inv);
            *(u32x4*)(OA + ((size_t)(half * 8 + bl) * 2048 + 512 * c + pp) * 1024 + h * 64 + 8 * c8) = w; }
        __syncthreads();
    }
}

constexpr int BK_STRIDE = 208, BK_TILE = 64 * BK_STRIDE, BV_STRIDE = 144, BV_TILE = 64 * BV_STRIDE;
__device__ __forceinline__ void mixB_attn(LAS unsigned char* lds, const bf16_t* QR, const bf16_t* KB, const bf16_t* VT, bf16_t* OB, const float* gq, const float* cosT, const float* sinT, float shift) {
    const int tid = opaque_tid(), lane = tid & 63, wid = __builtin_amdgcn_readfirstlane(tid >> 6), r32 = lane & 31, hi = lane >> 5;
    const float qsc = 0.10206207261596575f * LOG2E;
    LAS unsigned char* Kl = lds; LAS unsigned char* Vl = lds + 2 * BK_TILE;
    const int c2 = tid + 512;
    const int kdst1 = (tid / 12) * BK_STRIDE + 16 * (tid % 12), kdst2 = (c2 / 12) * BK_STRIDE + 16 * (c2 % 12);
    const int vd = tid >> 3, c8 = tid & 7, vdst = vd * BV_STRIDE + 2 * (16 * (c8 >> 1) + 4 * (c8 & 1));
    const int kfo = r32 * BK_STRIDE + 16 * hi, vfo = r32 * BV_STRIDE + 16 * hi;
#pragma unroll 1
    for (int unit = blockIdx.x; unit < 256; unit += gridDim.x) {
        const int b = unit >> 4, h = unit & 15;
        const bf16_t* kbase = KB + (size_t)(b * 16 + h) * 2048 * 96;
        const bf16_t* vsrc = VT + (size_t)(h * 64 + vd) * MTOK + (size_t)b * 2048 + 8 * c8;
#pragma unroll 1
        for (int qb = 0; qb < 8; ++qb) {
            const int qfirst = 256 * qb + 32 * wid, row = b * 2048 + qfirst + r32;
            bf16x8 qf[6];
            {   float qv[6][8]; float ss = 0.f;
#pragma unroll
                for (int d0 = 0; d0 < 6; ++d0) { const u32x4 w = *(const u32x4*)(QR + (size_t)row * 1536 + h * 96 + 16 * d0 + 8 * hi);
                    qv[d0][0] = bflo(w.x); qv[d0][1] = bfhi(w.x); qv[d0][2] = bflo(w.y); qv[d0][3] = bfhi(w.y); qv[d0][4] = bflo(w.z); qv[d0][5] = bfhi(w.z); qv[d0][6] = bflo(w.w); qv[d0][7] = bfhi(w.w);
#pragma unroll
                    for (int e = 0; e < 8; ++e) ss += qv[d0][e] * qv[d0][e]; }
                ss += __shfl_xor(ss, 32);
                const float sq = rsqrtf(ss * (1.f / 96.f) + NORM_EPS) * qsc;
#pragma unroll
                for (int d0 = 0; d0 < 6; ++d0)
#pragma unroll
                    for (int e = 0; e < 8; ++e) qv[d0][e] *= sq * gq[16 * d0 + 8 * hi + e];
#pragma unroll
                for (int e = 0; e < 8; ++e) { const float c = cosT[(size_t)row * 16 + 8 * hi + e], sn = sinT[(size_t)row * 16 + 8 * hi + e]; const float x1 = qv[4][e], x2 = qv[5][e];
                    qv[4][e] = x1 * c - x2 * sn; qv[5][e] = x2 * c + x1 * sn; }
#pragma unroll
                for (int d0 = 0; d0 < 6; ++d0) { u32x4 w; w.x = pk2(qv[d0][0], qv[d0][1]); w.y = pk2(qv[d0][2], qv[d0][3]); w.z = pk2(qv[d0][4], qv[d0][5]); w.w = pk2(qv[d0][6], qv[d0][7]); qf[d0] = __builtin_bit_cast(bf16x8, w); }
            }
            f32x16 negs;
#pragma unroll
            for (int rr = 0; rr < 16; ++rr) negs[rr] = -shift;
            f32x16 o0 = {}, o1 = {}; float lsum = 0.f;
            const int ntile = 4 * qb + 4;
            {
                const u32x4 k1 = *(const u32x4*)(kbase + 8 * tid); u32x4 k2 = {}; if (tid < 256) k2 = *(const u32x4*)(kbase + 8 * c2);
                const u32x4 v1 = *(const u32x4*)(vsrc);
                *(LAS u32x4*)(Kl + kdst1) = k1; if (tid < 256) *(LAS u32x4*)(Kl + kdst2) = k2;
                *(LAS u32x2*)(Vl + vdst) = (u32x2){v1.x, v1.y}; *(LAS u32x2*)(Vl + vdst + 16) = (u32x2){v1.z, v1.w};
            }
            __syncthreads();
#pragma unroll 1
            for (int t = 0; t < ntile; ++t) {
                const bool more = (t + 1 < ntile);
                u32x4 k1 = {}, k2 = {}, v1 = {};
                if (more) { const bf16_t* kt = kbase + (size_t)(t + 1) * 64 * 96; k1 = *(const u32x4*)(kt + 8 * tid); if (tid < 256) k2 = *(const u32x4*)(kt + 8 * c2); v1 = *(const u32x4*)(vsrc + 64 * (t + 1)); }
                const LAS unsigned char* Kt = Kl + (t & 1) * BK_TILE; const LAS unsigned char* Vt = Vl + (t & 1) * BV_TILE;
#pragma unroll
                for (int kblk = 0; kblk < 2; ++kblk) {
                    const int key0 = 64 * t + 32 * kblk;
                    if (key0 <= qfirst + 31) {
                        f32x16 st = negs;
#pragma unroll
                        for (int d0 = 0; d0 < 6; ++d0) { const bf16x8 kf = *(const LAS bf16x8*)(Kt + kblk * 32 * BK_STRIDE + kfo + 32 * d0); st = MFMA32(kf, qf[d0], st); }
                        if (key0 + 31 > qfirst) {
                            const int thi = (qfirst - key0 + r32) - 4 * hi;
#pragma unroll
                            for (int rr = 0; rr < 16; ++rr) { const int kc = (rr & 3) + 8 * (rr >> 2); const float p = (kc <= thi) ? fast_exp2(st[rr]) : 0.f; st[rr] = p; lsum += p; }
                        } else {
#pragma unroll
                            for (int rr = 0; rr < 16; ++rr) { const float p = fast_exp2(st[rr]); st[rr] = p; lsum += p; }
                        }
                        const bf16x8 p0 = pack8(st, 0), p1 = pack8(st, 1);
                        const LAS unsigned char* vp = Vt + vfo + 2 * (32 * kblk);
                        o0 = MFMA32(*(const LAS bf16x8*)(vp), p0, o0); o0 = MFMA32(*(const LAS bf16x8*)(vp + 32), p1, o0);
                        o1 = MFMA32(*(const LAS bf16x8*)(vp + 32 * BV_STRIDE), p0, o1); o1 = MFMA32(*(const LAS bf16x8*)(vp + 32 * BV_STRIDE + 32), p1, o1);
                    }
                }
                if (more) { LAS unsigned char* Kn = Kl + ((t + 1) & 1) * BK_TILE; LAS unsigned char* Vn = Vl + ((t + 1) & 1) * BV_TILE;
                    *(LAS u32x4*)(Kn + kdst1) = k1; if (tid < 256) *(LAS u32x4*)(Kn + kdst2) = k2;
                    *(LAS u32x2*)(Vn + vdst) = (u32x2){v1.x, v1.y}; *(LAS u32x2*)(Vn + vdst + 16) = (u32x2){v1.z, v1.w}; }
                __syncthreads();
            }
            lsum += __shfl_xor(lsum, 32);
            const float inv = 1.f / lsum;
            bf16_t* op = OB + (size_t)row * 1024 + h * 64;
#pragma unroll
            for (int db = 0; db < 2; ++db)
#pragma unroll
                for (int q4 = 0; q4 < 4; ++q4) { const f32x16& o = db ? o1 : o0; u32x2 w; w.x = pk2(o[4 * q4] * inv, o[4 * q4 + 1] * inv); w.y = pk2(o[4 * q4 + 2] * inv, o[4 * q4 + 3] * inv);
                    *(u32x2*)(op + 32 * db + 8 * q4 + 4 * hi) = w; }
        }
    }
}

constexpr int KT_STRIDE = 272, RT_STRIDE = 272, YS_STRIDE = 528;
constexpr int RET_KR = 0, RET_YS = 128 * KT_STRIDE, RET_RT = 2 * 128 * KT_STRIDE, RET_ST = MISC_OFF + 1024;
static_assert(RET_YS + 64 * YS_STRIDE <= RET_RT && RET_RT + 256 * RT_STRIDE <= MISC_OFF && RET_ST + 2048 <= LDS_BYTES, "retention LDS map");
typedef short v4i16_t __attribute__((ext_vector_type(4)));
__device__ __forceinline__ u32x2 lds_tr(const LAS unsigned char* p) { return __builtin_bit_cast(u32x2, __builtin_amdgcn_ds_read_tr16_b64_v4i16((LAS v4i16_t*)p)); }
__device__ __forceinline__ void mixC_retention(LAS unsigned char* lds, const bf16_t* QC, const bf16_t* KC, const bf16_t* VT, bf16_t* G) {
    const int tid = opaque_tid(), lane = tid & 63, wid = __builtin_amdgcn_readfirstlane(tid >> 6), r32 = lane & 31, hi = lane >> 5;
    LAS unsigned char* KR = lds + RET_KR; LAS unsigned char* YS = lds + RET_YS; LAS unsigned char* RT = lds + RET_RT; LAS float* ST = (LAS float*)(lds + RET_ST);
    const int trb = (8 * hi + ((lane & 15) >> 2)) * KT_STRIDE + (16 * ((lane >> 4) & 1) + 4 * (lane & 3)) * 2;
#pragma unroll 1
    for (int unit = blockIdx.x; unit < 256; unit += gridDim.x) {
        const int b = unit >> 4, h = (unit >> 1) & 7, rh = unit & 1;
        const int ib = wid & 1, gi = ib ? (3 - rh) : rh, vq = wid >> 1;
        const float lg = log2f(1.f - exp2f(-5.f - (float)h)), cd = exp2f(128.f * lg);
        const size_t bh = (size_t)(b * 8 + h) * 2048;
        f32x16 Racc[4];
#pragma unroll
        for (int db = 0; db < 4; ++db) Racc[db] = (f32x16){};
        const bf16_t* qsrc = QC + (bh + 32 * gi + r32) * 128 + 8 * hi;
        const bf16_t* ksrc = KC + bh * 128 + 8 * tid;
        const bf16_t* vin0 = VT + ((size_t)(h * 8 + 2 * vq) * (MTOK / 16) + (size_t)(b * 128)) * 512 + r32 * 8 + 4 * hi;
        const bf16_t* vup0 = VT + ((size_t)(h * 8 + wid) * (MTOK / 16) + (size_t)(b * 128)) * 512 + (hi * 32 + r32) * 8;
        const int orow = tid >> 3, ogi = (orow >> 5) ? (3 - rh) : rh;
        bf16_t* gp0 = G + ((size_t)b * 2048 + 32 * ogi + (orow & 31)) * 2048 + h * 256 + 8 * (tid & 7);
        u32x4 kst[4]; bf16x8 qf[8];
#pragma unroll
        for (int e = 0; e < 4; ++e) kst[e] = *(const u32x4*)(ksrc + 4096 * e);
#pragma unroll
        for (int s = 0; s < 8; ++s) qf[s] = *(const bf16x8*)(qsrc + 16 * s);
#pragma unroll 1
        for (int c = 0; c < 16; ++c) {
            const int cn = c < 15 ? c + 1 : c;
#pragma unroll
            for (int e = 0; e < 4; ++e) { const int id = tid + 512 * e; *(LAS u32x4*)(KR + (id >> 4) * KT_STRIDE + 16 * (id & 15)) = kst[e]; }
            bf16x8 vupd[8];
#pragma unroll
            for (int s = 0; s < 4; ++s) vupd[s] = *(const bf16x8*)(vup0 + (size_t)(8 * c + s) * 512);
            u32x2 vin[8];
#define C_VIN(dst, jb_) do { const bf16_t* vp_ = vin0 + (size_t)(8 * c + 2 * (jb_)) * 512; const bf16_t* vq_ = vp_ + (size_t)(MTOK / 16) * 512; \
                dst[0] = *(const u32x2*)(vp_); dst[1] = *(const u32x2*)(vp_ + 256); dst[2] = *(const u32x2*)(vp_ + 512); dst[3] = *(const u32x2*)(vp_ + 768); \
                dst[4] = *(const u32x2*)(vq_); dst[5] = *(const u32x2*)(vq_ + 256); dst[6] = *(const u32x2*)(vq_ + 512); dst[7] = *(const u32x2*)(vq_ + 768); } while (0)
            C_VIN(vin, 0);
            __syncthreads();
            f32x16 y0 = {}, y1 = {};
            if (c > 0) {
#pragma unroll
                for (int s = 0; s < 8; ++s) { const bf16x8 a0 = *(const LAS bf16x8*)(RT + (64 * vq + r32) * RT_STRIDE + (16 * s + 8 * hi) * 2), a1 = *(const LAS bf16x8*)(RT + (64 * vq + 32 + r32) * RT_STRIDE + (16 * s + 8 * hi) * 2);
                    y0 = MFMA32(a0, qf[s], y0); y1 = MFMA32(a1, qf[s], y1); }
            }
#pragma unroll 1
            for (int jb = 0; jb <= gi; ++jb) {
                u32x2 vnx[8];
                const int jn = jb < gi ? jb + 1 : jb;
                C_VIN(vnx, jn);
                f32x16 st = {};
#pragma unroll
                for (int s = 0; s < 8; ++s) { const bf16x8 kf = *(const LAS bf16x8*)(KR + (32 * jb + r32) * KT_STRIDE + (16 * s + 8 * hi) * 2); st = MFMA32(kf, qf[s], st); }
                {   const int thi = ((jb == gi) ? r32 : 63) - 4 * hi;
#pragma unroll
                    for (int rr = 0; rr < 16; ++rr) { const int kc = (rr & 3) + 8 * (rr >> 2); st[rr] = (kc <= thi) ? st[rr] : 0.f; } }
                const bf16x8 p0 = pack8(st, 0), p1 = pack8(st, 1);
                y0 = MFMA32(mk8(vin[0], vin[1]), p0, y0); y0 = MFMA32(mk8(vin[2], vin[3]), p1, y0); y1 = MFMA32(mk8(vin[4], vin[5]), p0, y1); y1 = MFMA32(mk8(vin[6], vin[7]), p1, y1);
#pragma unroll
                for (int e = 0; e < 8; ++e) vin[e] = vnx[e];
            }
#undef C_VIN
#pragma unroll
            for (int s = 4; s < 8; ++s) vupd[s] = *(const bf16x8*)(vup0 + (size_t)(8 * c + s) * 512);
#pragma unroll
            for (int s = 0; s < 8; ++s) qf[s] = *(const bf16x8*)(qsrc + (size_t)16384 * cn + 16 * s);
            bf16_t* gp = gp0 + (size_t)262144 * c;
            u32x4 gv[4];
#pragma unroll
            for (int k = 0; k < 4; ++k) gv[k] = *(const u32x4*)(gp + 64 * k);
#pragma unroll
            for (int s = 0; s < 8; ++s) {
#pragma unroll
                for (int db = 0; db < 4; ++db) { const LAS unsigned char* ap = KR + trb + (16 * s) * KT_STRIDE + 64 * db;
                    const bf16x8 af = mk8(lds_tr(ap), lds_tr(ap + 4 * KT_STRIDE)); Racc[db] = MFMA32(af, vupd[s], Racc[db]); } }
#pragma unroll
            for (int db = 0; db < 4; ++db) Racc[db] *= cd;
            float s1 = 0.f, s2 = 0.f;
#pragma unroll
            for (int rr = 0; rr < 16; ++rr) { s1 += y0[rr] + y1[rr]; s2 += y0[rr] * y0[rr] + y1[rr] * y1[rr]; }
            s1 += __shfl_xor(s1, 32); s2 += __shfl_xor(s2, 32);
            __syncthreads();
#pragma unroll
            for (int e = 0; e < 4; ++e) kst[e] = *(const u32x4*)(ksrc + (size_t)16384 * cn + 4096 * e);
#pragma unroll
            for (int db = 0; db < 4; ++db)
#pragma unroll
                for (int q4 = 0; q4 < 4; ++q4) { u32x2 w; w.x = pk2(Racc[db][4 * q4], Racc[db][4 * q4 + 1]); w.y = pk2(Racc[db][4 * q4 + 2], Racc[db][4 * q4 + 3]);
                    *(LAS u32x2*)(RT + (32 * wid + r32) * RT_STRIDE + (32 * db + 8 * q4 + 4 * hi) * 2) = w; }
            if (hi == 0) { ST[((ib * 4 + vq) * 32 + r32) * 2] = s1; ST[((ib * 4 + vq) * 32 + r32) * 2 + 1] = s2; }
            __syncthreads();
            float t1 = 0.f, t2 = 0.f;
#pragma unroll
            for (int q = 0; q < 4; ++q) { t1 += ST[((ib * 4 + q) * 32 + r32) * 2]; t2 += ST[((ib * 4 + q) * 32 + r32) * 2 + 1]; }
            const float mu = t1 * (1.f / 256.f), var = fmaxf(t2 * (1.f / 256.f) - mu * mu, 0.f), rstd = rsqrtf(var + GN_EPS);
#pragma unroll
            for (int vb = 0; vb < 2; ++vb)
#pragma unroll
                for (int q4 = 0; q4 < 4; ++q4) { const f32x16& y = vb ? y1 : y0; u32x2 w; w.x = pk2((y[4 * q4] - mu) * rstd, (y[4 * q4 + 1] - mu) * rstd); w.y = pk2((y[4 * q4 + 2] - mu) * rstd, (y[4 * q4 + 3] - mu) * rstd);
                    *(LAS u32x2*)(YS + (32 * ib + r32) * YS_STRIDE + (64 * vq + 32 * vb + 8 * q4 + 4 * hi) * 2) = w; }
            __syncthreads();
#pragma unroll
            for (int k = 0; k < 4; ++k) { const u32x4 yw = *(const LAS u32x4*)(YS + orow * YS_STRIDE + 16 * ((tid & 7) + 8 * k)); const u32x4 gw = gv[k];
                u32x4 o; o.x = pk2(silu_f(bflo(gw.x)) * bflo(yw.x), silu_f(bfhi(gw.x)) * bfhi(yw.x)); o.y = pk2(silu_f(bflo(gw.y)) * bflo(yw.y), silu_f(bfhi(gw.y)) * bfhi(yw.y));
                o.z = pk2(silu_f(bflo(gw.z)) * bflo(yw.z), silu_f(bfhi(gw.z)) * bfhi(yw.z)); o.w = pk2(silu_f(bflo(gw.w)) * bflo(yw.w), silu_f(bfhi(gw.w)) * bfhi(yw.w));
                *(u32x4*)(gp + 64 * k) = o; }
        }
        __syncthreads();
    }
}

__device__ __forceinline__ void mixD_conv(const bf16_t* U, bf16_t* UC, const float* cw, const float* cb) {
    const int gt = blockIdx.x * 512 + opaque_tid(), NT = gridDim.x * 512;
    for (int idx = gt; idx < (MTOK / 4) * 128; idx += NT) { const int row0 = (idx >> 7) * 4, c0 = (idx & 127) * 8, s0 = row0 & 2047;
        u32x4 uw[7];
#pragma unroll
        for (int k = 0; k < 7; ++k) { uw[k] = (u32x4){0u, 0u, 0u, 0u}; if (s0 - 3 + k >= 0) uw[k] = *(const u32x4*)(U + (size_t)(row0 - 3 + k) * 1024 + c0); }
        float wv[4][8], bv[8];
#pragma unroll
        for (int e = 0; e < 8; ++e) { bv[e] = cb[c0 + e];
#pragma unroll
            for (int w = 0; w < 4; ++w) wv[w][e] = cw[w * 1024 + c0 + e]; }
#pragma unroll
        for (int r = 0; r < 4; ++r) { float acc[8];
#pragma unroll
            for (int e = 0; e < 8; ++e) acc[e] = bv[e];
#pragma unroll
            for (int w = 0; w < 4; ++w) { const u32x4 x = uw[r + w]; const float uv[8] = {bflo(x.x), bfhi(x.x), bflo(x.y), bfhi(x.y), bflo(x.z), bfhi(x.z), bflo(x.w), bfhi(x.w)};
#pragma unroll
                for (int e = 0; e < 8; ++e) acc[e] += wv[w][e] * uv[e]; }
            u32x4 o; o.x = pk2(acc[0], acc[1]); o.y = pk2(acc[2], acc[3]); o.z = pk2(acc[4], acc[5]); o.w = pk2(acc[6], acc[7]);
            *(u32x4*)(UC + (size_t)(row0 + r) * 1024 + c0) = o; }
    }
}
__device__ __forceinline__ void mixD_scan(LAS unsigned char* lds, const bf16_t* LA, const bf16_t* GU, bf16_t* GG) {
    const int tid = opaque_tid(), lane = tid & 63, wid = __builtin_amdgcn_readfirstlane(tid >> 6);
    LAS float* CP = (LAS float*)(lds + LDS_X_OFF); LAS float* CH = CP + 512;
#pragma unroll 1
    for (int unit = blockIdx.x; unit < 256; unit += gridDim.x) {
        const int b = unit >> 4, ch = (unit & 15) * 64 + lane;
        float carry = 0.f;
#pragma unroll 1
        for (int rd = 0; rd < 8; ++rd) {
            const size_t base = ((size_t)b * 2048 + 256 * rd + 32 * wid) * 1024 + ch;
            float a[32], bb[32], gg[32];
#pragma unroll
            for (int s = 0; s < 32; ++s) { a[s] = __uint_as_float((unsigned)LA[base + (size_t)s * 1024] << 16); bb[s] = __uint_as_float((unsigned)GU[base + (size_t)s * 1024] << 16); gg[s] = __uint_as_float((unsigned)GG[base + (size_t)s * 1024] << 16); }
            float P = 1.f, H = 0.f;
#pragma unroll
            for (int s = 0; s < 32; ++s) { const float av = fast_exp2(a[s] * LOG2E); a[s] = av; bb[s] = sqrtf(fmaxf(1.f - av * av, 0.f)) * bb[s]; H = av * H + bb[s]; P *= av; }
            CP[wid * 64 + lane] = P; CH[wid * 64 + lane] = H;
            __syncthreads();
            float h = carry, hin = 0.f;
#pragma unroll
            for (int w = 0; w < 8; ++w) { if (w == wid) hin = h; h = CP[w * 64 + lane] * h + CH[w * 64 + lane]; }
            carry = h;
            h = hin;
#pragma unroll
            for (int s = 0; s < 32; ++s) { h = a[s] * h + bb[s]; GG[base + (size_t)s * 1024] = (bf16_t)(pk2(gg[s] * h, 0.f) & 0xffff); }
            __syncthreads();
        }
    }
}

constexpr int NWAVES = 8;
__device__ __forceinline__ const void* ldptr(int i) {
    const unsigned long long v = ((volatile LAS unsigned long long*)(LDS_BASE() + PT_OFF))[i];
    const unsigned lo = __builtin_amdgcn_readfirstlane((unsigned)v), hi = __builtin_amdgcn_readfirstlane((unsigned)(v >> 32));
    return (const void*)(((unsigned long long)hi << 32) | lo);
}
#define INF(i) ((const float*)ldptr(i))
#define WSP() ((unsigned char*)ldptr(29))
#define XOUT() ((float*)ldptr(28))
#define RSBUF(ws_, par_) ((float*)((ws_) + WS_SS))
#define GSZ ((int)gridDim.x)
#define BX ((int)blockIdx.x)
__device__ __forceinline__ void grid_bar() {
    XcdBarrier b; b.bar = (unsigned*)(WSP() + WS_CTL) + 1024; b.x = xb_xcc_id(); b.st = (volatile LAS unsigned*)(LDS_BASE() + MISC_OFF) + 8;
    xcd_barrier(b);
}
#define GRID_BAR() grid_bar()

__device__ __forceinline__ void phase_prologue() {
    LAS unsigned char* lds = LDS_BASE();
    const int tid = opaque_tid(), lane = tid & 63, wave = __builtin_amdgcn_readfirstlane(tid >> 6);
    const int gw = BX * NWAVES + wave, NGW = GSZ * NWAVES;
    unsigned char* ws = WSP();
    const float* norm_g = INF(2);
    LAS float* scr = (LAS float*)(lds + wave * 16384); int poff = 0;
    {   const float* ffn_w_in = INF(3); const float* ffn_w_out = INF(4);
        for (int lw = 0; lw < 8; ++lw) {
            const float* g = norm_g + (size_t)((lw >> 1) * 3 + ((lw & 1) ? 2 : 0)) * 1024;
            const float* wi = ffn_w_in + (size_t)lw * 1024 * 5632; const float* wo = ffn_w_out + (size_t)lw * 2816 * 1024;
            prep_matrix((bf16_t*)(ws + W_FUP + lw * SZ_FUP), 5632, 1024, [=](int n, int k) { const int p = n & 255, col = (p >> 7) * 2816 + (n >> 8) * 128 + (p & 127); return LD4(wi + (size_t)k * 5632 + col) * g[k]; }, scr, gw, NGW, lane, poff);
            prep_matrix((bf16_t*)(ws + W_FDN + lw * SZ_FDN), 1024, 2816, [=](int n, int k) { return LD4(wo + (size_t)k * 1024 + n); }, scr, gw, NGW, lane, poff);
        } }
    {
        const float* g = norm_g + (size_t)(0 * 3 + 1) * 1024; const float* w = INF(5); const float* wo = INF(8);
        prep_matrix((bf16_t*)(ws + W_AQK), 6144, 1024, [=](int n, int k) { const int pn = n >> 8, p = n & 255, bj = p >> 7, wc = (p >> 5) & 3, dd = p & 31, isk = pn >= 12 ? 1 : 0;
            const int col = isk * 3072 + (((pn - 12 * isk) * 4 + wc) * 64) + dd + 32 * bj; return LD4(w + (size_t)k * 9216 + col) * g[k]; }, scr, gw, NGW, lane, poff);
        prep_matrix((bf16_t*)(ws + W_AV), 3072, 1024, [=](int n, int k) { return LD4(w + (size_t)k * 9216 + 6144 + n) * g[k]; }, scr, gw, NGW, lane, poff);
        prep_matrix((bf16_t*)(ws + W_AO), 1024, 1024, [=](int n, int k) { return LD4(wo + (size_t)k * 1024 + n); }, scr, gw, NGW, lane, poff);
    }
    {
        const float* g = norm_g + (size_t)(1 * 3 + 1) * 1024; const float* w = INF(9); const float* qag = INF(10); const float* wq = INF(11);
        const float* kvg = INF(12); const float* wkv = INF(13); const float* wo = INF(16);
        prep_matrix((bf16_t*)(ws + W_BIN), 768, 1024, [=](int n, int k) { return n < 672 ? LD4(w + (size_t)k * 672 + n) * g[k] : (f32x4){0.f, 0.f, 0.f, 0.f}; }, scr, gw, NGW, lane, poff);
        prep_matrix((bf16_t*)(ws + W_BQ), 1536, 384, [=](int n, int k) { return LD4(wq + (size_t)k * 1536 + n) * qag[k]; }, scr, gw, NGW, lane, poff);
        prep_matrix((bf16_t*)(ws + W_BK), 1024, 256, [=](int n, int k) { const int pn = n >> 8, p = n & 255, bj = p >> 7, wc = (p >> 5) & 3, dd = p & 31;
            return LD4(wkv + (size_t)k * 2048 + (pn * 4 + wc) * 128 + dd + 32 * bj) * kvg[k]; }, scr, gw, NGW, lane, poff);
        prep_matrix((bf16_t*)(ws + W_BV), 1024, 256, [=](int n, int k) { return LD4(wkv + (size_t)k * 2048 + (n >> 6) * 128 + 64 + (n & 63)) * kvg[k]; }, scr, gw, NGW, lane, poff);
        prep_matrix((bf16_t*)(ws + W_BO), 1024, 1024, [=](int n, int k) { return LD4(wo + (size_t)k * 1024 + n); }, scr, gw, NGW, lane, poff);
    }
    {
        const float* g = norm_g + (size_t)(2 * 3 + 1) * 1024; const float* w = INF(17); const float* wo = INF(18);
        prep_matrix((bf16_t*)(ws + W_CIN), 4096, 1024, [=](int n, int k) { const int pn = n >> 8, p = n & 255; int col;
            if (pn >= 8) col = 4096 + (n - 2048);
            else { const int bj = p >> 7, wc = (p >> 5) & 3, dd = p & 31, isk = pn >> 2, hd = (pn & 3) * 2 + (wc >> 1); col = isk * 1024 + hd * 128 + 32 * (wc & 1) + dd + 64 * bj; }
            return LD4(w + (size_t)k * 6144 + col) * g[k]; }, scr, gw, NGW, lane, poff);
        prep_matrix((bf16_t*)(ws + W_CV), 2048, 1024, [=](int n, int k) { return LD4(w + (size_t)k * 6144 + 2048 + n) * g[k]; }, scr, gw, NGW, lane, poff);
        prep_matrix((bf16_t*)(ws + W_CO), 1024, 2048, [=](int n, int k) { return LD4(wo + (size_t)k * 1024 + n); }, scr, gw, NGW, lane, poff);
    }
    {
        const float* g = norm_g + (size_t)(3 * 3 + 1) * 1024; const float* w = INF(19); const float* wrg = INF(22); const float* wig = INF(24); const float* wo = INF(27);
        prep_matrix((bf16_t*)(ws + W_DIN), 2048, 1024, [=](int n, int k) { return LD4(w + (size_t)k * 2048 + n) * g[k]; }, scr, gw, NGW, lane, poff);
        prep_matrix((bf16_t*)(ws + W_DG), 2048, 256, [=](int n, int k) { const int pn = n >> 8, p = n & 255, bj = p >> 7, chn = pn * 128 + (p & 127), blk = chn >> 8, d = chn & 255;
            const float* src = bj ? wig : wrg; return LD4(src + ((size_t)blk * 256 + k) * 256 + d); }, scr, gw, NGW, lane, poff);
        prep_matrix((bf16_t*)(ws + W_DO), 1024, 1024, [=](int n, int k) { return LD4(wo + (size_t)k * 1024 + n); }, scr, gw, NGW, lane, poff);
    }
    {
        const float* x_in = INF(0); bf16_t* XB = (bf16_t*)(ws + WS_XB); float* SS = (float*)(ws + WS_SS);
        for (int m = gw; m < MTOK; m += NGW) { const f32x4* xr = (const f32x4*)(x_in + (size_t)m * DM) + lane; float s = 0.f;
            unsigned long long* o8 = (unsigned long long*)(XB + (size_t)m * DM) + lane;
#pragma unroll
            for (int j = 0; j < 4; ++j) { const f32x4 v = xr[64 * j]; s += (v.x * v.x + v.y * v.y) + (v.z * v.z + v.w * v.w); o8[64 * j] = (unsigned long long)pk2(v.x, v.y) | ((unsigned long long)pk2(v.z, v.w) << 32); }
            s = wave_sum(s);
            if (lane == 0) *(f32x4*)(SS + (size_t)m * 4) = (f32x4){s, 0.f, 0.f, 0.f}; } }
    {
        const float* lamp = INF(26); float* spt = (float*)(ws + WS_SPD);
        for (int i = BX * 512 + tid; i < 1024; i += GSZ * 512) spt[i] = -8.f * log1pf(expf(-lamp[i]));
    }
    {
        const int* positions = (const int*)ldptr(1);
        float* TAc = (float*)(ws + WS_TA); float* TAs = TAc + (size_t)MTOK * 32;
        float* TBc = (float*)(ws + WS_TB); float* TBs = TBc + (size_t)MTOK * 16;
        float* TCc = (float*)(ws + WS_TC); float* TCs = TCc + (size_t)MTOK * 64;
#define FAST_SC(a_, c_, s_) do { const float rv_ = (a_) * 0.15915494309189535f; const float fr_ = rv_ - floorf(rv_); c_ = __builtin_amdgcn_cosf(fr_); s_ = __builtin_amdgcn_sinf(fr_); } while (0)
        for (int idx = BX * 512 + tid; idx < MTOK * 16; idx += GSZ * 512) { const int row = idx >> 4, i = idx & 15; const float pos = (float)positions[row]; float cv, sv;
            const float inv = exp2f(-(float)i * (13.287712379549449f / 16.f)); FAST_SC(pos * inv, cv, sv); TBc[(size_t)row * 16 + i] = cv; TBs[(size_t)row * 16 + i] = sv; } }
#undef FAST_SC
}

#ifndef DIAG
#define DIAG 0
#endif
#define TIMED(mask, ...) do { if (DIAG & (mask)) { const unsigned long long t0_ = __builtin_amdgcn_s_memrealtime(); __VA_ARGS__; const unsigned long long t1_ = __builtin_amdgcn_s_memrealtime(); \
    while (__builtin_amdgcn_s_memrealtime() - t1_ < t1_ - t0_) __builtin_amdgcn_s_sleep(8); } else { __VA_ARGS__; } } while (0)
__device__ __forceinline__ void phase_ffn(int lw, bool from_input, bool last, int par) {
    TIMED(2,
    {   unsigned char* ws = WSP();
        pg8::Prob g = pg8::make_prob(ws + WS_XB, 1024, ws + W_FUP + (size_t)lw * SZ_FUP, 1024, 1024); pg8::StaticOrder SO; SO.init(MTOK / 256, 22, GSZ, BX);
        EpiSwiGLU E{(bf16_t*)(ws + WS_R), RSBUF(ws, par)};
        pg8::gemm_phase<EpiSwiGLU, true, true>(LDS_BASE(), g, SO, E); }
    GRID_BAR(););
    TIMED(32,
    {   unsigned char* ws = WSP(); float* X = XOUT();
        pg8::Prob g = pg8::make_prob(ws + WS_R, DFF, ws + W_FDN + (size_t)lw * SZ_FDN, DFF, DFF); pg8::StaticOrder SO; SO.init(MTOK / 256, 4, GSZ, BX);
        EpiRes E{from_input ? INF(0) : (const float*)nullptr, last ? X : (float*)nullptr, (bf16_t*)(ws + WS_XB), RSBUF(ws, par), 0.5f};
        pg8::gemm_phase<EpiRes, true, true>(LDS_BASE(), g, SO, E); }
    GRID_BAR(););
}
__device__ __forceinline__ void phase_outproj(size_t a_off, int Kdim, size_t w_off, int par) {
    {   unsigned char* ws = WSP();
        pg8::Prob g = pg8::make_prob(ws + a_off, Kdim, ws + w_off, Kdim, Kdim); pg8::StaticOrder SO; SO.init(MTOK / 256, 4, GSZ, BX);
        EpiRes E{(const float*)nullptr, (float*)nullptr, (bf16_t*)(ws + WS_XB), RSBUF(ws, par), 1.0f};
        pg8::gemm_phase<EpiRes, true, true>(LDS_BASE(), g, SO, E); }
    GRID_BAR();
}

#ifndef TS
#define TS 0
#endif
#define SUBOK(n) (TS == 0 || TS == (n))
__device__ __forceinline__ void phase_mixA(int par) {
    for (int half = 0; half < 2; ++half) {
        const int rowbase = half * 16384;
        if (SUBOK(1)) {   unsigned char* ws = WSP();
            pg8::Prob g = pg8::make_prob(ws + WS_XB + (size_t)rowbase * 2048, 1024, ws + W_AQK, 1024, 1024); pg8::StaticOrder SO; SO.init(64, 24, GSZ, BX);
            EpiAQK E{(bf16_t*)(ws + RA_Q), (bf16_t*)(ws + RA_K), RSBUF(ws, par), INF(6), INF(7), (const int*)ldptr(1), rowbase};
            pg8::gemm_phase<EpiAQK, true, true>(LDS_BASE(), g, SO, E); }
        if (SUBOK(2)) for (int gI = 0; gI < 3; ++gI) {
            unsigned char* ws = WSP();
            const int dsh = 2 * gI, dil = 1 << dsh;
            pg8::Prob g = pg8::make_prob(ws + W_AV + (size_t)gI * 1024 * 1024 * 2, 1024, ws + WS_XB + (size_t)rowbase * 2048, dil * 1024, 1024);
            g.mode = 1; g.dsh = dsh; g.hsB = (dsh == 4) ? (long)1024 * 2 : (long)128 * dil * 1024 * 2;
            pg8::StaticOrder SO; SO.init(4, 64, GSZ, BX);
            EpiVT E{(bf16_t*)(ws + RA_V) + (size_t)gI * 1024 * 16384, (size_t)16384, RSBUF(ws, par), 4, 0, 4, 1024.f, 1, dsh, rowbase, 1};
            pg8::gemm_phase<EpiVT, true, true>(LDS_BASE(), g, SO, E);
        }
        GRID_BAR();
        if (SUBOK(3)) {   unsigned char* ws = WSP(); const float* gq = INF(6); const float* gk = INF(7); const int lane = opaque_tid() & 63;
            const float shift = 11.541560327111707f * wave_max(fabsf(gq[lane])) * wave_max(fabsf(gk[lane]));
            mixA_attn(LDS_BASE(), (const bf16_t*)(ws + RA_Q), (const bf16_t*)(ws + RA_K), (const bf16_t*)(ws + RA_V), (bf16_t*)(ws + RA_O), half, shift); }
        GRID_BAR();
    }
    phase_outproj(RA_O, 1024, W_AO, par);
}

__device__ __forceinline__ void phase_mixB(int par) {
    if (SUBOK(1)) {   unsigned char* ws = WSP();
        pg8::Prob g = pg8::make_prob(ws + WS_XB, 1024, ws + W_BIN, 1024, 1024); pg8::StaticOrder SO; SO.init(MTOK / 256, 3, GSZ, BX);
        EpiBIn E{(bf16_t*)(ws + RB_CQ), (bf16_t*)(ws + RB_CKV), (float*)(ws + RB_KR), (float*)(ws + RB_SS), RSBUF(ws, par)};
        pg8::gemm_phase<EpiBIn, true, true>(LDS_BASE(), g, SO, E); }
    GRID_BAR();
    if (SUBOK(2)) {   unsigned char* ws = WSP();
        pg8::Prob g = pg8::make_prob(ws + RB_CQ, 384, ws + W_BQ, 384, 384); pg8::StaticOrder SO; SO.init(MTOK / 256, 6, GSZ, BX);
        EpiRowScale E{(bf16_t*)(ws + RB_QR), 1536, (bf16_t*)(ws + RB_QR), 1536, 1 << 30, (const float*)(ws + RB_SS), 32, 0, 12, 384.f, 0};
        pg8::gemm_phase<EpiRowScale, true, true>(LDS_BASE(), g, SO, E); }
    if (SUBOK(3)) {   unsigned char* ws = WSP();
        pg8::Prob g = pg8::make_prob(ws + RB_CKV, 256, ws + W_BK, 256, 256); pg8::StaticOrder SO; SO.init(MTOK / 256, 4, GSZ, BX);
        EpiBK E{(bf16_t*)(ws + RB_KB), (const float*)(ws + RB_SS), (const float*)(ws + RB_KR), INF(15), (const float*)(ws + WS_TB), (const float*)(ws + WS_TB) + (size_t)MTOK * 16};
        pg8::gemm_phase<EpiBK, true, true>(LDS_BASE(), g, SO, E); }
    if (SUBOK(4)) {   unsigned char* ws = WSP();
        pg8::Prob g = pg8::make_prob(ws + W_BV, 256, ws + RB_CKV, 256, 256); pg8::StaticOrder SO; SO.init(4, MTOK / 256, GSZ, BX);
        EpiVT E{(bf16_t*)(ws + RB_VT), (size_t)MTOK, (const float*)(ws + RB_SS), 32, 12, 8, 256.f, 0, 0, 0, 0};
        pg8::gemm_phase<EpiVT, true, true>(LDS_BASE(), g, SO, E); }
    GRID_BAR();
    if (SUBOK(5)) {   unsigned char* ws = WSP(); const float* gq = INF(14); const float* gk = INF(15); const int lane = opaque_tid() & 63;
        const float mq = wave_max(fmaxf(fabsf(gq[lane]), fabsf(gq[64 + (lane & 31)]))), mk = wave_max(fmaxf(fabsf(gk[lane]), fabsf(gk[64 + (lane & 31)])));
        const float shift = 14.134834215227234f * mq * mk;
        mixB_attn(LDS_BASE(), (const bf16_t*)(ws + RB_QR), (const bf16_t*)(ws + RB_KB), (const bf16_t*)(ws + RB_VT), (bf16_t*)(ws + RB_O), gq, (const float*)(ws + WS_TB), (const float*)(ws + WS_TB) + (size_t)MTOK * 16, shift); }
    GRID_BAR();
    phase_outproj(RB_O, 1024, W_BO, par);
}

__device__ __forceinline__ void phase_mixC(int par) {
    if (SUBOK(1)) {   unsigned char* ws = WSP();
        pg8::Prob g = pg8::make_prob(ws + WS_XB, 1024, ws + W_CIN, 1024, 1024); pg8::StaticOrder SO; SO.init(MTOK / 256, 16, GSZ, BX);
        EpiCIn E{(bf16_t*)(ws + RC_Q), (bf16_t*)(ws + RC_K), (bf16_t*)(ws + RC_G), RSBUF(ws, par), (const int*)ldptr(1)};
        pg8::gemm_phase<EpiCIn, true, true>(LDS_BASE(), g, SO, E); }
    if (SUBOK(2)) {   unsigned char* ws = WSP();
        pg8::Prob g = pg8::make_prob(ws + W_CV, 1024, ws + WS_XB, 1024, 1024); pg8::StaticOrder SO; SO.init(8, MTOK / 256, GSZ, BX);
        EpiVT E{(bf16_t*)(ws + RC_VT), (size_t)MTOK, RSBUF(ws, par), 4, 0, 4, 1024.f, 0, 0, 0, 1};
        pg8::gemm_phase<EpiVT, true, true>(LDS_BASE(), g, SO, E); }
    GRID_BAR();
    if (SUBOK(3)) {   unsigned char* ws = WSP();
        mixC_retention(LDS_BASE(), (const bf16_t*)(ws + RC_Q), (const bf16_t*)(ws + RC_K), (const bf16_t*)(ws + RC_VT), (bf16_t*)(ws + RC_G)); }
    GRID_BAR();
    phase_outproj(RC_G, 2048, W_CO, par);
}

__device__ __forceinline__ void phase_mixD(int par) {
    {   unsigned char* ws = WSP();
        pg8::Prob g = pg8::make_prob(ws + WS_XB, 1024, ws + W_DIN, 1024, 1024); pg8::StaticOrder SO; SO.init(MTOK / 256, 8, GSZ, BX);
        EpiRowScale E{(bf16_t*)(ws + RD_GG), 1024, (bf16_t*)(ws + RD_U), 1024, 1024, RSBUF(ws, par), 4, 0, 4, 1024.f, 1};
        pg8::gemm_phase<EpiRowScale, true, true>(LDS_BASE(), g, SO, E); }
    GRID_BAR();
    {   unsigned char* ws = WSP(); mixD_conv((const bf16_t*)(ws + RD_U), (bf16_t*)(ws + RD_UC), INF(20), INF(21)); }
    GRID_BAR();
    {   unsigned char* ws = WSP();
        pg8::Prob g = pg8::make_prob(ws + RD_UC, 1024, ws + W_DG, 256, 256); g.mode = 2; pg8::StaticOrder SO; SO.init(MTOK / 256, 8, GSZ, BX);
        EpiDGate E{(bf16_t*)(ws + RD_LA), (bf16_t*)(ws + RD_GU), (const bf16_t*)(ws + RD_UC), INF(23), INF(25), (const float*)(ws + WS_SPD)};
        pg8::gemm_phase<EpiDGate, true, true>(LDS_BASE(), g, SO, E); }
    GRID_BAR();
    {   unsigned char* ws = WSP(); mixD_scan(LDS_BASE(), (const bf16_t*)(ws + RD_LA), (const bf16_t*)(ws + RD_GU), (bf16_t*)(ws + RD_GG)); }
    GRID_BAR();
    phase_outproj(RD_GG, 1024, W_DO, par);
}

__global__ void __launch_bounds__(NWAVES * 64, 2) fwd_kernel(Args args) {
    {
        LAS unsigned char* lds = LDS_BASE();
        const int tid = threadIdx.x;
        for (int u = tid; u < (LDS_BYTES - MISC_OFF) / 4; u += NWAVES * 64) ((LAS unsigned*)(lds + MISC_OFF))[u] = 0u;
        __syncthreads();
        const unsigned long long* ka = (const unsigned long long*)__builtin_amdgcn_kernarg_segment_ptr();
        if (tid < 30) ((LAS unsigned long long*)(lds + PT_OFF))[tid] = ka[tid];
        __syncthreads();
        (void)xcd_barrier_post((unsigned*)(WSP() + WS_CTL) + 1024, (volatile LAS unsigned*)(lds + MISC_OFF) + 8);
    }
#ifndef TP
#define TP 0
#endif
    if (TP == 0 || TP == 1) { TIMED(1, phase_prologue(); GRID_BAR();); }
    if (TP == 0 || TP == 2) phase_ffn(0, true, false, 0);
    if (TP == 0 || TP == 3) { TIMED(4, phase_mixA(1);); }
    if (TP == 0) { phase_ffn(1, false, false, 0); phase_ffn(2, false, false, 1); }
    if (TP == 0 || TP == 4) { TIMED(8, phase_mixB(0);); }
    if (TP == 0) { phase_ffn(3, false, false, 1); phase_ffn(4, false, false, 0); }
    if (TP == 0 || TP == 5) { TIMED(16, phase_mixC(1);); }
    if (TP == 0) { phase_ffn(5, false, false, 0); phase_ffn(6, false, false, 1); }
    if (TP == 0 || TP == 6) { TIMED(64, phase_mixD(0);); }
    if (TP == 0) phase_ffn(7, false, true, 1);
}

extern "C" void kernel_launch(void* const* d_in, const int* in_sizes, int n_in, void* d_out, int out_size, void* d_ws, size_t ws_size, hipStream_t stream) {
    static int grid = 0;
    if (grid == 0) {
        if (n_in != 28 || out_size != MTOK * DM || ws_size < WS_NEED) { fprintf(stderr, "kernel_launch: unexpected shapes: n_in %d out %d ws %zu (need %zu)\n", n_in, out_size, ws_size, (size_t)WS_NEED); grid = -1; return; }
        int dev = 0, cus = 0, per_cu = 0;
        if (hipGetDevice(&dev) != hipSuccess || hipDeviceGetAttribute(&cus, hipDeviceAttributeMultiprocessorCount, dev) != hipSuccess) { grid = -1; return; }
        if (hipFuncSetAttribute((const void*)fwd_kernel, hipFuncAttributeMaxDynamicSharedMemorySize, LDS_BYTES) != hipSuccess) { fprintf(stderr, "kernel_launch: hipFuncSetAttribute failed\n"); grid = -1; return; }
        if (hipOccupancyMaxActiveBlocksPerMultiprocessor(&per_cu, (const void*)fwd_kernel, NWAVES * 64, LDS_BYTES) != hipSuccess || per_cu < 1) fprintf(stderr, "kernel_launch: occupancy query says %d\n", per_cu);
        (void)hipGetLastError();
        grid = cus;
    }
    if (grid < 0) return;
    (void)hipMemsetAsync((char*)d_ws + WS_CTL, 0, CTL_ZERO_BYTES, stream);
    Args a{};
    for (int i = 0; i < 28; ++i) a.in[i] = d_in[i];
    a.out = (float*)d_out; a.ws = (unsigned char*)d_ws;
    hipLaunchKernelGGL(fwd_kernel, dim3(grid), dim3(NWAVES * 64), LDS_BYTES, stream, a);
    const hipError_t le = hipPeekAtLastError();
    if (le != hipSuccess) fprintf(stderr, "kernel_launch: launch failed: %s\n", hipGetErrorName(le));
}
```

```cpp
#include <hip/hip_runtime.h>
#include <cstdio>
#include <cstdint>
#include <cmath>

#define LAS __attribute__((address_space(3)))
#define GAS __attribute__((address_space(1)))
typedef unsigned short bf16_t;
typedef short bf16x8 __attribute__((ext_vector_type(8)));
typedef float f32x4 __attribute__((ext_vector_type(4)));
typedef float f32x16 __attribute__((ext_vector_type(16)));
typedef unsigned u32x4 __attribute__((ext_vector_type(4)));
typedef unsigned u32x2 __attribute__((ext_vector_type(2)));
typedef float f32x2_t __attribute__((ext_vector_type(2)));
typedef __bf16 bf16x2_t __attribute__((ext_vector_type(2)));

constexpr int DM = 1024, NB = 16, SEQ = 2048, MTOK = NB * SEQ, DFF = 2816;
constexpr float NORM_EPS = 1e-6f, GN_EPS = 1e-5f;
constexpr float LOG2E = 1.4426950408889634f;

__device__ __forceinline__ unsigned pk2(float lo, float hi) { f32x2_t v = {lo, hi}; bf16x2_t b = __builtin_convertvector(v, bf16x2_t); return __builtin_bit_cast(unsigned, b); }
__device__ __forceinline__ float bflo(unsigned w) { return __uint_as_float(w << 16); }
__device__ __forceinline__ float bfhi(unsigned w) { return __uint_as_float(w & 0xffff0000u); }
__device__ __forceinline__ float fast_exp2(float x) { return __builtin_amdgcn_exp2f(x); }
__device__ __forceinline__ float fast_rcp(float x) { return __builtin_amdgcn_rcpf(x); }
__device__ __forceinline__ float silu_f(float g) { return g * fast_rcp(1.f + fast_exp2(-g * LOG2E)); }
__device__ __forceinline__ float sigmoid_f(float g) { return fast_rcp(1.f + fast_exp2(-g * LOG2E)); }
__device__ __forceinline__ float gelu_tanh_f(float x) {
    const float z = 0.7978845608028654f * (x + 0.044715f * x * x * x);
    const float e = fast_exp2(2.f * LOG2E * z);
    return x * (1.f - fast_rcp(1.f + e));
}
__device__ __forceinline__ float wave_sum(float v) {
#pragma unroll
    for (int o = 1; o < 64; o <<= 1) v += __shfl_xor(v, o);
    return v;
}
__device__ __forceinline__ float wave_max(float v) {
#pragma unroll
    for (int o = 1; o < 64; o <<= 1) v = fmaxf(v, __shfl_xor(v, o));
    return v;
}
__device__ __forceinline__ int opaque_tid() { int t = threadIdx.x; asm volatile("" : "+v"(t)); return t; }
__device__ __forceinline__ void lds_barrier() { asm volatile("s_waitcnt lgkmcnt(0)\n\ts_barrier" ::: "memory"); }
__device__ __forceinline__ int crow(int r, int hi) { return (r & 3) + 8 * (r >> 2) + 4 * hi; }

namespace pg8 {
constexpr int BM = 256, BK = 64, HALF = 128, HTB = HALF * BK * 2, STAGE_BYTES = 8 * HTB, NXCD = 8, WGM = 8;
__host__ __device__ __forceinline__ int lds_byte(int r, int c) { const int st = (r >> 4) * 2 + (c >> 5), rr = r & 15, cc = c & 31, ob = rr * 64 + cc * 2; return st * 1024 + (ob ^ (((ob >> 9) & 1) << 5)); }
__host__ __device__ __forceinline__ void stage_rc(int b, int& R, int& C) { const int st = b / 1024, sb = b % 1024, swz = sb ^ (((sb >> 9) & 1) << 5); R = (st >> 1) * 16 + swz / 64; C = (st & 1) * 32 + (swz % 64) / 2; }
__host__ __device__ __forceinline__ int perm32(int rho) { const int n = rho >> 4, i = rho & 15; return 8 * (i >> 2) + 4 * n + (i & 3); }
struct Unit { int pm, pn; };
struct StaticOrder {
    int nM, nN, nwg, G, c;
    __device__ void init(int nM_, int nN_, int G_, int c_) { nM = nM_; nN = nN_; nwg = nM * nN; G = G_; c = c_; }
    __device__ bool next(int i, Unit& u) const {
        const long L = (long)i * G + c; if (L >= nwg) return false;
        int wgid = (int)L; { const int q = nwg / NXCD, r = nwg % NXCD, xcd = wgid % NXCD, off = wgid / NXCD; wgid = (xcd < r ? xcd * (q + 1) : r * (q + 1) + (xcd - r) * q) + off; }
        const int nig = WGM * nN, gid = wgid / nig, fm = gid * WGM, gsz = (nM - fm) < WGM ? (nM - fm) : WGM;
        u.pm = fm + ((wgid % nig) % gsz); u.pn = (wgid % nig) / gsz; return true;
    }
};
struct Prob {
    const char* A; const char* B; int K, lda, ldb; long hsA, hsB, tsA, tsB; int mode, dsh;
    __device__ __forceinline__ const char* a_ptr(const Unit& u) const { const char* p = A + (long)u.pm * tsA; if (mode == 2) p += (long)(u.pn >> 1) * 512; return p; }
    __device__ __forceinline__ const char* b_ptr(const Unit& u) const {
        if (mode == 1) { const int b = u.pn >> 3, tt = u.pn & 7; int tok0;
            if (dsh == 0) tok0 = 256 * tt; else if (dsh == 2) tok0 = 4 * ((tt & 1) * 256) + (tt >> 1); else tok0 = 2 * tt;
            return B + ((long)b * SEQ + tok0) * (DM * 2); }
        return B + (long)u.pn * tsB; }
};
__device__ __forceinline__ Prob make_prob(const void* A, int lda, const void* B, int ldb, int K) {
    Prob p; p.A = (const char*)A; p.B = (const char*)B; p.K = K; p.lda = lda; p.ldb = ldb; p.hsA = (long)HALF * lda * 2; p.hsB = (long)HALF * ldb * 2; p.tsA = 2 * p.hsA; p.tsB = 2 * p.hsB; p.mode = 0; p.dsh = 0; return p;
}

template <class Epi, bool ALIGN_EPI, bool SP2>
__device__ __forceinline__ void gemm_phase(LAS unsigned char* lds, const Prob g, const StaticOrder& S, const Epi& E) {
    const int tid = opaque_tid(), wid = __builtin_amdgcn_readfirstlane(tid >> 6), lane = tid & 63, wr = wid >> 2, wc = wid & 3, fr = lane & 15, fq = lane >> 4;
    const int K = g.K, nt = K / BK;
    unsigned voffA[2], voffB[2];
#pragma unroll
    for (int i = 0; i < 2; ++i) { int R, C; stage_rc(tid * 16 + i * 8192, R, C); const int Rb = Epi::PERM ? ((R & ~31) + perm32(R & 31)) : R;
        voffA[i] = (unsigned)(R * g.lda + C) * 2u; voffB[i] = (unsigned)(Rb * g.ldb + C) * 2u; }
    const size_t kstep = (size_t)(BK * 2);
    const long hsA = g.hsA, hsB = g.hsB;
    const unsigned ldsw = (unsigned)wid * 1024u;
    const int aoff = lds_byte(wr * 64 + fr, fq * 8), boff = lds_byte(wc * 32 + fr, fq * 8);
#define PG8_SA(b, h) (((b) * 2 + (h)) * HTB)
#define PG8_SB(b, h) ((4 + (b) * 2 + (h)) * HTB)
#define PG8_STAGE(bufoff, gbase, voff) do { _Pragma("unroll") for (int _i = 0; _i < 2; ++_i) \
        __builtin_amdgcn_global_load_lds((const unsigned*)((const char*)(gbase) + (voff)[_i]), (LAS unsigned*)(lds + (bufoff) + ldsw + _i * 8192), 16, 0, 0); } while (0)
#define PG8_LDA(dst, b, h) do { _Pragma("unroll") for (int m = 0; m < 4; ++m) _Pragma("unroll") for (int k = 0; k < 2; ++k) dst[m][k] = *(const LAS bf16x8*)(lds + PG8_SA(b, h) + aoff + m * 2048 + k * 1024); } while (0)
#define PG8_LDB(dst, b, h) do { _Pragma("unroll") for (int n = 0; n < 2; ++n) _Pragma("unroll") for (int k = 0; k < 2; ++k) dst[n][k] = *(const LAS bf16x8*)(lds + PG8_SB(b, h) + boff + n * 2048 + k * 1024); } while (0)
#define PG8_MMA(ai, bj, At, Bt) do { __builtin_amdgcn_s_setprio(1); _Pragma("unroll") for (int m = 0; m < 4; ++m) _Pragma("unroll") for (int n = 0; n < 2; ++n) _Pragma("unroll") for (int k = 0; k < 2; ++k) \
        acc[ai][bj][m][n] = __builtin_amdgcn_mfma_f32_16x16x32_bf16(Bt[n][k], At[m][k], acc[ai][bj][m][n], 0, 0, 0); __builtin_amdgcn_s_setprio(0); } while (0)
#define PG8_WAIT_V(n) asm volatile("s_waitcnt vmcnt(" #n ")" ::: "memory")
#define PG8_WAIT_L(n) asm volatile("s_waitcnt lgkmcnt(" #n ")" ::: "memory")
#define PG8_BAR __builtin_amdgcn_s_barrier()
#define PG8_SCHED __builtin_amdgcn_sched_barrier(0)
    Unit cur, nxt; int ui = 0;
    if (!S.next(0, cur)) return;
    f32x4 acc[2][2][4][2];
#pragma unroll
    for (int a = 0; a < 2; ++a)
#pragma unroll
        for (int b = 0; b < 2; ++b)
#pragma unroll
            for (int m = 0; m < 4; ++m)
#pragma unroll
                for (int n = 0; n < 2; ++n) acc[a][b][m][n] = (f32x4){0.f, 0.f, 0.f, 0.f};
    bf16x8 At[4][2], B0[2][2], B1[2][2];
    const char* cA = g.a_ptr(cur); const char* cB = g.b_ptr(cur);
    if constexpr (SP2) {
        PG8_STAGE(PG8_SB(0, 0), cB, voffB); PG8_STAGE(PG8_SB(0, 1), cB + hsB, voffB); PG8_STAGE(PG8_SA(0, 0), cA, voffA); PG8_STAGE(PG8_SA(0, 1), cA + hsA, voffA);
        if (wr == 1) PG8_BAR;
        PG8_WAIT_V(2); PG8_BAR;
        PG8_STAGE(PG8_SB(1, 0), cB + kstep, voffB); PG8_STAGE(PG8_SA(1, 0), cA + kstep, voffA); PG8_STAGE(PG8_SB(1, 1), cB + hsB + kstep, voffB);
        PG8_WAIT_V(6); PG8_BAR;
    } else {
        PG8_STAGE(PG8_SB(0, 0), cB, voffB); PG8_STAGE(PG8_SA(0, 0), cA, voffA); PG8_STAGE(PG8_SB(0, 1), cB + hsB, voffB); PG8_STAGE(PG8_SA(0, 1), cA + hsA, voffA);
        if (wr == 1) PG8_BAR;
        PG8_WAIT_V(4); PG8_BAR;
        PG8_STAGE(PG8_SB(1, 0), cB + kstep, voffB); PG8_STAGE(PG8_SA(1, 0), cA + kstep, voffA); PG8_STAGE(PG8_SB(1, 1), cB + hsB + kstep, voffB);
        PG8_WAIT_V(6); PG8_BAR;
    }
    for (;;) {
        const bool has_next = S.next(ui + 1, nxt);
        const char* nA = has_next ? g.a_ptr(nxt) : cA; const char* nB = has_next ? g.b_ptr(nxt) : cB;
        for (int t = 0; t < nt; t += 2) {
            const bool last = (t == nt - 2);
            const char* a1 = cA + (size_t)(t + 1) * kstep;
            const char* a2 = last ? nA : cA + (size_t)(t + 2) * kstep; const char* b2 = last ? nB : cB + (size_t)(t + 2) * kstep;
            const char* a3 = a2 + kstep; const char* b3 = b2 + kstep;
            if constexpr (SP2) {
            PG8_LDB(B0, 0, 0); PG8_LDB(B1, 0, 1); PG8_SCHED; PG8_LDA(At, 0, 0); PG8_STAGE(PG8_SA(1, 1), a1 + hsA, voffA);
            PG8_WAIT_V(8); PG8_WAIT_L(0); PG8_BAR; PG8_MMA(0, 0, At, B0); PG8_MMA(0, 1, At, B1); PG8_BAR; PG8_SCHED;
            PG8_LDA(At, 0, 1); PG8_STAGE(PG8_SB(0, 0), b2, voffB); PG8_STAGE(PG8_SB(0, 1), b2 + hsB, voffB); PG8_STAGE(PG8_SA(0, 0), a2, voffA);
            PG8_WAIT_V(8); PG8_WAIT_L(0); PG8_BAR; PG8_MMA(1, 0, At, B0); PG8_MMA(1, 1, At, B1); PG8_BAR; PG8_SCHED;
            PG8_LDB(B0, 1, 0); PG8_LDB(B1, 1, 1); PG8_SCHED; PG8_LDA(At, 1, 0); PG8_STAGE(PG8_SA(0, 1), a2 + hsA, voffA);
            PG8_WAIT_V(8); PG8_WAIT_L(0); PG8_BAR; PG8_MMA(0, 0, At, B0); PG8_MMA(0, 1, At, B1); PG8_BAR; PG8_SCHED;
            PG8_LDA(At, 1, 1); PG8_STAGE(PG8_SB(1, 0), b3, voffB); PG8_STAGE(PG8_SB(1, 1), b3 + hsB, voffB); PG8_STAGE(PG8_SA(1, 0), a3, voffA);
            PG8_WAIT_V(8); PG8_WAIT_L(0); PG8_BAR; PG8_MMA(1, 0, At, B0); PG8_MMA(1, 1, At, B1); PG8_BAR; PG8_SCHED;
            } else {
            PG8_LDB(B0, 0, 0); PG8_SCHED; PG8_LDA(At, 0, 0); PG8_STAGE(PG8_SA(1, 1), a1 + hsA, voffA);
            PG8_WAIT_L(8); PG8_BAR; PG8_WAIT_L(0); PG8_MMA(0, 0, At, B0); PG8_BAR; PG8_SCHED;
            PG8_LDB(B1, 0, 1); PG8_STAGE(PG8_SB(0, 0), b2, voffB);
            PG8_BAR; PG8_WAIT_L(0); PG8_MMA(0, 1, At, B1); PG8_BAR;
            PG8_LDA(At, 0, 1); PG8_STAGE(PG8_SA(0, 0), a2, voffA);
            PG8_BAR; PG8_WAIT_L(0); PG8_MMA(1, 0, At, B0); PG8_BAR; PG8_SCHED;
            PG8_STAGE(PG8_SB(0, 1), b2 + hsB, voffB);
            PG8_WAIT_V(6); PG8_BAR; PG8_MMA(1, 1, At, B1); PG8_BAR;
            PG8_LDB(B0, 1, 0); PG8_SCHED; PG8_LDA(At, 1, 0); PG8_STAGE(PG8_SA(0, 1), a2 + hsA, voffA);
            PG8_WAIT_L(8); PG8_BAR; PG8_WAIT_L(0); PG8_MMA(0, 0, At, B0); PG8_BAR; PG8_SCHED;
            PG8_LDB(B1, 1, 1); PG8_STAGE(PG8_SB(1, 0), b3, voffB);
            PG8_BAR; PG8_WAIT_L(0); PG8_MMA(0, 1, At, B1); PG8_BAR;
            PG8_LDA(At, 1, 1); PG8_STAGE(PG8_SA(1, 0), a3, voffA);
            PG8_BAR; PG8_WAIT_L(0); PG8_MMA(1, 0, At, B0); PG8_BAR; PG8_SCHED;
            PG8_STAGE(PG8_SB(1, 1), b3 + hsB, voffB);
            PG8_WAIT_V(6); PG8_BAR; PG8_MMA(1, 1, At, B1); PG8_BAR;
            }
        }
        if constexpr (ALIGN_EPI) { if (wr == 0) PG8_BAR; }
        E(acc, cur, wr, wc, fr, fq);
        if (!has_next) break;
#pragma unroll
        for (int a = 0; a < 2; ++a)
#pragma unroll
            for (int b = 0; b < 2; ++b)
#pragma unroll
                for (int m = 0; m < 4; ++m)
#pragma unroll
                    for (int n = 0; n < 2; ++n) acc[a][b][m][n] = (f32x4){0.f, 0.f, 0.f, 0.f};
        cur = nxt; cA = nA; cB = nB; ++ui;
        if constexpr (ALIGN_EPI) { if (wr == 1) PG8_BAR; }
    }
    PG8_WAIT_V(0);
    if constexpr (!ALIGN_EPI) { if (wr == 0) PG8_BAR; }
    PG8_BAR;
#undef PG8_SA
#undef PG8_SB
#undef PG8_STAGE
#undef PG8_LDA
#undef PG8_LDB
#undef PG8_MMA
#undef PG8_WAIT_V
#undef PG8_WAIT_L
#undef PG8_BAR
#undef PG8_SCHED
}
}
typedef f32x4 AccT[2][2][4][2];

#define XB_TMO      128
#define XB_XCNT(j)  (256  + 64 * (j))
#define XB_XSUB(j)  (1280 + 64 * (j))
#define XB_XGEN(j)  (2304 + 64 * (j))
#define XB_TOP      3328
#define XB_TOPGEN   3392
#define XCD_BAR_WORDS 3456
#define XB_SPIN_CAP (1u << 18)
__device__ __forceinline__ unsigned xb_ld(unsigned* p)              { return __hip_atomic_load(p, __ATOMIC_RELAXED, __HIP_MEMORY_SCOPE_AGENT); }
__device__ __forceinline__ unsigned xb_add(unsigned* p, unsigned v) { return __hip_atomic_fetch_add(p, v, __ATOMIC_RELAXED, __HIP_MEMORY_SCOPE_AGENT); }
__device__ __forceinline__ unsigned xb_xcc_id() { return (unsigned)__builtin_amdgcn_s_getreg((3 << 11) | 20) & 0xFu; }
#define XB_SPIN(cond, bar) do { unsigned _sp = 0; while (cond) { __builtin_amdgcn_s_sleep(1); \
    if ((++_sp & 255u) == 0u) { if (xb_ld(&(bar)[XB_TMO])) break; if (_sp > XB_SPIN_CAP) { atomicAdd(&(bar)[XB_TMO], 1u); break; } } } } while (0)
struct XcdBarrier { unsigned* bar; unsigned x; volatile LAS unsigned* st; };
__device__ __forceinline__ XcdBarrier xcd_barrier_post(unsigned* bar, volatile LAS unsigned* st) {
    XcdBarrier b; b.bar = bar; b.x = xb_xcc_id(); b.st = st;
    if (threadIdx.x == 0) (void)xb_add(&bar[XB_XCNT(b.x)], 1u);
    return b;
}
__device__ __forceinline__ void xcd_barrier_complete(unsigned* bar, unsigned x, unsigned& nloc, unsigned& nx) {
    const unsigned G = gridDim.x * gridDim.y * gridDim.z;
    unsigned sum, cnt, mine, sp = 0u;
    for (;;) {
        sum = 0u; cnt = 0u; mine = 0u;
#pragma unroll
        for (unsigned j = 0; j < 16; ++j) { const unsigned c = xb_ld(&bar[XB_XCNT(j)]); sum += c; cnt += (c > 0u) ? 1u : 0u; mine = (j == x) ? c : mine; }
        if (sum == G) break;
        __builtin_amdgcn_s_sleep(1);
        if ((++sp & 255u) == 0u) { if (xb_ld(&bar[XB_TMO])) break; if (sp > XB_SPIN_CAP) { atomicAdd(&bar[XB_TMO], 1u); break; } }
    }
    nloc = mine > 0u ? mine : 1u; nx = cnt > 0u ? cnt : 1u;
}
__device__ __forceinline__ void xcd_barrier(const XcdBarrier& b) {
    asm volatile("s_waitcnt vmcnt(0)" ::: "memory");
    __syncthreads();
    if (threadIdx.x == 0) {
        unsigned* bar = b.bar;
        __builtin_amdgcn_s_waitcnt(0);
        unsigned nloc = b.st[0], nx = b.st[1];
        if (nloc == 0u) { xcd_barrier_complete(bar, b.x, nloc, nx); b.st[0] = nloc; b.st[1] = nx; }
        const unsigned old = xb_add(&bar[XB_XSUB(b.x)], 1u);
        const unsigned gen = old / nloc;
        if (old + 1u == (gen + 1u) * nloc) {
            __builtin_amdgcn_fence(__ATOMIC_RELEASE, "agent");
            asm volatile("s_waitcnt vmcnt(0)" ::: "memory");
            const unsigned og = xb_add(&bar[XB_TOP], 1u);
            const unsigned tg = og / nx;
            if (og + 1u == (tg + 1u) * nx) xb_add(&bar[XB_TOPGEN], 1u);
            else XB_SPIN(xb_ld(&bar[XB_TOPGEN]) == tg, bar);
            __builtin_amdgcn_fence(__ATOMIC_ACQUIRE, "agent");
            xb_add(&bar[XB_XGEN(b.x)], 1u);
            asm volatile("s_waitcnt vmcnt(0)" ::: "memory");
        } else {
            XB_SPIN(xb_ld(&bar[XB_XGEN(b.x)]) == gen, bar);
            __builtin_amdgcn_fence(__ATOMIC_ACQUIRE, "agent");
            asm volatile("s_waitcnt vmcnt(0)" ::: "memory");
        }
    }
    __syncthreads();
}

constexpr size_t MiB = 1u << 20;
constexpr size_t WS_CTL = 0, CTL_ZERO_BYTES = 64 * 1024, WS_SPD = 128 * 1024;
constexpr size_t SZ_FUP = (size_t)5632 * 1024 * 2, SZ_FDN = (size_t)1024 * 2816 * 2;
constexpr size_t WS_W = 1 * MiB;
constexpr size_t W_FUP = WS_W;
constexpr size_t W_FDN = W_FUP + 8 * SZ_FUP;
constexpr size_t W_AQK = W_FDN + 8 * SZ_FDN;
constexpr size_t W_AV  = W_AQK + (size_t)6144 * 1024 * 2;
constexpr size_t W_AO  = W_AV + (size_t)3072 * 1024 * 2;
constexpr size_t W_BIN = W_AO + (size_t)1024 * 1024 * 2;
constexpr size_t W_BQ  = W_BIN + (size_t)768 * 1024 * 2;
constexpr size_t W_BK  = W_BQ + (size_t)1536 * 384 * 2;
constexpr size_t W_BV  = W_BK + (size_t)1024 * 256 * 2;
constexpr size_t W_BO  = W_BV + (size_t)1024 * 256 * 2;
constexpr size_t W_CIN = W_BO + (size_t)1024 * 1024 * 2;
constexpr size_t W_CV  = W_CIN + (size_t)4096 * 1024 * 2;
constexpr size_t W_CO  = W_CV + (size_t)2048 * 1024 * 2;
constexpr size_t W_DIN = W_CO + (size_t)1024 * 2048 * 2;
constexpr size_t W_DG  = W_DIN + (size_t)2048 * 1024 * 2;
constexpr size_t W_DO  = W_DG + (size_t)2048 * 256 * 2;
constexpr size_t W_END = W_DO + (size_t)1024 * 1024 * 2;
constexpr size_t WS_XB = ((W_END + MiB - 1) / MiB) * MiB;
constexpr size_t WS_SS = WS_XB + (size_t)MTOK * DM * 2;
constexpr size_t WS_TA = WS_SS + (size_t)MTOK * 16 * 4;
constexpr size_t WS_TB = WS_TA + (size_t)MTOK * 32 * 4 * 2;
constexpr size_t WS_TC = WS_TB + (size_t)MTOK * 16 * 4 * 2;
constexpr size_t WS_R  = WS_TC + (size_t)MTOK * 64 * 4 * 2;
constexpr size_t SZ_AH = (size_t)3 * 8 * 16 * 2048 * 64 * 2;
constexpr size_t RA_Q = WS_R, RA_K = RA_Q + SZ_AH, RA_V = RA_K + SZ_AH, RA_O = RA_V + SZ_AH, RA_END = RA_O + (size_t)MTOK * DM * 2;
constexpr size_t RB_CQ = WS_R, RB_CKV = RB_CQ + (size_t)MTOK * 384 * 2, RB_KR = RB_CKV + (size_t)MTOK * 256 * 2, RB_SS = RB_KR + (size_t)MTOK * 32 * 4,
                 RB_QR = RB_SS + (size_t)MTOK * 32 * 4, RB_KB = RB_QR + (size_t)MTOK * 1536 * 2, RB_VT = RB_KB + (size_t)MTOK * 1536 * 2, RB_O = RB_VT + (size_t)MTOK * 1024 * 2, RB_END = RB_O + (size_t)MTOK * 1024 * 2;
constexpr size_t RC_Q = WS_R, RC_K = RC_Q + (size_t)MTOK * 1024 * 2, RC_G = RC_K + (size_t)MTOK * 1024 * 2, RC_VT = RC_G + (size_t)MTOK * 2048 * 2, RC_END = RC_VT + (size_t)MTOK * 2048 * 2;
constexpr size_t RD_GG = WS_R, RD_U = RD_GG + (size_t)MTOK * 1024 * 2, RD_UC = RD_U + (size_t)MTOK * 1024 * 2, RD_LA = RD_UC + (size_t)MTOK * 1024 * 2, RD_GU = RD_LA + (size_t)MTOK * 1024 * 4, RD_END = RD_GU + (size_t)MTOK * 1024 * 2;
constexpr size_t WS_NEED = RC_END > RA_END ? (RC_END > RB_END ? RC_END : RB_END) : (RA_END > RB_END ? RA_END : RB_END);
static_assert(RD_END <= WS_NEED && WS_R + (size_t)MTOK * DFF * 2 <= WS_NEED, "ws map");
static_assert(WS_NEED <= (size_t)738197504, "workspace must fit 4x the largest input");

constexpr int RING_BYTES = 131072, LDS_X_OFF = RING_BYTES, LDS_X_BYTES = 8192, MISC_OFF = LDS_X_OFF + LDS_X_BYTES, PT_OFF = MISC_OFF + 256, LDS_BYTES = 147456;

struct Args { const void* in[28]; float* out; unsigned char* ws; };

extern __shared__ __attribute__((aligned(16))) unsigned char lds_dyn[];
#define LDS_BASE() ((LAS unsigned char*)lds_dyn)
__device__ __forceinline__ float sum16(const float* p) {
    const f32x4 a = ((const GAS f32x4*)p)[0], b = ((const GAS f32x4*)p)[1], c = ((const GAS f32x4*)p)[2], d = ((const GAS f32x4*)p)[3];
    return ((a.x + a.y) + (a.z + a.w)) + ((b.x + b.y) + (b.z + b.w)) + ((c.x + c.y) + (c.z + c.w)) + ((d.x + d.y) + (d.z + d.w));
}
__device__ __forceinline__ float sum8(const float* p) {
    const f32x4 a = ((const GAS f32x4*)p)[0], b = ((const GAS f32x4*)p)[1];
    return ((a.x + a.y) + (a.z + a.w)) + ((b.x + b.y) + (b.z + b.w));
}
__device__ __forceinline__ float rs_of(const f32x4 s) { return rsqrtf(((s.x + s.y) + (s.z + s.w)) * (1.f / 1024.f) + NORM_EPS); }
__device__ __forceinline__ float row_rs(const float* SS, int row) { return rs_of(*(const GAS f32x4*)(SS + (size_t)row * 4)); }

struct EpiSwiGLU { static constexpr bool PERM = true;
    bf16_t* H; const float* SS;
    __device__ __forceinline__ void operator()(const AccT& acc, const pg8::Unit& u, int wr, int wc, int fr, int fq) const {
        const int row0 = u.pm * 256 + wr * 64 + fr, hcol = u.pn * 128 + wc * 32 + 8 * fq;
        f32x4 ssv[2][4];
#pragma unroll
        for (int ai = 0; ai < 2; ++ai)
#pragma unroll
            for (int m = 0; m < 4; ++m) ssv[ai][m] = *(const GAS f32x4*)(SS + (size_t)(row0 + ai * 128 + m * 16) * 4);
#pragma unroll
        for (int ai = 0; ai < 2; ++ai)
#pragma unroll
            for (int m = 0; m < 4; ++m) { const int row = row0 + ai * 128 + m * 16; const float rs = rs_of(ssv[ai][m]);
                float h[8];
#pragma unroll
                for (int n = 0; n < 2; ++n)
#pragma unroll
                    for (int j = 0; j < 4; ++j) { const float g = acc[ai][0][m][n][j] * rs, up = acc[ai][1][m][n][j] * rs; h[4 * n + j] = silu_f(g) * up; }
                u32x4 w; w.x = pk2(h[0], h[1]); w.y = pk2(h[2], h[3]); w.z = pk2(h[4], h[5]); w.w = pk2(h[6], h[7]);
                *(GAS u32x4*)(H + (size_t)row * DFF + hcol) = w; }
    }
};
struct EpiRes { static constexpr bool PERM = true;
    const float* base32; float* out32; bf16_t* XB; float* SS; float alpha;
    __device__ __forceinline__ void operator()(const AccT& acc, const pg8::Unit& u, int wr, int wc, int fr, int fq) const {
        const int row0 = u.pm * 256 + wr * 64 + fr, col0 = u.pn * 256 + wc * 32 + 8 * fq;
        LAS float* P = (LAS float*)(LDS_BASE() + LDS_X_OFF);
#pragma unroll
        for (int ai = 0; ai < 2; ++ai) {
            u32x4 xw[4][2];
            if (!base32) {
#pragma unroll
                for (int m = 0; m < 4; ++m)
#pragma unroll
                    for (int bj = 0; bj < 2; ++bj) xw[m][bj] = *(const GAS u32x4*)(XB + (size_t)(row0 + ai * 128 + m * 16) * DM + col0 + bj * 128);
            }
#pragma unroll
            for (int m = 0; m < 4; ++m) { const int row = row0 + ai * 128 + m * 16; float ssq = 0.f;
#pragma unroll
                for (int bj = 0; bj < 2; ++bj) { const size_t off = (size_t)row * DM + col0 + bj * 128;
                    f32x4 b0, b1;
                    if (base32) { b0 = *(const GAS f32x4*)(base32 + off); b1 = *(const GAS f32x4*)(base32 + off + 4); }
                    else { const u32x4 x_ = xw[m][bj]; b0 = (f32x4){bflo(x_.x), bfhi(x_.x), bflo(x_.y), bfhi(x_.y)}; b1 = (f32x4){bflo(x_.z), bfhi(x_.z), bflo(x_.w), bfhi(x_.w)}; }
                    const f32x4 x0 = b0 + acc[ai][bj][m][0] * alpha, x1 = b1 + acc[ai][bj][m][1] * alpha;
                    if (out32) { *(GAS f32x4*)(out32 + off) = x0; *(GAS f32x4*)(out32 + off + 4) = x1; }
                    ssq += (x0.x * x0.x + x0.y * x0.y) + (x0.z * x0.z + x0.w * x0.w) + (x1.x * x1.x + x1.y * x1.y) + (x1.z * x1.z + x1.w * x1.w);
                    if (!out32) { u32x4 w; w.x = pk2(x0.x, x0.y); w.y = pk2(x0.z, x0.w); w.z = pk2(x1.x, x1.y); w.w = pk2(x1.z, x1.w);
                        *(GAS u32x4*)(XB + off) = w; } }
                ssq += __shfl_xor(ssq, 16); ssq += __shfl_xor(ssq, 32);
                if (fq == 0) P[(ai * 128 + wr * 64 + m * 16 + fr) * 4 + wc] = ssq; }
        }
        lds_barrier();
        if (wc == 0 && fq == 0) {
#pragma unroll
            for (int ai = 0; ai < 2; ++ai)
#pragma unroll
                for (int m = 0; m < 4; ++m) { const int rl = ai * 128 + wr * 64 + m * 16 + fr; const f32x4 s = *(const LAS f32x4*)(P + rl * 4);
                    ((GAS float*)SS)[(size_t)(u.pm * 256 + rl) * 4 + u.pn] = (s.x + s.y) + (s.z + s.w); }
        }
    }
};
__device__ __forceinline__ void rope4(float pos, const f32x4 inv, f32x4& c, f32x4& s) {
#pragma unroll
    for (int j = 0; j < 4; ++j) { const float rv = (pos * inv[j]) * 0.15915494309189535f; const float fr = rv - floorf(rv); c[j] = __builtin_amdgcn_cosf(fr); s[j] = __builtin_amdgcn_sinf(fr); }
}
struct EpiAQK { static constexpr bool PERM = false;
    bf16_t* Q; bf16_t* Kb; const float* SS; const float* gq; const float* gk; const int* pos; int rowbase;
    __device__ __forceinline__ void operator()(const AccT& acc, const pg8::Unit& u, int wr, int wc, int fr, int fq) const {
        const int isk = u.pn >= 12 ? 1 : 0, hh = (u.pn - 12 * isk) * 4 + wc, g = hh >> 4, h = hh & 15, dsh = 2 * g;
        bf16_t* dst = isk ? Kb : Q; const float* gain = isk ? gk : gq; const float osc = isk ? 1.f : 0.125f * LOG2E;
        f32x4 ga[2][2], inv[2];
#pragma unroll
        for (int bj = 0; bj < 2; ++bj)
#pragma unroll
            for (int n = 0; n < 2; ++n) ga[bj][n] = *(const GAS f32x4*)(gain + 32 * bj + 16 * n + 4 * fq);
#pragma unroll
        for (int n = 0; n < 2; ++n)
#pragma unroll
            for (int j = 0; j < 4; ++j) inv[n][j] = exp2f(-(float)(16 * n + 4 * fq + j) * (13.287712379549449f / 32.f));
        f32x4 ssv[2][4]; float pv[2][4];
#pragma unroll
        for (int ai = 0; ai < 2; ++ai)
#pragma unroll
            for (int m = 0; m < 4; ++m) { const int row = rowbase + u.pm * 256 + ai * 128 + wr * 64 + m * 16 + fr; ssv[ai][m] = *(const GAS f32x4*)(SS + (size_t)row * 4); pv[ai][m] = (float)((const GAS int*)pos)[row]; }
#pragma unroll
        for (int ai = 0; ai < 2; ++ai)
#pragma unroll
            for (int m = 0; m < 4; ++m) { const int rl = u.pm * 256 + ai * 128 + wr * 64 + m * 16 + fr; const float rs = rs_of(ssv[ai][m]);
                f32x4 v[2][2]; float ss = 0.f;
#pragma unroll
                for (int bj = 0; bj < 2; ++bj)
#pragma unroll
                    for (int n = 0; n < 2; ++n) { v[bj][n] = acc[ai][bj][m][n] * rs; ss += (v[bj][n].x * v[bj][n].x + v[bj][n].y * v[bj][n].y) + (v[bj][n].z * v[bj][n].z + v[bj][n].w * v[bj][n].w); }
                ss += __shfl_xor(ss, 16); ss += __shfl_xor(ss, 32);
                const float hs = rsqrtf(ss * (1.f / 64.f) + NORM_EPS) * osc;
                const int bl = rl >> 11, s = rl & 2047, r = s & ((1 << dsh) - 1), j = s >> dsh, tp = r * (2048 >> dsh) + j;
                bf16_t* o = dst + ((size_t)((g * 8 + bl) * 16 + h) * 2048 + tp) * 64;
#pragma unroll
                for (int n = 0; n < 2; ++n) { f32x4 c, sn; rope4(pv[ai][m], inv[n], c, sn);
                    const f32x4 x1 = v[0][n] * ga[0][n] * hs, x2 = v[1][n] * ga[1][n] * hs;
                    const f32x4 o1 = x1 * c - x2 * sn, o2 = x2 * c + x1 * sn;
                    u32x2 w1, w2; w1.x = pk2(o1.x, o1.y); w1.y = pk2(o1.z, o1.w); w2.x = pk2(o2.x, o2.y); w2.y = pk2(o2.z, o2.w);
                    *(GAS u32x2*)(o + 16 * n + 4 * fq) = w1; *(GAS u32x2*)(o + 32 + 16 * n + 4 * fq) = w2; } }
    }
};
struct EpiVT { static constexpr bool PERM = true;
    bf16_t* O; size_t ldo; const float* SS; int sstride, soff, scnt; float sdiv; int mode, dsh, rowtok0; int tiled;
    __device__ __forceinline__ void operator()(const AccT& acc, const pg8::Unit& u, int wr, int wc, int fr, int fq) const {
        int tok0, tstride, thoff;
        if (mode == 1) { const int b = u.pn >> 3, tt = u.pn & 7; int t0;
            if (dsh == 0) { t0 = 256 * tt; tstride = 1; thoff = 128; } else if (dsh == 2) { t0 = 4 * ((tt & 1) * 256) + (tt >> 1); tstride = 4; thoff = 512; } else { t0 = 2 * tt; tstride = 16; thoff = 1; }
            tok0 = rowtok0 + b * SEQ + t0; }
        else { tok0 = u.pn * 256; tstride = 1; thoff = 128; }
        float myv;
        {   const int l = fr + 16 * fq, tok = tok0 + tstride * (32 * wc + (l & 31)) + thoff * (l >> 5); const float* p = SS + (size_t)tok * sstride + soff;
            float s; if (scnt == 4) { const f32x4 q = *(const f32x4*)p; s = (q.x + q.y) + (q.z + q.w); } else s = sum8(p); myv = rsqrtf(s / sdiv + NORM_EPS); }
        float sc[2][8];
#pragma unroll
        for (int bj = 0; bj < 2; ++bj)
#pragma unroll
            for (int e = 0; e < 8; ++e) sc[bj][e] = __shfl(myv, bj * 32 + 8 * fq + e);
#pragma unroll
        for (int ai = 0; ai < 2; ++ai)
#pragma unroll
            for (int m = 0; m < 4; ++m) { const int orow = u.pm * 256 + ai * 128 + wr * 64 + m * 16 + fr;
#pragma unroll
                for (int bj = 0; bj < 2; ++bj) { const f32x4 a0 = acc[ai][bj][m][0], a1 = acc[ai][bj][m][1];
                    u32x4 w; w.x = pk2(a0.x * sc[bj][0], a0.y * sc[bj][1]); w.y = pk2(a0.z * sc[bj][2], a0.w * sc[bj][3]); w.z = pk2(a1.x * sc[bj][4], a1.y * sc[bj][5]); w.w = pk2(a1.z * sc[bj][6], a1.w * sc[bj][7]);
                    const size_t col0 = (size_t)u.pn * 256 + 128 * bj + 32 * wc + 8 * fq;
                    if (tiled) *(GAS u32x4*)(O + ((size_t)(orow >> 5) * (ldo >> 4) + (col0 >> 4)) * 512 + ((((int)col0 >> 3) & 1) * 32 + (orow & 31)) * 8) = w;
                    else *(GAS u32x4*)(O + (size_t)orow * ldo + col0) = w; } }
    }
};
struct EpiBIn { static constexpr bool PERM = true;
    bf16_t* CQ; bf16_t* CKV; float* KR; float* SSB; const float* SS;
    __device__ __forceinline__ void operator()(const AccT& acc, const pg8::Unit& u, int wr, int wc, int fr, int fq) const {
        f32x4 ssv[2][4];
#pragma unroll
        for (int ai = 0; ai < 2; ++ai)
#pragma unroll
            for (int m = 0; m < 4; ++m) ssv[ai][m] = *(const GAS f32x4*)(SS + (size_t)(u.pm * 256 + ai * 128 + wr * 64 + m * 16 + fr) * 4);
#pragma unroll
        for (int ai = 0; ai < 2; ++ai)
#pragma unroll
            for (int m = 0; m < 4; ++m) { const int row = u.pm * 256 + ai * 128 + wr * 64 + m * 16 + fr; const float rs = rs_of(ssv[ai][m]);
#pragma unroll
                for (int bj = 0; bj < 2; ++bj) { const int col = u.pn * 256 + bj * 128 + wc * 32 + 8 * fq;
                    const f32x4 v0 = acc[ai][bj][m][0] * rs, v1 = acc[ai][bj][m][1] * rs;
                    float ss = (v0.x * v0.x + v0.y * v0.y) + (v0.z * v0.z + v0.w * v0.w) + (v1.x * v1.x + v1.y * v1.y) + (v1.z * v1.z + v1.w * v1.w);
                    ss += __shfl_xor(ss, 16); ss += __shfl_xor(ss, 32);
                    if (col < 672) { if (fq == 0) ((GAS float*)SSB)[(size_t)row * 32 + (col >> 5)] = ss;
                        if (col < 640) { u32x4 w; w.x = pk2(v0.x, v0.y); w.y = pk2(v0.z, v0.w); w.z = pk2(v1.x, v1.y); w.w = pk2(v1.z, v1.w);
                            if (col < 384) *(GAS u32x4*)(CQ + (size_t)row * 384 + col) = w; else *(GAS u32x4*)(CKV + (size_t)row * 256 + (col - 384)) = w; }
                        else { *(GAS f32x4*)(KR + (size_t)row * 32 + (col - 640)) = v0; *(GAS f32x4*)(KR + (size_t)row * 32 + (col - 640) + 4) = v1; } } } }
    }
};
struct EpiRowScale { static constexpr bool PERM = true;
    bf16_t* O; int ldo; bf16_t* O2; int ld2; int split; const float* SS; int sstride, soff, scnt; float sdiv; int act;
    __device__ __forceinline__ void operator()(const AccT& acc, const pg8::Unit& u, int wr, int wc, int fr, int fq) const {
#pragma unroll
        for (int ai = 0; ai < 2; ++ai) {
            float rsv[4];
#pragma unroll
            for (int m = 0; m < 4; ++m) { const int row = u.pm * 256 + ai * 128 + wr * 64 + m * 16 + fr;
                const float* p = SS + (size_t)row * sstride + soff; float s; if (scnt == 4) { const f32x4 q = *(const f32x4*)p; s = (q.x + q.y) + (q.z + q.w); } else { s = sum8(p); if (scnt >= 12) s += ((const GAS f32x4*)p)[2].x + ((const GAS f32x4*)p)[2].y + ((const GAS f32x4*)p)[2].z + ((const GAS f32x4*)p)[2].w; }
                rsv[m] = s; }
#pragma unroll
            for (int m = 0; m < 4; ++m) { const int row = u.pm * 256 + ai * 128 + wr * 64 + m * 16 + fr;
                const float rs = rsqrtf(rsv[m] / sdiv + NORM_EPS);
#pragma unroll
                for (int bj = 0; bj < 2; ++bj) { const int col = u.pn * 256 + bj * 128 + wc * 32 + 8 * fq;
                    f32x4 v0 = acc[ai][bj][m][0] * rs, v1 = acc[ai][bj][m][1] * rs;
                    if (act == 1 && col < split) { v0 = (f32x4){gelu_tanh_f(v0.x), gelu_tanh_f(v0.y), gelu_tanh_f(v0.z), gelu_tanh_f(v0.w)}; v1 = (f32x4){gelu_tanh_f(v1.x), gelu_tanh_f(v1.y), gelu_tanh_f(v1.z), gelu_tanh_f(v1.w)}; }
                    u32x4 w; w.x = pk2(v0.x, v0.y); w.y = pk2(v0.z, v0.w); w.z = pk2(v1.x, v1.y); w.w = pk2(v1.z, v1.w);
                    if (col < split) *(GAS u32x4*)(O + (size_t)row * ldo + col) = w; else *(GAS u32x4*)(O2 + (size_t)row * ld2 + (col - split)) = w; } }
        }
    }
};
struct EpiBK { static constexpr bool PERM = false;
    bf16_t* KB; const float* SSB; const float* KR; const float* gk; const float* cosT; const float* sinT;
    __device__ __forceinline__ void operator()(const AccT& acc, const pg8::Unit& u, int wr, int wc, int fr, int fq) const {
        const int h = u.pn * 4 + wc;
        f32x4 ga[2][2];
#pragma unroll
        for (int bj = 0; bj < 2; ++bj)
#pragma unroll
            for (int n = 0; n < 2; ++n) ga[bj][n] = *(const GAS f32x4*)(gk + 32 * bj + 16 * n + 4 * fq);
        const f32x4 gr1 = *(const GAS f32x4*)(gk + 64 + 4 * fq), gr2 = *(const GAS f32x4*)(gk + 80 + 4 * fq);
#pragma unroll
        for (int ai = 0; ai < 2; ++ai)
#pragma unroll
            for (int mh = 0; mh < 2; ++mh) {
                f32x4 s0[2], s1[2], kr1[2], kr2[2], cs[2], sv[2]; float ssr[2];
#pragma unroll
                for (int mm = 0; mm < 2; ++mm) { const int row = u.pm * 256 + ai * 128 + wr * 64 + (2 * mh + mm) * 16 + fr; const float* sp = SSB + (size_t)row * 32;
                    s0[mm] = *(const GAS f32x4*)(sp + 12); s1[mm] = *(const GAS f32x4*)(sp + 16); ssr[mm] = ((const GAS float*)sp)[20];
                    kr1[mm] = *(const GAS f32x4*)(KR + (size_t)row * 32 + 4 * fq); kr2[mm] = *(const GAS f32x4*)(KR + (size_t)row * 32 + 16 + 4 * fq);
                    cs[mm] = *(const GAS f32x4*)(cosT + (size_t)row * 16 + 4 * fq); sv[mm] = *(const GAS f32x4*)(sinT + (size_t)row * 16 + 4 * fq); }
#pragma unroll
                for (int mm = 0; mm < 2; ++mm) { const int m = 2 * mh + mm; const int row = u.pm * 256 + ai * 128 + wr * 64 + m * 16 + fr;
                    const float rkv = rsqrtf((((s0[mm].x + s0[mm].y) + (s0[mm].z + s0[mm].w)) + ((s1[mm].x + s1[mm].y) + (s1[mm].z + s1[mm].w))) * (1.f / 256.f) + NORM_EPS);
                    f32x4 v[2][2]; float ss = 0.f;
#pragma unroll
                    for (int bj = 0; bj < 2; ++bj)
#pragma unroll
                        for (int n = 0; n < 2; ++n) { v[bj][n] = acc[ai][bj][m][n] * rkv; ss += (v[bj][n].x * v[bj][n].x + v[bj][n].y * v[bj][n].y) + (v[bj][n].z * v[bj][n].z + v[bj][n].w * v[bj][n].w); }
                    ss += __shfl_xor(ss, 16); ss += __shfl_xor(ss, 32);
                    const float sk = rsqrtf((ss + ssr[mm]) * (1.f / 96.f) + NORM_EPS);
                    const int b = row >> 11, s = row & 2047;
                    bf16_t* o = KB + ((size_t)(b * 16 + h) * 2048 + s) * 96;
#pragma unroll
                    for (int bj = 0; bj < 2; ++bj)
#pragma unroll
                        for (int n = 0; n < 2; ++n) { const f32x4 y = v[bj][n] * ga[bj][n] * sk; u32x2 w; w.x = pk2(y.x, y.y); w.y = pk2(y.z, y.w); *(GAS u32x2*)(o + 32 * bj + 16 * n + 4 * fq) = w; }
                    const f32x4 k1 = kr1[mm] * gr1 * sk, k2 = kr2[mm] * gr2 * sk;
                    const f32x4 o1 = k1 * cs[mm] - k2 * sv[mm], o2 = k2 * cs[mm] + k1 * sv[mm];
                    u32x2 w1, w2; w1.x = pk2(o1.x, o1.y); w1.y = pk2(o1.z, o1.w); w2.x = pk2(o2.x, o2.y); w2.y = pk2(o2.z, o2.w);
                    *(GAS u32x2*)(o + 64 + 4 * fq) = w1; *(GAS u32x2*)(o + 80 + 4 * fq) = w2; }
            }
    }
};
struct EpiCIn { static constexpr bool PERM = false;
    bf16_t* Q; bf16_t* Kc; bf16_t* G; const float* SS; const int* pos;
    __device__ __forceinline__ void operator()(const AccT& acc, const pg8::Unit& u, int wr, int wc, int fr, int fq) const {
        f32x4 ssv[2][4];
#pragma unroll
        for (int ai = 0; ai < 2; ++ai)
#pragma unroll
            for (int m = 0; m < 4; ++m) ssv[ai][m] = *(const GAS f32x4*)(SS + (size_t)(u.pm * 256 + ai * 128 + wr * 64 + m * 16 + fr) * 4);
        if (u.pn >= 8) {
#pragma unroll
            for (int ai = 0; ai < 2; ++ai)
#pragma unroll
                for (int m = 0; m < 4; ++m) { const int row = u.pm * 256 + ai * 128 + wr * 64 + m * 16 + fr; const float rs = rs_of(ssv[ai][m]);
#pragma unroll
                    for (int bj = 0; bj < 2; ++bj)
#pragma unroll
                        for (int n = 0; n < 2; ++n) { const f32x4 v = acc[ai][bj][m][n] * rs; u32x2 w; w.x = pk2(v.x, v.y); w.y = pk2(v.z, v.w);
                            *(GAS u32x2*)(G + (size_t)row * 2048 + (u.pn - 8) * 256 + bj * 128 + wc * 32 + 16 * n + 4 * fq) = w; } }
            return; }
        const int isk = u.pn >= 4 ? 1 : 0, h = (u.pn & 3) * 2 + (wc >> 1);
        bf16_t* dst = isk ? Kc : Q;
        const float lg = log2f(1.f - exp2f(-5.f - (float)h));
        const float ksc = isk ? 0.08838834764831845f : 1.f;
        float pv[2][4]; f32x4 inv[2];
#pragma unroll
        for (int ai = 0; ai < 2; ++ai)
#pragma unroll
            for (int m = 0; m < 4; ++m) pv[ai][m] = (float)((const GAS int*)pos)[u.pm * 256 + ai * 128 + wr * 64 + m * 16 + fr];
#pragma unroll
        for (int n = 0; n < 2; ++n)
#pragma unroll
            for (int j = 0; j < 4; ++j) inv[n][j] = exp2f(-(float)(32 * (wc & 1) + 16 * n + 4 * fq + j) * (13.287712379549449f / 64.f));
#pragma unroll
        for (int ai = 0; ai < 2; ++ai)
#pragma unroll
            for (int m = 0; m < 4; ++m) { const int row = u.pm * 256 + ai * 128 + wr * 64 + m * 16 + fr; const float rs = rs_of(ssv[ai][m]);
                const int b = row >> 11, s = row & 2047, il = s & 127;
                const float dec = fast_exp2((isk ? -(float)(il + 1) : (float)(il + 1)) * lg) * ksc * rs;
                bf16_t* o = dst + ((size_t)(b * 8 + h) * 2048 + s) * 128;
#pragma unroll
                for (int n = 0; n < 2; ++n) { const int i0 = 32 * (wc & 1) + 16 * n + 4 * fq; f32x4 c, sn; rope4(pv[ai][m], inv[n], c, sn);
                    const f32x4 x1 = acc[ai][0][m][n] * dec, x2 = acc[ai][1][m][n] * dec;
                    const f32x4 o1 = x1 * c - x2 * sn, o2 = x2 * c + x1 * sn;
                    u32x2 w1, w2; w1.x = pk2(o1.x, o1.y); w1.y = pk2(o1.z, o1.w); w2.x = pk2(o2.x, o2.y); w2.y = pk2(o2.z, o2.w);
                    *(GAS u32x2*)(o + i0) = w1; *(GAS u32x2*)(o + 64 + i0) = w2; } }
    }
};
struct EpiDGate { static constexpr bool PERM = true;
    bf16_t* LA; bf16_t* GU; const bf16_t* UC; const float* brg; const float* big; const float* lam;
    __device__ __forceinline__ void operator()(const AccT& acc, const pg8::Unit& u, int wr, int wc, int fr, int fq) const {
        const int ch = u.pn * 128 + wc * 32 + 8 * fq;
        u32x4 ucv[2][4];
#pragma unroll
        for (int ai = 0; ai < 2; ++ai)
#pragma unroll
            for (int m = 0; m < 4; ++m) ucv[ai][m] = *(const GAS u32x4*)(UC + (size_t)(u.pm * 256 + ai * 128 + wr * 64 + m * 16 + fr) * 1024 + ch);
        float b1[8], b2[8], sp[8];
#pragma unroll
        for (int e = 0; e < 8; ++e) { b1[e] = ((const GAS float*)brg)[ch + e]; b2[e] = ((const GAS float*)big)[ch + e]; sp[e] = ((const GAS float*)lam)[ch + e]; }
#pragma unroll
        for (int ai = 0; ai < 2; ++ai)
#pragma unroll
            for (int m = 0; m < 4; ++m) { const int row = u.pm * 256 + ai * 128 + wr * 64 + m * 16 + fr;
                const u32x4 uw = ucv[ai][m];
                float uc[8] = {bflo(uw.x), bfhi(uw.x), bflo(uw.y), bfhi(uw.y), bflo(uw.z), bfhi(uw.z), bflo(uw.w), bfhi(uw.w)};
                float la[8], gu[8];
#pragma unroll
                for (int n = 0; n < 2; ++n)
#pragma unroll
                    for (int j = 0; j < 4; ++j) { const int e = 4 * n + j; const float r = sigmoid_f(acc[ai][0][m][n][j] + b1[e]), ig = sigmoid_f(acc[ai][1][m][n][j] + b2[e]);
                        la[e] = sp[e] * r; gu[e] = ig * uc[e]; }
                { u32x4 wl; wl.x = pk2(la[0], la[1]); wl.y = pk2(la[2], la[3]); wl.z = pk2(la[4], la[5]); wl.w = pk2(la[6], la[7]); *(GAS u32x4*)(LA + (size_t)row * 1024 + ch) = wl; }
                u32x4 w; w.x = pk2(gu[0], gu[1]); w.y = pk2(gu[2], gu[3]); w.z = pk2(gu[4], gu[5]); w.w = pk2(gu[6], gu[7]);
                *(GAS u32x4*)(GU + (size_t)row * 1024 + ch) = w; }
    }
};

#define LDS_WAIT() asm volatile("s_waitcnt lgkmcnt(0)" ::: "memory")
template <class F> __device__ __forceinline__ void prep_matrix(bf16_t* Bt, int N, int K, F src4, LAS float* scr, int gw, int NGW, int lane, int& off) {
    const int nblk = N / 32, items = nblk * (K / 64);
    int first = gw - off; if (first < 0) first += NGW;
    off = (off + items) % NGW;
    for (int it = first; it < items; it += NGW) {
        const int kb = it / nblk, nb = it % nblk, k0 = 64 * kb, n0 = 32 * nb;
        const int n4 = (lane & 7) * 4;
#pragma unroll
        for (int i = 0; i < 8; ++i) { const int kk = (lane >> 3) + 8 * i; const f32x4 v = src4(n0 + n4, k0 + kk); LAS float* d = scr + kk * 33 + n4; d[0] = v.x; d[1] = v.y; d[2] = v.z; d[3] = v.w; }
        LDS_WAIT(); asm volatile("" ::: "memory");
        const int c = lane & 7;
#pragma unroll
        for (int j = 0; j < 4; ++j) { const int n = (lane >> 3) + 8 * j; const LAS float* s = scr + (8 * c) * 33 + n;
            u32x4 o; o.x = pk2(s[0 * 33], s[1 * 33]); o.y = pk2(s[2 * 33], s[3 * 33]); o.z = pk2(s[4 * 33], s[5 * 33]); o.w = pk2(s[6 * 33], s[7 * 33]);
            *(u32x4*)(Bt + (size_t)(n0 + n) * K + k0 + 8 * c) = o; }
        LDS_WAIT(); asm volatile("" ::: "memory");
    }
}
#define LD4(p) (*(const f32x4*)(p))

#define MFMA32(a, b, c) __builtin_amdgcn_mfma_f32_32x32x16_bf16((a), (b), (c), 0, 0, 0)
__device__ __forceinline__ bf16x8 mk8(u32x2 lo, u32x2 hi) { u32x4 v = {lo.x, lo.y, hi.x, hi.y}; return __builtin_bit_cast(bf16x8, v); }
__device__ __forceinline__ bf16x8 pack8(const f32x16& p, int ks) {
    u32x4 v; v.x = pk2(p[8 * ks + 0], p[8 * ks + 1]); v.y = pk2(p[8 * ks + 2], p[8 * ks + 3]); v.z = pk2(p[8 * ks + 4], p[8 * ks + 5]); v.w = pk2(p[8 * ks + 6], p[8 * ks + 7]);
    return __builtin_bit_cast(bf16x8, v);
}

__device__ __forceinline__ void mixA_attn(LAS unsigned char* lds, const bf16_t* QA, const bf16_t* KA, const bf16_t* VT, bf16_t* OA, int half, float shift) {
    const int tid = opaque_tid(), lane = tid & 63, wid = __builtin_amdgcn_readfirstlane(tid >> 6), r32 = lane & 31, hi = lane >> 5;
    LAS float* Ol = (LAS float*)lds; LAS float* Ll = (LAS float*)(lds + LDS_X_OFF);
#pragma unroll 1
    for (int unit = blockIdx.x; unit < 512; unit += gridDim.x) {
        const int bl = unit >> 6, h = (unit >> 2) & 15, c = unit & 3;
#pragma unroll 1
        for (int g = 0; g < 3; ++g) {
            const int dsh = 2 * g, L = 2048 >> dsh, tsh = 4 - dsh;
            const size_t hb = ((size_t)((g * 8 + bl) * 16 + h)) * 2048;
            const bf16_t* vbase = VT + ((size_t)(g * 1024 + h * 64)) * 16384 + (size_t)bl * 2048;
#pragma unroll 1
            for (int tt = 0; tt < 2; ++tt) {
                const int tau = 2 * wid + tt, r = tau >> tsh, a = (c << tsh) + (tau & ((1 << tsh) - 1));
                const size_t rb = hb + (size_t)r * L;
                bf16x8 qf[4];
#pragma unroll
                for (int d0 = 0; d0 < 4; ++d0) qf[d0] = *(const bf16x8*)(QA + (rb + 32 * a + r32) * 64 + 16 * d0 + 8 * hi);
                f32x16 o0 = {}, o1 = {}; float lsum = 0.f;
                const int kb0 = a - 4 < 0 ? 0 : a - 4;
                const bf16_t* kp0 = KA + (rb + r32) * 64 + 8 * hi;
                const bf16_t* vp0 = VT + ((size_t)(g * 32 + 2 * h) * 1024 + (size_t)((bl * 2048 + r * L) >> 4)) * 512 + r32 * 8 + 4 * hi;
                bf16x8 kf[4]; u32x2 vl[2][2][2];
#define A_LOAD(KF, VL, kb_) do { _Pragma("unroll") for (int d0 = 0; d0 < 4; ++d0) KF[d0] = *(const bf16x8*)(kp0 + (size_t)(32 * (kb_)) * 64 + 16 * d0); \
                    _Pragma("unroll") for (int db = 0; db < 2; ++db) _Pragma("unroll") for (int ks = 0; ks < 2; ++ks) { const bf16_t* f_ = vp0 + ((size_t)db * 1024 + 2 * (kb_) + ks) * 512; VL[db][ks][0] = *(const u32x2*)(f_); VL[db][ks][1] = *(const u32x2*)(f_ + 256); } } while (0)
                A_LOAD(kf, vl, kb0);
#pragma unroll 1
                for (int kb = kb0; kb <= a; ++kb) {
                    bf16x8 kfn[4]; u32x2 vln[2][2][2];
                    const int kbn = kb < a ? kb + 1 : kb;
                    A_LOAD(kfn, vln, kbn);
                    f32x16 st = {};
#pragma unroll
                    for (int d0 = 0; d0 < 4; ++d0) st = MFMA32(kf[d0], qf[d0], st);
                    const int thi = ((kb == a) ? r32 : 63) - 4 * hi, tlo = ((kb == a - 4) ? r32 : -1) - 4 * hi;
#pragma unroll
                    for (int rr = 0; rr < 16; ++rr) { const int kc = (rr & 3) + 8 * (rr >> 2); const bool ok = (kc <= thi) && (kc >= tlo);
                        const float p = ok ? fast_exp2(st[rr] - shift) : 0.f; st[rr] = p; lsum += p; }
                    const bf16x8 p0 = pack8(st, 0), p1 = pack8(st, 1);
                    o0 = MFMA32(mk8(vl[0][0][0], vl[0][0][1]), p0, o0); o0 = MFMA32(mk8(vl[0][1][0], vl[0][1][1]), p1, o0);
                    o1 = MFMA32(mk8(vl[1][0][0], vl[1][0][1]), p0, o1); o1 = MFMA32(mk8(vl[1][1][0], vl[1][1][1]), p1, o1);
#pragma unroll
                    for (int d0 = 0; d0 < 4; ++d0) kf[d0] = kfn[d0];
#pragma unroll
                    for (int db = 0; db < 2; ++db)
#pragma unroll
                        for (int ks = 0; ks < 2; ++ks) { vl[db][ks][0] = vln[db][ks][0]; vl[db][ks][1] = vln[db][ks][1]; }
                }
#undef A_LOAD
                lsum += __shfl_xor(lsum, 32);
                const int pp = ((32 * a + r32) << dsh) + r - 512 * c;
#pragma unroll
                for (int db = 0; db < 2; ++db)
#pragma unroll
                    for (int q4 = 0; q4 < 4; ++q4) { const int ch = 2 * q4 + hi + 8 * db; LAS f32x4* ad = (LAS f32x4*)(Ol + pp * 64 + ((ch ^ (pp & 15)) << 2));
                        const f32x16& o = db ? o1 : o0; f32x4 v = {o[4 * q4], o[4 * q4 + 1], o[4 * q4 + 2], o[4 * q4 + 3]};
                        if (g > 0) v += *ad; *ad = v; }
                if (hi == 0) Ll[pp] = (g > 0 ? Ll[pp] : 0.f) + lsum;
            }
            __syncthreads();
        }
        for (int idx = tid; idx < 4096; idx += 512) { const int pp = idx >> 3, c8 = idx & 7; const float inv = 1.f / Ll[pp];
            const f32x4 a = *(LAS f32x4*)(Ol + pp * 64 + (((2 * c8) ^ (pp & 15)) << 2)), b = *(LAS f32x4*)(Ol + pp * 64 + (((2 * c8 + 1) ^ (pp & 15)) << 2));
            u32x4 w; w.x = pk2(a.x * inv, a.y * inv); w.y = pk2(a.z * inv, a.w * inv); w.z = pk2(b.x * inv, b.y * inv); w.w = pk2(b.z * inv, b.w * inv);
            *(u32x4*)(OA + ((size_t)(half * 8 + bl) * 2048 + 512 * c + pp) * 1024 + h * 64 + 8 * c8) = w; }
        __syncthreads();
    }
}

constexpr int BK_STRIDE = 208, BK_TILE = 64 * BK_STRIDE, BV_STRIDE = 144, BV_TILE = 64 * BV_STRIDE;
__device__ __forceinline__ void mixB_attn(LAS unsigned char* lds, const bf16_t* QR, const bf16_t* KB, const bf16_t* VT, bf16_t* OB, const float* gq, const float* cosT, const float* sinT, float shift) {
    const int tid = opaque_tid(), lane = tid & 63, wid = __builtin_amdgcn_readfirstlane(tid >> 6), r32 = lane & 31, hi = lane >> 5;
    const float qsc = 0.10206207261596575f * LOG2E;
    LAS unsigned char* Kl = lds; LAS unsigned char* Vl = lds + 2 * BK_TILE;
    const int c2 = tid + 512;
    const int kdst1 = (tid / 12) * BK_STRIDE + 16 * (tid % 12), kdst2 = (c2 / 12) * BK_STRIDE + 16 * (c2 % 12);
    const int vd = tid >> 3, c8 = tid & 7, vdst = vd * BV_STRIDE + 2 * (16 * (c8 >> 1) + 4 * (c8 & 1));
    const int kfo = r32 * BK_STRIDE + 16 * hi, vfo = r32 * BV_STRIDE + 16 * hi;
#pragma unroll 1
    for (int unit = blockIdx.x; unit < 256; unit += gridDim.x) {
        const int b = unit >> 4, h = unit & 15;
        const bf16_t* kbase = KB + (size_t)(b * 16 + h) * 2048 * 96;
        const bf16_t* vsrc = VT + (size_t)(h * 64 + vd) * MTOK + (size_t)b * 2048 + 8 * c8;
#pragma unroll 1
        for (int qb = 0; qb < 8; ++qb) {
            const int qfirst = 256 * qb + 32 * wid, row = b * 2048 + qfirst + r32;
            bf16x8 qf[6];
            {   float qv[6][8]; float ss = 0.f;
#pragma unroll
                for (int d0 = 0; d0 < 6; ++d0) { const u32x4 w = *(const u32x4*)(QR + (size_t)row * 1536 + h * 96 + 16 * d0 + 8 * hi);
                    qv[d0][0] = bflo(w.x); qv[d0][1] = bfhi(w.x); qv[d0][2] = bflo(w.y); qv[d0][3] = bfhi(w.y); qv[d0][4] = bflo(w.z); qv[d0][5] = bfhi(w.z); qv[d0][6] = bflo(w.w); qv[d0][7] = bfhi(w.w);
#pragma unroll
                    for (int e = 0; e < 8; ++e) ss += qv[d0][e] * qv[d0][e]; }
                ss += __shfl_xor(ss, 32);
                const float sq = rsqrtf(ss * (1.f / 96.f) + NORM_EPS) * qsc;
#pragma unroll
                for (int d0 = 0; d0 < 6; ++d0)
#pragma unroll
                    for (int e = 0; e < 8; ++e) qv[d0][e] *= sq * gq[16 * d0 + 8 * hi + e];
#pragma unroll
                for (int e = 0; e < 8; ++e) { const float c = cosT[(size_t)row * 16 + 8 * hi + e], sn = sinT[(size_t)row * 16 + 8 * hi + e]; const float x1 = qv[4][e], x2 = qv[5][e];
                    qv[4][e] = x1 * c - x2 * sn; qv[5][e] = x2 * c + x1 * sn; }
#pragma unroll
                for (int d0 = 0; d0 < 6; ++d0) { u32x4 w; w.x = pk2(qv[d0][0], qv[d0][1]); w.y = pk2(qv[d0][2], qv[d0][3]); w.z = pk2(qv[d0][4], qv[d0][5]); w.w = pk2(qv[d0][6], qv[d0][7]); qf[d0] = __builtin_bit_cast(bf16x8, w); }
            }
            f32x16 negs;
#pragma unroll
            for (int rr = 0; rr < 16; ++rr) negs[rr] = -shift;
            f32x16 o0 = {}, o1 = {}; float lsum = 0.f;
            const int ntile = 4 * qb + 4;
            {
                const u32x4 k1 = *(const u32x4*)(kbase + 8 * tid); u32x4 k2 = {}; if (tid < 256) k2 = *(const u32x4*)(kbase + 8 * c2);
                const u32x4 v1 = *(const u32x4*)(vsrc);
                *(LAS u32x4*)(Kl + kdst1) = k1; if (tid < 256) *(LAS u32x4*)(Kl + kdst2) = k2;
                *(LAS u32x2*)(Vl + vdst) = (u32x2){v1.x, v1.y}; *(LAS u32x2*)(Vl + vdst + 16) = (u32x2){v1.z, v1.w};
            }
            __syncthreads();
#pragma unroll 1
            for (int t = 0; t < ntile; ++t) {
                const bool more = (t + 1 < ntile);
                u32x4 k1 = {}, k2 = {}, v1 = {};
                if (more) { const bf16_t* kt = kbase + (size_t)(t + 1) * 64 * 96; k1 = *(const u32x4*)(kt + 8 * tid); if (tid < 256) k2 = *(const u32x4*)(kt + 8 * c2); v1 = *(const u32x4*)(vsrc + 64 * (t + 1)); }
                const LAS unsigned char* Kt = Kl + (t & 1) * BK_TILE; const LAS unsigned char* Vt = Vl + (t & 1) * BV_TILE;
#pragma unroll
                for (int kblk = 0; kblk < 2; ++kblk) {
                    const int key0 = 64 * t + 32 * kblk;
                    if (key0 <= qfirst + 31) {
                        f32x16 st = negs;
#pragma unroll
                        for (int d0 = 0; d0 < 6; ++d0) { const bf16x8 kf = *(const LAS bf16x8*)(Kt + kblk * 32 * BK_STRIDE + kfo + 32 * d0); st = MFMA32(kf, qf[d0], st); }
                        if (key0 + 31 > qfirst) {
                            const int thi = (qfirst - key0 + r32) - 4 * hi;
#pragma unroll
                            for (int rr = 0; rr < 16; ++rr) { const int kc = (rr & 3) + 8 * (rr >> 2); const float p = (kc <= thi) ? fast_exp2(st[rr]) : 0.f; st[rr] = p; lsum += p; }
                        } else {
#pragma unroll
                            for (int rr = 0; rr < 16; ++rr) { const float p = fast_exp2(st[rr]); st[rr] = p; lsum += p; }
                        }
                        const bf16x8 p0 = pack8(st, 0), p1 = pack8(st, 1);
                        const LAS unsigned char* vp = Vt + vfo + 2 * (32 * kblk);
                        o0 = MFMA32(*(const LAS bf16x8*)(vp), p0, o0); o0 = MFMA32(*(const LAS bf16x8*)(vp + 32), p1, o0);
                        o1 = MFMA32(*(const LAS bf16x8*)(vp + 32 * BV_STRIDE), p0, o1); o1 = MFMA32(*(const LAS bf16x8*)(vp + 32 * BV_STRIDE + 32), p1, o1);
                    }
                }
                if (more) { LAS unsigned char* Kn = Kl + ((t + 1) & 1) * BK_TILE; LAS unsigned char* Vn = Vl + ((t + 1) & 1) * BV_TILE;
                    *(LAS u32x4*)(Kn + kdst1) = k1; if (tid < 256) *(LAS u32x4*)(Kn + kdst2) = k2;
                    *(LAS u32x2*)(Vn + vdst) = (u32x2){v1.x, v1.y}; *(LAS u32x2*)(Vn + vdst + 16) = (u32x2){v1.z, v1.w}; }
                __syncthreads();
            }
            lsum += __shfl_xor(lsum, 32);
            const float inv = 1.f / lsum;
            bf16_t* op = OB + (size_t)row * 1024 + h * 64;
#pragma unroll
            for (int db = 0; db < 2; ++db)
#pragma unroll
                for (int q4 = 0; q4 < 4; ++q4) { const f32x16& o = db ? o1 : o0; u32x2 w; w.x = pk2(o[4 * q4] * inv, o[4 * q4 + 1] * inv); w.y = pk2(o[4 * q4 + 2] * inv, o[4 * q4 + 3] * inv);
                    *(u32x2*)(op + 32 * db + 8 * q4 + 4 * hi) = w; }
        }
    }
}

constexpr int KT_STRIDE = 272, RT_STRIDE = 272, YS_STRIDE = 528;
constexpr int RET_KR = 0, RET_YS = 128 * KT_STRIDE, RET_RT = 2 * 128 * KT_STRIDE, RET_ST = MISC_OFF + 1024;
static_assert(RET_YS + 64 * YS_STRIDE <= RET_RT && RET_RT + 256 * RT_STRIDE <= MISC_OFF && RET_ST + 2048 <= LDS_BYTES, "retention LDS map");
typedef short v4i16_t __attribute__((ext_vector_type(4)));
__device__ __forceinline__ u32x2 lds_tr(const LAS unsigned char* p) { return __builtin_bit_cast(u32x2, __builtin_amdgcn_ds_read_tr16_b64_v4i16((LAS v4i16_t*)p)); }
__device__ __forceinline__ void mixC_retention(LAS unsigned char* lds, const bf16_t* QC, const bf16_t* KC, const bf16_t* VT, bf16_t* G) {
    const int tid = opaque_tid(), lane = tid & 63, wid = __builtin_amdgcn_readfirstlane(tid >> 6), r32 = lane & 31, hi = lane >> 5;
    LAS unsigned char* KR = lds + RET_KR; LAS unsigned char* YS = lds + RET_YS; LAS unsigned char* RT = lds + RET_RT; LAS float* ST = (LAS float*)(lds + RET_ST);
    const int trb = (8 * hi + ((lane & 15) >> 2)) * KT_STRIDE + (16 * ((lane >> 4) & 1) + 4 * (lane & 3)) * 2;
#pragma unroll 1
    for (int unit = blockIdx.x; unit < 256; unit += gridDim.x) {
        const int b = unit >> 4, h = (unit >> 1) & 7, rh = unit & 1;
        const int ib = wid & 1, gi = ib ? (3 - rh) : rh, vq = wid >> 1;
        const float lg = log2f(1.f - exp2f(-5.f - (float)h)), cd = exp2f(128.f * lg);
        const size_t bh = (size_t)(b * 8 + h) * 2048;
        f32x16 Racc[4];
#pragma unroll
        for (int db = 0; db < 4; ++db) Racc[db] = (f32x16){};
        const bf16_t* qsrc = QC + (bh + 32 * gi + r32) * 128 + 8 * hi;
        const bf16_t* ksrc = KC + bh * 128 + 8 * tid;
        const bf16_t* vin0 = VT + ((size_t)(h * 8 + 2 * vq) * (MTOK / 16) + (size_t)(b * 128)) * 512 + r32 * 8 + 4 * hi;
        const bf16_t* vup0 = VT + ((size_t)(h * 8 + wid) * (MTOK / 16) + (size_t)(b * 128)) * 512 + (hi * 32 + r32) * 8;
        const int orow = tid >> 3, ogi = (orow >> 5) ? (3 - rh) : rh;
        bf16_t* gp0 = G + ((size_t)b * 2048 + 32 * ogi + (orow & 31)) * 2048 + h * 256 + 8 * (tid & 7);
        u32x4 kst[4]; bf16x8 qf[8];
#pragma unroll
        for (int e = 0; e < 4; ++e) kst[e] = *(const u32x4*)(ksrc + 4096 * e);
#pragma unroll
        for (int s = 0; s < 8; ++s) qf[s] = *(const bf16x8*)(qsrc + 16 * s);
#pragma unroll 1
        for (int c = 0; c < 16; ++c) {
            const int cn = c < 15 ? c + 1 : c;
#pragma unroll
            for (int e = 0; e < 4; ++e) { const int id = tid + 512 * e; *(LAS u32x4*)(KR + (id >> 4) * KT_STRIDE + 16 * (id & 15)) = kst[e]; }
            bf16x8 vupd[8];
#pragma unroll
            for (int s = 0; s < 4; ++s) vupd[s] = *(const bf16x8*)(vup0 + (size_t)(8 * c + s) * 512);
            u32x2 vin[8];
#define C_VIN(dst, jb_) do { const bf16_t* vp_ = vin0 + (size_t)(8 * c + 2 * (jb_)) * 512; const bf16_t* vq_ = vp_ + (size_t)(MTOK / 16) * 512; \
                dst[0] = *(const u32x2*)(vp_); dst[1] = *(const u32x2*)(vp_ + 256); dst[2] = *(const u32x2*)(vp_ + 512); dst[3] = *(const u32x2*)(vp_ + 768); \
                dst[4] = *(const u32x2*)(vq_); dst[5] = *(const u32x2*)(vq_ + 256); dst[6] = *(const u32x2*)(vq_ + 512); dst[7] = *(const u32x2*)(vq_ + 768); } while (0)
            C_VIN(vin, 0);
            __syncthreads();
            f32x16 y0 = {}, y1 = {};
            if (c > 0) {
#pragma unroll
                for (int s = 0; s < 8; ++s) { const bf16x8 a0 = *(const LAS bf16x8*)(RT + (64 * vq + r32) * RT_STRIDE + (16 * s + 8 * hi) * 2), a1 = *(const LAS bf16x8*)(RT + (64 * vq + 32 + r32) * RT_STRIDE + (16 * s + 8 * hi) * 2);
                    y0 = MFMA32(a0, qf[s], y0); y1 = MFMA32(a1, qf[s], y1); }
            }
#pragma unroll 1
            for (int jb = 0; jb <= gi; ++jb) {
                u32x2 vnx[8];
                const int jn = jb < gi ? jb + 1 : jb;
                C_VIN(vnx, jn);
                f32x16 st = {};
#pragma unroll
                for (int s = 0; s < 8; ++s) { const bf16x8 kf = *(const LAS bf16x8*)(KR + (32 * jb + r32) * KT_STRIDE + (16 * s + 8 * hi) * 2); st = MFMA32(kf, qf[s], st); }
                {   const int thi = ((jb == gi) ? r32 : 63) - 4 * hi;
#pragma unroll
                    for (int rr = 0; rr < 16; ++rr) { const int kc = (rr & 3) + 8 * (rr >> 2); st[rr] = (kc <= thi) ? st[rr] : 0.f; } }
                const bf16x8 p0 = pack8(st, 0), p1 = pack8(st, 1);
                y0 = MFMA32(mk8(vin[0], vin[1]), p0, y0); y0 = MFMA32(mk8(vin[2], vin[3]), p1, y0); y1 = MFMA32(mk8(vin[4], vin[5]), p0, y1); y1 = MFMA32(mk8(vin[6], vin[7]), p1, y1);
#pragma unroll
                for (int e = 0; e < 8; ++e) vin[e] = vnx[e];
            }
#undef C_VIN
#pragma unroll
            for (int s = 4; s < 8; ++s) vupd[s] = *(const bf16x8*)(vup0 + (size_t)(8 * c + s) * 512);
#pragma unroll
            for (int s = 0; s < 8; ++s) qf[s] = *(const bf16x8*)(qsrc + (size_t)16384 * cn + 16 * s);
            bf16_t* gp = gp0 + (size_t)262144 * c;
            u32x4 gv[4];
#pragma unroll
            for (int k = 0; k < 4; ++k) gv[k] = *(const u32x4*)(gp + 64 * k);
#pragma unroll
            for (int s = 0; s < 8; ++s) {
#pragma unroll
                for (int db = 0; db < 4; ++db) { const LAS unsigned char* ap = KR + trb + (16 * s) * KT_STRIDE + 64 * db;
                    const bf16x8 af = mk8(lds_tr(ap), lds_tr(ap + 4 * KT_STRIDE)); Racc[db] = MFMA32(af, vupd[s], Racc[db]); } }
#pragma unroll
            for (int db = 0; db < 4; ++db) Racc[db] *= cd;
            float s1 = 0.f, s2 = 0.f;
#pragma unroll
            for (int rr = 0; rr < 16; ++rr) { s1 += y0[rr] + y1[rr]; s2 += y0[rr] * y0[rr] + y1[rr] * y1[rr]; }
            s1 += __shfl_xor(s1, 32); s2 += __shfl_xor(s2, 32);
            __syncthreads();
#pragma unroll
            for (int e = 0; e < 4; ++e) kst[e] = *(const u32x4*)(ksrc + (size_t)16384 * cn + 4096 * e);
#pragma unroll
            for (int db = 0; db < 4; ++db)
#pragma unroll
                for (int q4 = 0; q4 < 4; ++q4) { u32x2 w; w.x = pk2(Racc[db][4 * q4], Racc[db][4 * q4 + 1]); w.y = pk2(Racc[db][4 * q4 + 2], Racc[db][4 * q4 + 3]);
                    *(LAS u32x2*)(RT + (32 * wid + r32) * RT_STRIDE + (32 * db + 8 * q4 + 4 * hi) * 2) = w; }
            if (hi == 0) { ST[((ib * 4 + vq) * 32 + r32) * 2] = s1; ST[((ib * 4 + vq) * 32 + r32) * 2 + 1] = s2; }
            __syncthreads();
            float t1 = 0.f, t2 = 0.f;
#pragma unroll
            for (int q = 0; q < 4; ++q) { t1 += ST[((ib * 4 + q) * 32 + r32) * 2]; t2 += ST[((ib * 4 + q) * 32 + r32) * 2 + 1]; }
            const float mu = t1 * (1.f / 256.f), var = fmaxf(t2 * (1.f / 256.f) - mu * mu, 0.f), rstd = rsqrtf(var + GN_EPS);
#pragma unroll
            for (int vb = 0; vb < 2; ++vb)
#pragma unroll
                for (int q4 = 0; q4 < 4; ++q4) { const f32x16& y = vb ? y1 : y0; u32x2 w; w.x = pk2((y[4 * q4] - mu) * rstd, (y[4 * q4 + 1] - mu) * rstd); w.y = pk2((y[4 * q4 + 2] - mu) * rstd, (y[4 * q4 + 3] - mu) * rstd);
                    *(LAS u32x2*)(YS + (32 * ib + r32) * YS_STRIDE + (64 * vq + 32 * vb + 8 * q4 + 4 * hi) * 2) = w; }
            __syncthreads();
#pragma unroll
            for (int k = 0; k < 4; ++k) { const u32x4 yw = *(const LAS u32x4*)(YS + orow * YS_STRIDE + 16 * ((tid & 7) + 8 * k)); const u32x4 gw = gv[k];
                u32x4 o; o.x = pk2(silu_f(bflo(gw.x)) * bflo(yw.x), silu_f(bfhi(gw.x)) * bfhi(yw.x)); o.y = pk2(silu_f(bflo(gw.y)) * bflo(yw.y), silu_f(bfhi(gw.y)) * bfhi(yw.y));
                o.z = pk2(silu_f(bflo(gw.z)) * bflo(yw.z), silu_f(bfhi(gw.z)) * bfhi(yw.z)); o.w = pk2(silu_f(bflo(gw.w)) * bflo(yw.w), silu_f(bfhi(gw.w)) * bfhi(yw.w));
                *(u32x4*)(gp + 64 * k) = o; }
        }
        __syncthreads();
    }
}

__device__ __forceinline__ void mixD_conv(const bf16_t* U, bf16_t* UC, const float* cw, const float* cb) {
    const int gt = blockIdx.x * 512 + opaque_tid(), NT = gridDim.x * 512;
    for (int idx = gt; idx < (MTOK / 4) * 128; idx += NT) { const int row0 = (idx >> 7) * 4, c0 = (idx & 127) * 8, s0 = row0 & 2047;
        u32x4 uw[7];
#pragma unroll
        for (int k = 0; k < 7; ++k) { uw[k] = (u32x4){0u, 0u, 0u, 0u}; if (s0 - 3 + k >= 0) uw[k] = *(const u32x4*)(U + (size_t)(row0 - 3 + k) * 1024 + c0); }
        float wv[4][8], bv[8];
#pragma unroll
        for (int e = 0; e < 8; ++e) { bv[e] = cb[c0 + e];
#pragma unroll
            for (int w = 0; w < 4; ++w) wv[w][e] = cw[w * 1024 + c0 + e]; }
#pragma unroll
        for (int r = 0; r < 4; ++r) { float acc[8];
#pragma unroll
            for (int e = 0; e < 8; ++e) acc[e] = bv[e];
#pragma unroll
            for (int w = 0; w < 4; ++w) { const u32x4 x = uw[r + w]; const float uv[8] = {bflo(x.x), bfhi(x.x), bflo(x.y), bfhi(x.y), bflo(x.z), bfhi(x.z), bflo(x.w), bfhi(x.w)};
#pragma unroll
                for (int e = 0; e < 8; ++e) acc[e] += wv[w][e] * uv[e]; }
            u32x4 o; o.x = pk2(acc[0], acc[1]); o.y = pk2(acc[2], acc[3]); o.z = pk2(acc[4], acc[5]); o.w = pk2(acc[6], acc[7]);
            *(u32x4*)(UC + (size_t)(row0 + r) * 1024 + c0) = o; }
    }
}
__device__ __forceinline__ void mixD_scan(LAS unsigned char* lds, const bf16_t* LA, const bf16_t* GU, bf16_t* GG) {
    const int tid = opaque_tid(), lane = tid & 63, wid = __builtin_amdgcn_readfirstlane(tid >> 6);
    LAS float* CP = (LAS float*)(lds + LDS_X_OFF); LAS float* CH = CP + 512;
#pragma unroll 1
    for (int unit = blockIdx.x; unit < 256; unit += gridDim.x) {
        const int b = unit >> 4, ch = (unit & 15) * 64 + lane;
        float carry = 0.f;
#pragma unroll 1
        for (int rd = 0; rd < 8; ++rd) {
            const size_t base = ((size_t)b * 2048 + 256 * rd + 32 * wid) * 1024 + ch;
            float a[32], bb[32], gg[32];
#pragma unroll
            for (int s = 0; s < 32; ++s) { a[s] = __uint_as_float((unsigned)LA[base + (size_t)s * 1024] << 16); bb[s] = __uint_as_float((unsigned)GU[base + (size_t)s * 1024] << 16); gg[s] = __uint_as_float((unsigned)GG[base + (size_t)s * 1024] << 16); }
            float P = 1.f, H = 0.f;
#pragma unroll
            for (int s = 0; s < 32; ++s) { const float av = fast_exp2(a[s] * LOG2E); a[s] = av; bb[s] = sqrtf(fmaxf(1.f - av * av, 0.f)) * bb[s]; H = av * H + bb[s]; P *= av; }
            CP[wid * 64 + lane] = P; CH[wid * 64 + lane] = H;
            __syncthreads();
            float h = carry, hin = 0.f;
#pragma unroll
            for (int w = 0; w < 8; ++w) { if (w == wid) hin = h; h = CP[w * 64 + lane] * h + CH[w * 64 + lane]; }
            carry = h;
            h = hin;
#pragma unroll
            for (int s = 0; s < 32; ++s) { h = a[s] * h + bb[s]; GG[base + (size_t)s * 1024] = (bf16_t)(pk2(gg[s] * h, 0.f) & 0xffff); }
            __syncthreads();
        }
    }
}

constexpr int NWAVES = 8;
__device__ __forceinline__ const void* ldptr(int i) {
    const unsigned long long v = ((volatile LAS unsigned long long*)(LDS_BASE() + PT_OFF))[i];
    const unsigned lo = __builtin_amdgcn_readfirstlane((unsigned)v), hi = __builtin_amdgcn_readfirstlane((unsigned)(v >> 32));
    return (const void*)(((unsigned long long)hi << 32) | lo);
}
#define INF(i) ((const float*)ldptr(i))
#define WSP() ((unsigned char*)ldptr(29))
#define XOUT() ((float*)ldptr(28))
#define RSBUF(ws_, par_) ((float*)((ws_) + WS_SS))
#define GSZ ((int)gridDim.x)
#define BX ((int)blockIdx.x)
__device__ __forceinline__ void grid_bar() {
    XcdBarrier b; b.bar = (unsigned*)(WSP() + WS_CTL) + 1024; b.x = xb_xcc_id(); b.st = (volatile LAS unsigned*)(LDS_BASE() + MISC_OFF) + 8;
    xcd_barrier(b);
}
#define GRID_BAR() grid_bar()

__device__ __forceinline__ void phase_prologue() {
    LAS unsigned char* lds = LDS_BASE();
    const int tid = opaque_tid(), lane = tid & 63, wave = __builtin_amdgcn_readfirstlane(tid >> 6);
    const int gw = BX * NWAVES + wave, NGW = GSZ * NWAVES;
    unsigned char* ws = WSP();
    const float* norm_g = INF(2);
    LAS float* scr = (LAS float*)(lds + wave * 16384); int poff = 0;
    {   const float* ffn_w_in = INF(3); const float* ffn_w_out = INF(4);
        for (int lw = 0; lw < 8; ++lw) {
            const float* g = norm_g + (size_t)((lw >> 1) * 3 + ((lw & 1) ? 2 : 0)) * 1024;
            const float* wi = ffn_w_in + (size_t)lw * 1024 * 5632; const float* wo = ffn_w_out + (size_t)lw * 2816 * 1024;
            prep_matrix((bf16_t*)(ws + W_FUP + lw * SZ_FUP), 5632, 1024, [=](int n, int k) { const int p = n & 255, col = (p >> 7) * 2816 + (n >> 8) * 128 + (p & 127); return LD4(wi + (size_t)k * 5632 + col) * g[k]; }, scr, gw, NGW, lane, poff);
            prep_matrix((bf16_t*)(ws + W_FDN + lw * SZ_FDN), 1024, 2816, [=](int n, int k) { return LD4(wo + (size_t)k * 1024 + n); }, scr, gw, NGW, lane, poff);
        } }
    {
        const float* g = norm_g + (size_t)(0 * 3 + 1) * 1024; const float* w = INF(5); const float* wo = INF(8);
        prep_matrix((bf16_t*)(ws + W_AQK), 6144, 1024, [=](int n, int k) { const int pn = n >> 8, p = n & 255, bj = p >> 7, wc = (p >> 5) & 3, dd = p & 31, isk = pn >= 12 ? 1 : 0;
            const int col = isk * 3072 + (((pn - 12 * isk) * 4 + wc) * 64) + dd + 32 * bj; return LD4(w + (size_t)k * 9216 + col) * g[k]; }, scr, gw, NGW, lane, poff);
        prep_matrix((bf16_t*)(ws + W_AV), 3072, 1024, [=](int n, int k) { return LD4(w + (size_t)k * 9216 + 6144 + n) * g[k]; }, scr, gw, NGW, lane, poff);
        prep_matrix((bf16_t*)(ws + W_AO), 1024, 1024, [=](int n, int k) { return LD4(wo + (size_t)k * 1024 + n); }, scr, gw, NGW, lane, poff);
    }
    {
        const float* g = norm_g + (size_t)(1 * 3 + 1) * 1024; const float* w = INF(9); const float* qag = INF(10); const float* wq = INF(11);
        const float* kvg = INF(12); const float* wkv = INF(13); const float* wo = INF(16);
        prep_matrix((bf16_t*)(ws + W_BIN), 768, 1024, [=](int n, int k) { return n < 672 ? LD4(w + (size_t)k * 672 + n) * g[k] : (f32x4){0.f, 0.f, 0.f, 0.f}; }, scr, gw, NGW, lane, poff);
        prep_matrix((bf16_t*)(ws + W_BQ), 1536, 384, [=](int n, int k) { return LD4(wq + (size_t)k * 1536 + n) * qag[k]; }, scr, gw, NGW, lane, poff);
        prep_matrix((bf16_t*)(ws + W_BK), 1024, 256, [=](int n, int k) { const int pn = n >> 8, p = n & 255, bj = p >> 7, wc = (p >> 5) & 3, dd = p & 31;
            return LD4(wkv + (size_t)k * 2048 + (pn * 4 + wc) * 128 + dd + 32 * bj) * kvg[k]; }, scr, gw, NGW, lane, poff);
        prep_matrix((bf16_t*)(ws + W_BV), 1024, 256, [=](int n, int k) { return LD4(wkv + (size_t)k * 2048 + (n >> 6) * 128 + 64 + (n & 63)) * kvg[k]; }, scr, gw, NGW, lane, poff);
        prep_matrix((bf16_t*)(ws + W_BO), 1024, 1024, [=](int n, int k) { return LD4(wo + (size_t)k * 1024 + n); }, scr, gw, NGW, lane, poff);
    }
    {
        const float* g = norm_g + (size_t)(2 * 3 + 1) * 1024; const float* w = INF(17); const float* wo = INF(18);
        prep_matrix((bf16_t*)(ws + W_CIN), 4096, 1024, [=](int n, int k) { const int pn = n >> 8, p = n & 255; int col;
            if (pn >= 8) col = 4096 + (n - 2048);
            else { const int bj = p >> 7, wc = (p >> 5) & 3, dd = p & 31, isk = pn >> 2, hd = (pn & 3) * 2 + (wc >> 1); col = isk * 1024 + hd * 128 + 32 * (wc & 1) + dd + 64 * bj; }
            return LD4(w + (size_t)k * 6144 + col) * g[k]; }, scr, gw, NGW, lane, poff);
        prep_matrix((bf16_t*)(ws + W_CV), 2048, 1024, [=](int n, int k) { return LD4(w + (size_t)k * 6144 + 2048 + n) * g[k]; }, scr, gw, NGW, lane, poff);
        prep_matrix((bf16_t*)(ws + W_CO), 1024, 2048, [=](int n, int k) { return LD4(wo + (size_t)k * 1024 + n); }, scr, gw, NGW, lane, poff);
    }
    {
        const float* g = norm_g + (size_t)(3 * 3 + 1) * 1024; const float* w = INF(19); const float* wrg = INF(22); const float* wig = INF(24); const float* wo = INF(27);
        prep_matrix((bf16_t*)(ws + W_DIN), 2048, 1024, [=](int n, int k) { return LD4(w + (size_t)k * 2048 + n) * g[k]; }, scr, gw, NGW, lane, poff);
        prep_matrix((bf16_t*)(ws + W_DG), 2048, 256, [=](int n, int k) { const int pn = n >> 8, p = n & 255, bj = p >> 7, chn = pn * 128 + (p & 127), blk = chn >> 8, d = chn & 255;
            const float* src = bj ? wig : wrg; return LD4(src + ((size_t)blk * 256 + k) * 256 + d); }, scr, gw, NGW, lane, poff);
        prep_matrix((bf16_t*)(ws + W_DO), 1024, 1024, [=](int n, int k) { return LD4(wo + (size_t)k * 1024 + n); }, scr, gw, NGW, lane, poff);
    }
    {
        const float* x_in = INF(0); bf16_t* XB = (bf16_t*)(ws + WS_XB); float* SS = (float*)(ws + WS_SS);
        for (int m = gw; m < MTOK; m += NGW) { const f32x4* xr = (const f32x4*)(x_in + (size_t)m * DM) + lane; float s = 0.f;
            unsigned long long* o8 = (unsigned long long*)(XB + (size_t)m * DM) + lane;
#pragma unroll
            for (int j = 0; j < 4; ++j) { const f32x4 v = xr[64 * j]; s += (v.x * v.x + v.y * v.y) + (v.z * v.z + v.w * v.w); o8[64 * j] = (unsigned long long)pk2(v.x, v.y) | ((unsigned long long)pk2(v.z, v.w) << 32); }
            s = wave_sum(s);
            if (lane == 0) *(f32x4*)(SS + (size_t)m * 4) = (f32x4){s, 0.f, 0.f, 0.f}; } }
    {
        const float* lamp = INF(26); float* spt = (float*)(ws + WS_SPD);
        for (int i = BX * 512 + tid; i < 1024; i += GSZ * 512) spt[i] = -8.f * log1pf(expf(-lamp[i]));
    }
    {
        const int* positions = (const int*)ldptr(1);
        float* TAc = (float*)(ws + WS_TA); float* TAs = TAc + (size_t)MTOK * 32;
        float* TBc = (float*)(ws + WS_TB); float* TBs = TBc + (size_t)MTOK * 16;
        float* TCc = (float*)(ws + WS_TC); float* TCs = TCc + (size_t)MTOK * 64;
#define FAST_SC(a_, c_, s_) do { const float rv_ = (a_) * 0.15915494309189535f; const float fr_ = rv_ - floorf(rv_); c_ = __builtin_amdgcn_cosf(fr_); s_ = __builtin_amdgcn_sinf(fr_); } while (0)
        for (int idx = BX * 512 + tid; idx < MTOK * 16; idx += GSZ * 512) { const int row = idx >> 4, i = idx & 15; const float pos = (float)positions[row]; float cv, sv;
            const float inv = exp2f(-(float)i * (13.287712379549449f / 16.f)); FAST_SC(pos * inv, cv, sv); TBc[(size_t)row * 16 + i] = cv; TBs[(size_t)row * 16 + i] = sv; } }
#undef FAST_SC
}

#ifndef DIAG
#define DIAG 0
#endif
#define TIMED(mask, ...) do { if (DIAG & (mask)) { const unsigned long long t0_ = __builtin_amdgcn_s_memrealtime(); __VA_ARGS__; const unsigned long long t1_ = __builtin_amdgcn_s_memrealtime(); \
    while (__builtin_amdgcn_s_memrealtime() - t1_ < t1_ - t0_) __builtin_amdgcn_s_sleep(8); } else { __VA_ARGS__; } } while (0)
__device__ __forceinline__ void phase_ffn(int lw, bool from_input, bool last, int par) {
    TIMED(2,
    {   unsigned char* ws = WSP();
        pg8::Prob g = pg8::make_prob(ws + WS_XB, 1024, ws + W_FUP + (size_t)lw * SZ_FUP, 1024, 1024); pg8::StaticOrder SO; SO.init(MTOK / 256, 22, GSZ, BX);
        EpiSwiGLU E{(bf16_t*)(ws + WS_R), RSBUF(ws, par)};
        pg8::gemm_phase<EpiSwiGLU, true, true>(LDS_BASE(), g, SO, E); }
    GRID_BAR(););
    TIMED(32,
    {   unsigned char* ws = WSP(); float* X = XOUT();
        pg8::Prob g = pg8::make_prob(ws + WS_R, DFF, ws + W_FDN + (size_t)lw * SZ_FDN, DFF, DFF); pg8::StaticOrder SO; SO.init(MTOK / 256, 4, GSZ, BX);
        EpiRes E{from_input ? INF(0) : (const float*)nullptr, last ? X : (float*)nullptr, (bf16_t*)(ws + WS_XB), RSBUF(ws, par), 0.5f};
        pg8::gemm_phase<EpiRes, true, true>(LDS_BASE(), g, SO, E); }
    GRID_BAR(););
}
__device__ __forceinline__ void phase_outproj(size_t a_off, int Kdim, size_t w_off, int par) {
    {   unsigned char* ws = WSP();
        pg8::Prob g = pg8::make_prob(ws + a_off, Kdim, ws + w_off, Kdim, Kdim); pg8::StaticOrder SO; SO.init(MTOK / 256, 4, GSZ, BX);
        EpiRes E{(const float*)nullptr, (float*)nullptr, (bf16_t*)(ws + WS_XB), RSBUF(ws, par), 1.0f};
        pg8::gemm_phase<EpiRes, true, true>(LDS_BASE(), g, SO, E); }
    GRID_BAR();
}

#ifndef TS
#define TS 0
#endif
#define SUBOK(n) (TS == 0 || TS == (n))
__device__ __forceinline__ void phase_mixA(int par) {
    for (int half = 0; half < 2; ++half) {
        const int rowbase = half * 16384;
        if (SUBOK(1)) {   unsigned char* ws = WSP();
            pg8::Prob g = pg8::make_prob(ws + WS_XB + (size_t)rowbase * 2048, 1024, ws + W_AQK, 1024, 1024); pg8::StaticOrder SO; SO.init(64, 24, GSZ, BX);
            EpiAQK E{(bf16_t*)(ws + RA_Q), (bf16_t*)(ws + RA_K), RSBUF(ws, par), INF(6), INF(7), (const int*)ldptr(1), rowbase};
            pg8::gemm_phase<EpiAQK, true, true>(LDS_BASE(), g, SO, E); }
        if (SUBOK(2)) for (int gI = 0; gI < 3; ++gI) {
            unsigned char* ws = WSP();
            const int dsh = 2 * gI, dil = 1 << dsh;
            pg8::Prob g = pg8::make_prob(ws + W_AV + (size_t)gI * 1024 * 1024 * 2, 1024, ws + WS_XB + (size_t)rowbase * 2048, dil * 1024, 1024);
            g.mode = 1; g.dsh = dsh; g.hsB = (dsh == 4) ? (long)1024 * 2 : (long)128 * dil * 1024 * 2;
            pg8::StaticOrder SO; SO.init(4, 64, GSZ, BX);
            EpiVT E{(bf16_t*)(ws + RA_V) + (size_t)gI * 1024 * 16384, (size_t)16384, RSBUF(ws, par), 4, 0, 4, 1024.f, 1, dsh, rowbase, 1};
            pg8::gemm_phase<EpiVT, true, true>(LDS_BASE(), g, SO, E);
        }
        GRID_BAR();
        if (SUBOK(3)) {   unsigned char* ws = WSP(); const float* gq = INF(6); const float* gk = INF(7); const int lane = opaque_tid() & 63;
            const float shift = 11.541560327111707f * wave_max(fabsf(gq[lane])) * wave_max(fabsf(gk[lane]));
            mixA_attn(LDS_BASE(), (const bf16_t*)(ws + RA_Q), (const bf16_t*)(ws + RA_K), (const bf16_t*)(ws + RA_V), (bf16_t*)(ws + RA_O), half, shift); }
        GRID_BAR();
    }
    phase_outproj(RA_O, 1024, W_AO, par);
}

__device__ __forceinline__ void phase_mixB(int par) {
    if (SUBOK(1)) {   unsigned char* ws = WSP();
        pg8::Prob g = pg8::make_prob(ws + WS_XB, 1024, ws + W_BIN, 1024, 1024); pg8::StaticOrder SO; SO.init(MTOK / 256, 3, GSZ, BX);
        EpiBIn E{(bf16_t*)(ws + RB_CQ), (bf16_t*)(ws + RB_CKV), (float*)(ws + RB_KR), (float*)(ws + RB_SS), RSBUF(ws, par)};
        pg8::gemm_phase<EpiBIn, true, true>(LDS_BASE(), g, SO, E); }
    GRID_BAR();
    if (SUBOK(2)) {   unsigned char* ws = WSP();
        pg8::Prob g = pg8::make_prob(ws + RB_CQ, 384, ws + W_BQ, 384, 384); pg8::StaticOrder SO; SO.init(MTOK / 256, 6, GSZ, BX);
        EpiRowScale E{(bf16_t*)(ws + RB_QR), 1536, (bf16_t*)(ws + RB_QR), 1536, 1 << 30, (const float*)(ws + RB_SS), 32, 0, 12, 384.f, 0};
        pg8::gemm_phase<EpiRowScale, true, true>(LDS_BASE(), g, SO, E); }
    if (SUBOK(3)) {   unsigned char* ws = WSP();
        pg8::Prob g = pg8::make_prob(ws + RB_CKV, 256, ws + W_BK, 256, 256); pg8::StaticOrder SO; SO.init(MTOK / 256, 4, GSZ, BX);
        EpiBK E{(bf16_t*)(ws + RB_KB), (const float*)(ws + RB_SS), (const float*)(ws + RB_KR), INF(15), (const float*)(ws + WS_TB), (const float*)(ws + WS_TB) + (size_t)MTOK * 16};
        pg8::gemm_phase<EpiBK, true, true>(LDS_BASE(), g, SO, E); }
    if (SUBOK(4)) {   unsigned char* ws = WSP();
        pg8::Prob g = pg8::make_prob(ws + W_BV, 256, ws + RB_CKV, 256, 256); pg8::StaticOrder SO; SO.init(4, MTOK / 256, GSZ, BX);
        EpiVT E{(bf16_t*)(ws + RB_VT), (size_t)MTOK, (const float*)(ws + RB_SS), 32, 12, 8, 256.f, 0, 0, 0, 0};
        pg8::gemm_phase<EpiVT, true, true>(LDS_BASE(), g, SO, E); }
    GRID_BAR();
    if (SUBOK(5)) {   unsigned char* ws = WSP(); const float* gq = INF(14); const float* gk = INF(15); const int lane = opaque_tid() & 63;
        const float mq = wave_max(fmaxf(fabsf(gq[lane]), fabsf(gq[64 + (lane & 31)]))), mk = wave_max(fmaxf(fabsf(gk[lane]), fabsf(gk[64 + (lane & 31)])));
        const float shift = 14.134834215227234f * mq * mk;
        mixB_attn(LDS_BASE(), (const bf16_t*)(ws + RB_QR), (const bf16_t*)(ws + RB_KB), (const bf16_t*)(ws + RB_VT), (bf16_t*)(ws + RB_O), gq, (const float*)(ws + WS_TB), (const float*)(ws + WS_TB) + (size_t)MTOK * 16, shift); }
    GRID_BAR();
    phase_outproj(RB_O, 1024, W_BO, par);
}

__device__ __forceinline__ void phase_mixC(int par) {
    if (SUBOK(1)) {   unsigned char* ws = WSP();
        pg8::Prob g = pg8::make_prob(ws + WS_XB, 1024, ws + W_CIN, 1024, 1024); pg8::StaticOrder SO; SO.init(MTOK / 256, 16, GSZ, BX);
        EpiCIn E{(bf16_t*)(ws + RC_Q), (bf16_t*)(ws + RC_K), (bf16_t*)(ws + RC_G), RSBUF(ws, par), (const int*)ldptr(1)};
        pg8::gemm_phase<EpiCIn, true, true>(LDS_BASE(), g, SO, E); }
    if (SUBOK(2)) {   unsigned char* ws = WSP();
        pg8::Prob g = pg8::make_prob(ws + W_CV, 1024, ws + WS_XB, 1024, 1024); pg8::StaticOrder SO; SO.init(8, MTOK / 256, GSZ, BX);
        EpiVT E{(bf16_t*)(ws + RC_VT), (size_t)MTOK, RSBUF(ws, par), 4, 0, 4, 1024.f, 0, 0, 0, 1};
        pg8::gemm_phase<EpiVT, true, true>(LDS_BASE(), g, SO, E); }
    GRID_BAR();
    if (SUBOK(3)) {   unsigned char* ws = WSP();
        mixC_retention(LDS_BASE(), (const bf16_t*)(ws + RC_Q), (const bf16_t*)(ws + RC_K), (const bf16_t*)(ws + RC_VT), (bf16_t*)(ws + RC_G)); }
    GRID_BAR();
    phase_outproj(RC_G, 2048, W_CO, par);
}

__device__ __forceinline__ void phase_mixD(int par) {
    {   unsigned char* ws = WSP();
        pg8::Prob g = pg8::make_prob(ws + WS_XB, 1024, ws + W_DIN, 1024, 1024); pg8::StaticOrder SO; SO.init(MTOK / 256, 8, GSZ, BX);
        EpiRowScale E{(bf16_t*)(ws + RD_GG), 1024, (bf16_t*)(ws + RD_U), 1024, 1024, RSBUF(ws, par), 4, 0, 4, 1024.f, 1};
        pg8::gemm_phase<EpiRowScale, true, true>(LDS_BASE(), g, SO, E); }
    GRID_BAR();
    {   unsigned char* ws = WSP(); mixD_conv((const bf16_t*)(ws + RD_U), (bf16_t*)(ws + RD_UC), INF(20), INF(21)); }
    GRID_BAR();
    {   unsigned char* ws = WSP();
        pg8::Prob g = pg8::make_prob(ws + RD_UC, 1024, ws + W_DG, 256, 256); g.mode = 2; pg8::StaticOrder SO; SO.init(MTOK / 256, 8, GSZ, BX);
        EpiDGate E{(bf16_t*)(ws + RD_LA), (bf16_t*)(ws + RD_GU), (const bf16_t*)(ws + RD_UC), INF(23), INF(25), (const float*)(ws + WS_SPD)};
        pg8::gemm_phase<EpiDGate, true, true>(LDS_BASE(), g, SO, E); }
    GRID_BAR();
    {   unsigned char* ws = WSP(); mixD_scan(LDS_BASE(), (const bf16_t*)(ws + RD_LA), (const bf16_t*)(ws + RD_GU), (bf16_t*)(ws + RD_GG)); }
    GRID_BAR();
    phase_outproj(RD_GG, 1024, W_DO, par);
}

__global__ void __launch_bounds__(NWAVES * 64, 2) fwd_kernel(Args args) {
    {
        LAS unsigned char* lds = LDS_BASE();
        const int tid = threadIdx.x;
        for (int u = tid; u < (LDS_BYTES - MISC_OFF) / 4; u += NWAVES * 64) ((LAS unsigned*)(lds + MISC_OFF))[u] = 0u;
        __syncthreads();
        const unsigned long long* ka = (const unsigned long long*)__builtin_amdgcn_kernarg_segment_ptr();
        if (tid < 30) ((LAS unsigned long long*)(lds + PT_OFF))[tid] = ka[tid];
        __syncthreads();
        (void)xcd_barrier_post((unsigned*)(WSP() + WS_CTL) + 1024, (volatile LAS unsigned*)(lds + MISC_OFF) + 8);
    }
#ifndef TP
#define TP 0
#endif
    if (TP == 0 || TP == 1) { TIMED(1, phase_prologue(); GRID_BAR();); }
    if (TP == 0 || TP == 2) phase_ffn(0, true, false, 0);
    if (TP == 0 || TP == 3) { TIMED(4, phase_mixA(1);); }
    if (TP == 0) { phase_ffn(1, false, false, 0); phase_ffn(2, false, false, 1); }
    if (TP == 0 || TP == 4) { TIMED(8, phase_mixB(0);); }
    if (TP == 0) { phase_ffn(3, false, false, 1); phase_ffn(4, false, false, 0); }
    if (TP == 0 || TP == 5) { TIMED(16, phase_mixC(1);); }
    if (TP == 0) { phase_ffn(5, false, false, 0); phase_ffn(6, false, false, 1); }
    if (TP == 0 || TP == 6) { TIMED(64, phase_mixD(0);); }
    if (TP == 0) phase_ffn(7, false, true, 1);
}

extern "C" void kernel_launch(void* const* d_in, const int* in_sizes, int n_in, void* d_out, int out_size, void* d_ws, size_t ws_size, hipStream_t stream) {
    static int grid = 0;
    if (grid == 0) {
        if (n_in != 28 || out_size != MTOK * DM || ws_size < WS_NEED) { fprintf(stderr, "kernel_launch: unexpected shapes: n_in %d out %d ws %zu (need %zu)\n", n_in, out_size, ws_size, (size_t)WS_NEED); grid = -1; return; }
        int dev = 0, cus = 0, per_cu = 0;
        if (hipGetDevice(&dev) != hipSuccess || hipDeviceGetAttribute(&cus, hipDeviceAttributeMultiprocessorCount, dev) != hipSuccess) { grid = -1; return; }
        if (hipFuncSetAttribute((const void*)fwd_kernel, hipFuncAttributeMaxDynamicSharedMemorySize, LDS_BYTES) != hipSuccess) { fprintf(stderr, "kernel_launch: hipFuncSetAttribute failed\n"); grid = -1; return; }
        if (hipOccupancyMaxActiveBlocksPerMultiprocessor(&per_cu, (const void*)fwd_kernel, NWAVES * 64, LDS_BYTES) != hipSuccess || per_cu < 1) fprintf(stderr, "kernel_launch: occupancy query says %d\n", per_cu);
        (void)hipGetLastError();
        grid = cus;
    }
    if (grid < 0) return;
    (void)hipMemsetAsync((char*)d_ws + WS_CTL, 0, CTL_ZERO_BYTES, stream);
    Args a{};
    for (int i = 0; i < 28; ++i) a.in[i] = d_in[i];
    a.out = (float*)d_out; a.ws = (unsigned char*)d_ws;
    hipLaunchKernelGGL(fwd_kernel, dim3(grid), dim3(NWAVES * 64), LDS_BYTES, stream, a);
    const hipError_t le = hipPeekAtLastError();
    if (le != hipSuccess) fprintf(stderr, "kernel_launch: launch failed: %s\n", hipGetErrorName(le));
}
```

```cpp
#include <hip/hip_runtime.h>
#include <cstdio>
#include <cstdint>
#include <cmath>

#define LAS __attribute__((address_space(3)))
#define GAS __attribute__((address_space(1)))
typedef unsigned short bf16_t;
typedef short bf16x8 __attribute__((ext_vector_type(8)));
typedef float f32x4 __attribute__((ext_vector_type(4)));
typedef float f32x16 __attribute__((ext_vector_type(16)));
typedef unsigned u32x4 __attribute__((ext_vector_type(4)));
typedef unsigned u32x2 __attribute__((ext_vector_type(2)));
typedef float f32x2_t __attribute__((ext_vector_type(2)));
typedef __bf16 bf16x2_t __attribute__((ext_vector_type(2)));

constexpr int DM = 1024, NB = 16, SEQ = 2048, MTOK = NB * SEQ, DFF = 2816;
constexpr float NORM_EPS = 1e-6f, GN_EPS = 1e-5f;
constexpr float LOG2E = 1.4426950408889634f;

__device__ __forceinline__ unsigned pk2(float lo, float hi) { f32x2_t v = {lo, hi}; bf16x2_t b = __builtin_convertvector(v, bf16x2_t); return __builtin_bit_cast(unsigned, b); }
__device__ __forceinline__ float bflo(unsigned w) { return __uint_as_float(w << 16); }
__device__ __forceinline__ float bfhi(unsigned w) { return __uint_as_float(w & 0xffff0000u); }
__device__ __forceinline__ float fast_exp2(float x) { return __builtin_amdgcn_exp2f(x); }
__device__ __forceinline__ float fast_rcp(float x) { return __builtin_amdgcn_rcpf(x); }
__device__ __forceinline__ float silu_f(float g) { return g * fast_rcp(1.f + fast_exp2(-g * LOG2E)); }
__device__ __forceinline__ float sigmoid_f(float g) { return fast_rcp(1.f + fast_exp2(-g * LOG2E)); }
__device__ __forceinline__ float gelu_tanh_f(float x) {
    const float z = 0.7978845608028654f * (x + 0.044715f * x * x * x);
    const float e = fast_exp2(2.f * LOG2E * z);
    return x * (1.f - fast_rcp(1.f + e));
}
__device__ __forceinline__ float wave_sum(float v) {
#pragma unroll
    for (int o = 1; o < 64; o <<= 1) v += __shfl_xor(v, o);
    return v;
}
__device__ __forceinline__ float wave_max(float v) {
#pragma unroll
    for (int o = 1; o < 64; o <<= 1) v = fmaxf(v, __shfl_xor(v, o));
    return v;
}
__device__ __forceinline__ int opaque_tid() { int t = threadIdx.x; asm volatile("" : "+v"(t)); return t; }
__device__ __forceinline__ void lds_barrier() { asm volatile("s_waitcnt lgkmcnt(0)\n\ts_barrier" ::: "memory"); }
__device__ __forceinline__ int crow(int r, int hi) { return (r & 3) + 8 * (r >> 2) + 4 * hi; }

namespace pg8 {
constexpr int BM = 256, BK = 64, HALF = 128, HTB = HALF * BK * 2, STAGE_BYTES = 8 * HTB, NXCD = 8, WGM = 8;
__host__ __device__ __forceinline__ int lds_byte(int r, int c) { const int st = (r >> 4) * 2 + (c >> 5), rr = r & 15, cc = c & 31, ob = rr * 64 + cc * 2; return st * 1024 + (ob ^ (((ob >> 9) & 1) << 5)); }
__host__ __device__ __forceinline__ void stage_rc(int b, int& R, int& C) { const int st = b / 1024, sb = b % 1024, swz = sb ^ (((sb >> 9) & 1) << 5); R = (st >> 1) * 16 + swz / 64; C = (st & 1) * 32 + (swz % 64) / 2; }
__host__ __device__ __forceinline__ int perm32(int rho) { const int n = rho >> 4, i = rho & 15; return 8 * (i >> 2) + 4 * n + (i & 3); }
struct Unit { int pm, pn; };
struct StaticOrder {
    int nM, nN, nwg, G, c;
    __device__ void init(int nM_, int nN_, int G_, int c_) { nM = nM_; nN = nN_; nwg = nM * nN; G = G_; c = c_; }
    __device__ bool next(int i, Unit& u) const {
        const long L = (long)i * G + c; if (L >= nwg) return false;
        int wgid = (int)L; { const int q = nwg / NXCD, r = nwg % NXCD, xcd = wgid % NXCD, off = wgid / NXCD; wgid = (xcd < r ? xcd * (q + 1) : r * (q + 1) + (xcd - r) * q) + off; }
        const int nig = WGM * nN, gid = wgid / nig, fm = gid * WGM, gsz = (nM - fm) < WGM ? (nM - fm) : WGM;
        u.pm = fm + ((wgid % nig) % gsz); u.pn = (wgid % nig) / gsz; return true;
    }
};
struct Prob {
    const char* A; const char* B; int K, lda, ldb; long hsA, hsB, tsA, tsB; int mode, dsh;
    __device__ __forceinline__ const char* a_ptr(const Unit& u) const { const char* p = A + (long)u.pm * tsA; if (mode == 2) p += (long)(u.pn >> 1) * 512; return p; }
    __device__ __forceinline__ const char* b_ptr(const Unit& u) const {
        if (mode == 1) { const int b = u.pn >> 3, tt = u.pn & 7; int tok0;
            if (dsh == 0) tok0 = 256 * tt; else if (dsh == 2) tok0 = 4 * ((tt & 1) * 256) + (tt >> 1); else tok0 = 2 * tt;
            return B + ((long)b * SEQ + tok0) * (DM * 2); }
        return B + (long)u.pn * tsB; }
};
__device__ __forceinline__ Prob make_prob(const void* A, int lda, const void* B, int ldb, int K) {
    Prob p; p.A = (const char*)A; p.B = (const char*)B; p.K = K; p.lda = lda; p.ldb = ldb; p.hsA = (long)HALF * lda * 2; p.hsB = (long)HALF * ldb * 2; p.tsA = 2 * p.hsA; p.tsB = 2 * p.hsB; p.mode = 0; p.dsh = 0; return p;
}

template <class Epi, bool ALIGN_EPI, bool SP2>
__device__ __forceinline__ void gemm_phase(LAS unsigned char* lds, const Prob g, const StaticOrder& S, const Epi& E) {
    const int tid = opaque_tid(), wid = __builtin_amdgcn_readfirstlane(tid >> 6), lane = tid & 63, wr = wid >> 2, wc = wid & 3, fr = lane & 15, fq = lane >> 4;
    const int K = g.K, nt = K / BK;
    unsigned voffA[2], voffB[2];
#pragma unroll
    for (int i = 0; i < 2; ++i) { int R, C; stage_rc(tid * 16 + i * 8192, R, C); const int Rb = Epi::PERM ? ((R & ~31) + perm32(R & 31)) : R;
        voffA[i] = (unsigned)(R * g.lda + C) * 2u; voffB[i] = (unsigned)(Rb * g.ldb + C) * 2u; }
    const size_t kstep = (size_t)(BK * 2);
    const long hsA = g.hsA, hsB = g.hsB;
    const unsigned ldsw = (unsigned)wid * 1024u;
    const int aoff = lds_byte(wr * 64 + fr, fq * 8), boff = lds_byte(wc * 32 + fr, fq * 8);
#define PG8_SA(b, h) (((b) * 2 + (h)) * HTB)
#define PG8_SB(b, h) ((4 + (b) * 2 + (h)) * HTB)
#define PG8_STAGE(bufoff, gbase, voff) do { _Pragma("unroll") for (int _i = 0; _i < 2; ++_i) \
        __builtin_amdgcn_global_load_lds((const unsigned*)((const char*)(gbase) + (voff)[_i]), (LAS unsigned*)(lds + (bufoff) + ldsw + _i * 8192), 16, 0, 0); } while (0)
#define PG8_LDA(dst, b, h) do { _Pragma("unroll") for (int m = 0; m < 4; ++m) _Pragma("unroll") for (int k = 0; k < 2; ++k) dst[m][k] = *(const LAS bf16x8*)(lds + PG8_SA(b, h) + aoff + m * 2048 + k * 1024); } while (0)
#define PG8_LDB(dst, b, h) do { _Pragma("unroll") for (int n = 0; n < 2; ++n) _Pragma("unroll") for (int k = 0; k < 2; ++k) dst[n][k] = *(const LAS bf16x8*)(lds + PG8_SB(b, h) + boff + n * 2048 + k * 1024); } while (0)
#define PG8_MMA(ai, bj, At, Bt) do { __builtin_amdgcn_s_setprio(1); _Pragma("unroll") for (int m = 0; m < 4; ++m) _Pragma("unroll") for (int n = 0; n < 2; ++n) _Pragma("unroll") for (int k = 0; k < 2; ++k) \
        acc[ai][bj][m][n] = __builtin_amdgcn_mfma_f32_16x16x32_bf16(Bt[n][k], At[m][k], acc[ai][bj][m][n], 0, 0, 0); __builtin_amdgcn_s_setprio(0); } while (0)
#define PG8_WAIT_V(n) asm volatile("s_waitcnt vmcnt(" #n ")" ::: "memory")
#define PG8_WAIT_L(n) asm volatile("s_waitcnt lgkmcnt(" #n ")" ::: "memory")
#define PG8_BAR __builtin_amdgcn_s_barrier()
#define PG8_SCHED __builtin_amdgcn_sched_barrier(0)
    Unit cur, nxt; int ui = 0;
    if (!S.next(0, cur)) return;
    f32x4 acc[2][2][4][2];
#pragma unroll
    for (int a = 0; a < 2; ++a)
#pragma unroll
        for (int b = 0; b < 2; ++b)
#pragma unroll
            for (int m = 0; m < 4; ++m)
#pragma unroll
                for (int n = 0; n < 2; ++n) acc[a][b][m][n] = (f32x4){0.f, 0.f, 0.f, 0.f};
    bf16x8 At[4][2], B0[2][2], B1[2][2];
    const char* cA = g.a_ptr(cur); const char* cB = g.b_ptr(cur);
    if constexpr (SP2) {
        PG8_STAGE(PG8_SB(0, 0), cB, voffB); PG8_STAGE(PG8_SB(0, 1), cB + hsB, voffB); PG8_STAGE(PG8_SA(0, 0), cA, voffA); PG8_STAGE(PG8_SA(0, 1), cA + hsA, voffA);
        if (wr == 1) PG8_BAR;
        PG8_WAIT_V(2); PG8_BAR;
        PG8_STAGE(PG8_SB(1, 0), cB + kstep, voffB); PG8_STAGE(PG8_SA(1, 0), cA + kstep, voffA); PG8_STAGE(PG8_SB(1, 1), cB + hsB + kstep, voffB);
        PG8_WAIT_V(6); PG8_BAR;
    } else {
        PG8_STAGE(PG8_SB(0, 0), cB, voffB); PG8_STAGE(PG8_SA(0, 0), cA, voffA); PG8_STAGE(PG8_SB(0, 1), cB + hsB, voffB); PG8_STAGE(PG8_SA(0, 1), cA + hsA, voffA);
        if (wr == 1) PG8_BAR;
        PG8_WAIT_V(4); PG8_BAR;
        PG8_STAGE(PG8_SB(1, 0), cB + kstep, voffB); PG8_STAGE(PG8_SA(1, 0), cA + kstep, voffA); PG8_STAGE(PG8_SB(1, 1), cB + hsB + kstep, voffB);
        PG8_WAIT_V(6); PG8_BAR;
    }
    for (;;) {
        const bool has_next = S.next(ui + 1, nxt);
        const char* nA = has_next ? g.a_ptr(nxt) : cA; const char* nB = has_next ? g.b_ptr(nxt) : cB;
        for (int t = 0; t < nt; t += 2) {
            const bool last = (t == nt - 2);
            const char* a1 = cA + (size_t)(t + 1) * kstep;
            const char* a2 = last ? nA : cA + (size_t)(t + 2) * kstep; const char* b2 = last ? nB : cB + (size_t)(t + 2) * kstep;
            const char* a3 = a2 + kstep; const char* b3 = b2 + kstep;
            if constexpr (SP2) {
            PG8_LDB(B0, 0, 0); PG8_LDB(B1, 0, 1); PG8_SCHED; PG8_LDA(At, 0, 0); PG8_STAGE(PG8_SA(1, 1), a1 + hsA, voffA);
            PG8_WAIT_V(8); PG8_WAIT_L(0); PG8_BAR; PG8_MMA(0, 0, At, B0); PG8_MMA(0, 1, At, B1); PG8_BAR; PG8_SCHED;
            PG8_LDA(At, 0, 1); PG8_STAGE(PG8_SB(0, 0), b2, voffB); PG8_STAGE(PG8_SB(0, 1), b2 + hsB, voffB); PG8_STAGE(PG8_SA(0, 0), a2, voffA);
            PG8_WAIT_V(8); PG8_WAIT_L(0); PG8_BAR; PG8_MMA(1, 0, At, B0); PG8_MMA(1, 1, At, B1); PG8_BAR; PG8_SCHED;
            PG8_LDB(B0, 1, 0); PG8_LDB(B1, 1, 1); PG8_SCHED; PG8_LDA(At, 1, 0); PG8_STAGE(PG8_SA(0, 1), a2 + hsA, voffA);
            PG8_WAIT_V(8); PG8_WAIT_L(0); PG8_BAR; PG8_MMA(0, 0, At, B0); PG8_MMA(0, 1, At, B1); PG8_BAR; PG8_SCHED;
            PG8_LDA(At, 1, 1); PG8_STAGE(PG8_SB(1, 0), b3, voffB); PG8_STAGE(PG8_SB(1, 1), b3 + hsB, voffB); PG8_STAGE(PG8_SA(1, 0), a3, voffA);
            PG8_WAIT_V(8); PG8_WAIT_L(0); PG8_BAR; PG8_MMA(1, 0, At, B0); PG8_MMA(1, 1, At, B1); PG8_BAR; PG8_SCHED;
            } else {
            PG8_LDB(B0, 0, 0); PG8_SCHED; PG8_LDA(At, 0, 0); PG8_STAGE(PG8_SA(1, 1), a1 + hsA, voffA);
            PG8_WAIT_L(8); PG8_BAR; PG8_WAIT_L(0); PG8_MMA(0, 0, At, B0); PG8_BAR; PG8_SCHED;
            PG8_LDB(B1, 0, 1); PG8_STAGE(PG8_SB(0, 0), b2, voffB);
            PG8_BAR; PG8_WAIT_L(0); PG8_MMA(0, 1, At, B1); PG8_BAR;
            PG8_LDA(At, 0, 1); PG8_STAGE(PG8_SA(0, 0), a2, voffA);
            PG8_BAR; PG8_WAIT_L(0); PG8_MMA(1, 0, At, B0); PG8_BAR; PG8_SCHED;
            PG8_STAGE(PG8_SB(0, 1), b2 + hsB, voffB);
            PG8_WAIT_V(6); PG8_BAR; PG8_MMA(1, 1, At, B1); PG8_BAR;
            PG8_LDB(B0, 1, 0); PG8_SCHED; PG8_LDA(At, 1, 0); PG8_STAGE(PG8_SA(0, 1), a2 + hsA, voffA);
            PG8_WAIT_L(8); PG8_BAR; PG8_WAIT_L(0); PG8_MMA(0, 0, At, B0); PG8_BAR; PG8_SCHED;
            PG8_LDB(B1, 1, 1); PG8_STAGE(PG8_SB(1, 0), b3, voffB);
            PG8_BAR; PG8_WAIT_L(0); PG8_MMA(0, 1, At, B1); PG8_BAR;
            PG8_LDA(At, 1, 1); PG8_STAGE(PG8_SA(1, 0), a3, voffA);
            PG8_BAR; PG8_WAIT_L(0); PG8_MMA(1, 0, At, B0); PG8_BAR; PG8_SCHED;
            PG8_STAGE(PG8_SB(1, 1), b3 + hsB, voffB);
            PG8_WAIT_V(6); PG8_BAR; PG8_MMA(1, 1, At, B1); PG8_BAR;
            }
        }
        if constexpr (ALIGN_EPI) { if (wr == 0) PG8_BAR; }
        E(acc, cur, wr, wc, fr, fq);
        if (!has_next) break;
#pragma unroll
        for (int a = 0; a < 2; ++a)
#pragma unroll
            for (int b = 0; b < 2; ++b)
#pragma unroll
                for (int m = 0; m < 4; ++m)
#pragma unroll
                    for (int n = 0; n < 2; ++n) acc[a][b][m][n] = (f32x4){0.f, 0.f, 0.f, 0.f};
        cur = nxt; cA = nA; cB = nB; ++ui;
        if constexpr (ALIGN_EPI) { if (wr == 1) PG8_BAR; }
    }
    PG8_WAIT_V(0);
    if constexpr (!ALIGN_EPI) { if (wr == 0) PG8_BAR; }
    PG8_BAR;
#undef PG8_SA
#undef PG8_SB
#undef PG8_STAGE
#undef PG8_LDA
#undef PG8_LDB
#undef PG8_MMA
#undef PG8_WAIT_V
#undef PG8_WAIT_L
#undef PG8_BAR
#undef PG8_SCHED
}
}
typedef f32x4 AccT[2][2][4][2];

#define XB_TMO      128
#define XB_XCNT(j)  (256  + 64 * (j))
#define XB_XSUB(j)  (1280 + 64 * (j))
#define XB_XGEN(j)  (2304 + 64 * (j))
#define XB_TOP      3328
#define XB_TOPGEN   3392
#define XCD_BAR_WORDS 3456
#define XB_SPIN_CAP (1u << 18)
__device__ __forceinline__ unsigned xb_ld(unsigned* p)              { return __hip_atomic_load(p, __ATOMIC_RELAXED, __HIP_MEMORY_SCOPE_AGENT); }
__device__ __forceinline__ unsigned xb_add(unsigned* p, unsigned v) { return __hip_atomic_fetch_add(p, v, __ATOMIC_RELAXED, __HIP_MEMORY_SCOPE_AGENT); }
__device__ __forceinline__ unsigned xb_xcc_id() { return (unsigned)__builtin_amdgcn_s_getreg((3 << 11) | 20) & 0xFu; }
#define XB_SPIN(cond, bar) do { unsigned _sp = 0; while (cond) { __builtin_amdgcn_s_sleep(1); \
    if ((++_sp & 255u) == 0u) { if (xb_ld(&(bar)[XB_TMO])) break; if (_sp > XB_SPIN_CAP) { atomicAdd(&(bar)[XB_TMO], 1u); break; } } } } while (0)
struct XcdBarrier { unsigned* bar; unsigned x; volatile LAS unsigned* st; };
__device__ __forceinline__ XcdBarrier xcd_barrier_post(unsigned* bar, volatile LAS unsigned* st) {
    XcdBarrier b; b.bar = bar; b.x = xb_xcc_id(); b.st = st;
    if (threadIdx.x == 0) (void)xb_add(&bar[XB_XCNT(b.x)], 1u);
    return b;
}
__device__ __forceinline__ void xcd_barrier_complete(unsigned* bar, unsigned x, unsigned& nloc, unsigned& nx) {
    const unsigned G = gridDim.x * gridDim.y * gridDim.z;
    unsigned sum, cnt, mine, sp = 0u;
    for (;;) {
        sum = 0u; cnt = 0u; mine = 0u;
#pragma unroll
        for (unsigned j = 0; j < 16; ++j) { const unsigned c = xb_ld(&bar[XB_XCNT(j)]); sum += c; cnt += (c > 0u) ? 1u : 0u; mine = (j == x) ? c : mine; }
        if (sum == G) break;
        __builtin_amdgcn_s_sleep(1);
        if ((++sp & 255u) == 0u) { if (xb_ld(&bar[XB_TMO])) break; if (sp > XB_SPIN_CAP) { atomicAdd(&bar[XB_TMO], 1u); break; } }
    }
    nloc = mine > 0u ? mine : 1u; nx = cnt > 0u ? cnt : 1u;
}
__device__ __forceinline__ void xcd_barrier(const XcdBarrier& b) {
    asm volatile("s_waitcnt vmcnt(0)" ::: "memory");
    __syncthreads();
    if (threadIdx.x == 0) {
        unsigned* bar = b.bar;
        __builtin_amdgcn_s_waitcnt(0);
        unsigned nloc = b.st[0], nx = b.st[1];
        if (nloc == 0u) { xcd_barrier_complete(bar, b.x, nloc, nx); b.st[0] = nloc; b.st[1] = nx; }
        const unsigned old = xb_add(&bar[XB_XSUB(b.x)], 1u);
        const unsigned gen = old / nloc;
        if (old + 1u == (gen + 1u) * nloc) {
            __builtin_amdgcn_fence(__ATOMIC_RELEASE, "agent");
            asm volatile("s_waitcnt vmcnt(0)" ::: "memory");
            const unsigned og = xb_add(&bar[XB_TOP], 1u);
            const unsigned tg = og / nx;
            if (og + 1u == (tg + 1u) * nx) xb_add(&bar[XB_TOPGEN], 1u);
            else XB_SPIN(xb_ld(&bar[XB_TOPGEN]) == tg, bar);
            __builtin_amdgcn_fence(__ATOMIC_ACQUIRE, "agent");
            xb_add(&bar[XB_XGEN(b.x)], 1u);
            asm volatile("s_waitcnt vmcnt(0)" ::: "memory");
        } else {
            XB_SPIN(xb_ld(&bar[XB_XGEN(b.x)]) == gen, bar);
            __builtin_amdgcn_fence(__ATOMIC_ACQUIRE, "agent");
            asm volatile("s_waitcnt vmcnt(0)" ::: "memory");
        }
    }
    __syncthreads();
}

constexpr size_t MiB = 1u << 20;
constexpr size_t WS_CTL = 0, CTL_ZERO_BYTES = 64 * 1024, WS_SPD = 128 * 1024;
constexpr size_t SZ_FUP = (size_t)5632 * 1024 * 2, SZ_FDN = (size_t)1024 * 2816 * 2;
constexpr size_t WS_W = 1 * MiB;
constexpr size_t W_FUP = WS_W;
constexpr size_t W_FDN = W_FUP + 8 * SZ_FUP;
constexpr size_t W_AQK = W_FDN + 8 * SZ_FDN;
constexpr size_t W_AV  = W_AQK + (size_t)6144 * 1024 * 2;
constexpr size_t W_AO  = W_AV + (size_t)3072 * 1024 * 2;
constexpr size_t W_BIN = W_AO + (size_t)1024 * 1024 * 2;
constexpr size_t W_BQ  = W_BIN + (size_t)768 * 1024 * 2;
constexpr size_t W_BK  = W_BQ + (size_t)1536 * 384 * 2;
constexpr size_t W_BV  = W_BK + (size_t)1024 * 256 * 2;
constexpr size_t W_BO  = W_BV + (size_t)1024 * 256 * 2;
constexpr size_t W_CIN = W_BO + (size_t)1024 * 1024 * 2;
constexpr size_t W_CV  = W_CIN + (size_t)4096 * 1024 * 2;
constexpr size_t W_CO  = W_CV + (size_t)2048 * 1024 * 2;
constexpr size_t W_DIN = W_CO + (size_t)1024 * 2048 * 2;
constexpr size_t W_DG  = W_DIN + (size_t)2048 * 1024 * 2;
constexpr size_t W_DO  = W_DG + (size_t)2048 * 256 * 2;
constexpr size_t W_END = W_DO + (size_t)1024 * 1024 * 2;
constexpr size_t WS_XB = ((W_END + MiB - 1) / MiB) * MiB;
constexpr size_t WS_SS = WS_XB + (size_t)MTOK * DM * 2;
constexpr size_t WS_TA = WS_SS + (size_t)MTOK * 16 * 4;
constexpr size_t WS_TB = WS_TA + (size_t)MTOK * 32 * 4 * 2;
constexpr size_t WS_TC = WS_TB + (size_t)MTOK * 16 * 4 * 2;
constexpr size_t WS_R  = WS_TC + (size_t)MTOK * 64 * 4 * 2;
constexpr size_t SZ_AH = (size_t)3 * 8 * 16 * 2048 * 64 * 2;
constexpr size_t RA_Q = WS_R, RA_K = RA_Q + SZ_AH, RA_V = RA_K + SZ_AH, RA_O = RA_V + SZ_AH, RA_END = RA_O + (size_t)MTOK * DM * 2;
constexpr size_t RB_CQ = WS_R, RB_CKV = RB_CQ + (size_t)MTOK * 384 * 2, RB_KR = RB_CKV + (size_t)MTOK * 256 * 2, RB_SS = RB_KR + (size_t)MTOK * 32 * 4,
                 RB_QR = RB_SS + (size_t)MTOK * 32 * 4, RB_KB = RB_QR + (size_t)MTOK * 1536 * 2, RB_VT = RB_KB + (size_t)MTOK * 1536 * 2, RB_O = RB_VT + (size_t)MTOK * 1024 * 2, RB_END = RB_O + (size_t)MTOK * 1024 * 2;
constexpr size_t RC_Q = WS_R, RC_K = RC_Q + (size_t)MTOK * 1024 * 2, RC_G = RC_K + (size_t)MTOK * 1024 * 2, RC_VT = RC_G + (size_t)MTOK * 2048 * 2, RC_END = RC_VT + (size_t)MTOK * 2048 * 2;
constexpr size_t RD_GG = WS_R, RD_U = RD_GG + (size_t)MTOK * 1024 * 2, RD_UC = RD_U + (size_t)MTOK * 1024 * 2, RD_LA = RD_UC + (size_t)MTOK * 1024 * 2, RD_GU = RD_LA + (size_t)MTOK * 1024 * 4, RD_END = RD_GU + (size_t)MTOK * 1024 * 2;
constexpr size_t WS_NEED = RC_END > RA_END ? (RC_END > RB_END ? RC_END : RB_END) : (RA_END > RB_END ? RA_END : RB_END);
static_assert(RD_END <= WS_NEED && WS_R + (size_t)MTOK * DFF * 2 <= WS_NEED, "ws map");
static_assert(WS_NEED <= (size_t)738197504, "workspace must fit 4x the largest input");

constexpr int RING_BYTES = 131072, LDS_X_OFF = RING_BYTES, LDS_X_BYTES = 8192, MISC_OFF = LDS_X_OFF + LDS_X_BYTES, PT_OFF = MISC_OFF + 256, LDS_BYTES = 147456;

struct Args { const void* in[28]; float* out; unsigned char* ws; };

extern __shared__ __attribute__((aligned(16))) unsigned char lds_dyn[];
#define LDS_BASE() ((LAS unsigned char*)lds_dyn)
__device__ __forceinline__ float sum16(const float* p) {
    const f32x4 a = ((const GAS f32x4*)p)[0], b = ((const GAS f32x4*)p)[1], c = ((const GAS f32x4*)p)[2], d = ((const GAS f32x4*)p)[3];
    return ((a.x + a.y) + (a.z + a.w)) + ((b.x + b.y) + (b.z + b.w)) + ((c.x + c.y) + (c.z + c.w)) + ((d.x + d.y) + (d.z + d.w));
}
__device__ __forceinline__ float sum8(const float* p) {
    const f32x4 a = ((const GAS f32x4*)p)[0], b = ((const GAS f32x4*)p)[1];
    return ((a.x + a.y) + (a.z + a.w)) + ((b.x + b.y) + (b.z + b.w));
}
__device__ __forceinline__ float rs_of(const f32x4 s) { return rsqrtf(((s.x + s.y) + (s.z + s.w)) * (1.f / 1024.f) + NORM_EPS); }
__device__ __forceinline__ float row_rs(const float* SS, int row) { return rs_of(*(const GAS f32x4*)(SS + (size_t)row * 4)); }

struct EpiSwiGLU { static constexpr bool PERM = true;
    bf16_t* H; const float* SS;
    __device__ __forceinline__ void operator()(const AccT& acc, const pg8::Unit& u, int wr, int wc, int fr, int fq) const {
        const int row0 = u.pm * 256 + wr * 64 + fr, hcol = u.pn * 128 + wc * 32 + 8 * fq;
        f32x4 ssv[2][4];
#pragma unroll
        for (int ai = 0; ai < 2; ++ai)
#pragma unroll
            for (int m = 0; m < 4; ++m) ssv[ai][m] = *(const GAS f32x4*)(SS + (size_t)(row0 + ai * 128 + m * 16) * 4);
#pragma unroll
        for (int ai = 0; ai < 2; ++ai)
#pragma unroll
            for (int m = 0; m < 4; ++m) { const int row = row0 + ai * 128 + m * 16; const float rs = rs_of(ssv[ai][m]);
                float h[8];
#pragma unroll
                for (int n = 0; n < 2; ++n)
#pragma unroll
                    for (int j = 0; j < 4; ++j) { const float g = acc[ai][0][m][n][j] * rs, up = acc[ai][1][m][n][j] * rs; h[4 * n + j] = silu_f(g) * up; }
                u32x4 w; w.x = pk2(h[0], h[1]); w.y = pk2(h[2], h[3]); w.z = pk2(h[4], h[5]); w.w = pk2(h[6], h[7]);
                *(GAS u32x4*)(H + (size_t)row * DFF + hcol) = w; }
    }
};
struct EpiRes { static constexpr bool PERM = true;
    const float* base32; float* out32; bf16_t* XB; float* SS; float alpha;
    __device__ __forceinline__ void operator()(const AccT& acc, const pg8::Unit& u, int wr, int wc, int fr, int fq) const {
        const int row0 = u.pm * 256 + wr * 64 + fr, col0 = u.pn * 256 + wc * 32 + 8 * fq;
        LAS float* P = (LAS float*)(LDS_BASE() + LDS_X_OFF);
#pragma unroll
        for (int ai = 0; ai < 2; ++ai) {
            u32x4 xw[4][2];
            if (!base32) {
#pragma unroll
                for (int m = 0; m < 4; ++m)
#pragma unroll
                    for (int bj = 0; bj < 2; ++bj) xw[m][bj] = *(const GAS u32x4*)(XB + (size_t)(row0 + ai * 128 + m * 16) * DM + col0 + bj * 128);
            }
#pragma unroll
            for (int m = 0; m < 4; ++m) { const int row = row0 + ai * 128 + m * 16; float ssq = 0.f;
#pragma unroll
                for (int bj = 0; bj < 2; ++bj) { const size_t off = (size_t)row * DM + col0 + bj * 128;
                    f32x4 b0, b1;
                    if (base32) { b0 = *(const GAS f32x4*)(base32 + off); b1 = *(const GAS f32x4*)(base32 + off + 4); }
                    else { const u32x4 x_ = xw[m][bj]; b0 = (f32x4){bflo(x_.x), bfhi(x_.x), bflo(x_.y), bfhi(x_.y)}; b1 = (f32x4){bflo(x_.z), bfhi(x_.z), bflo(x_.w), bfhi(x_.w)}; }
                    const f32x4 x0 = b0 + acc[ai][bj][m][0] * alpha, x1 = b1 + acc[ai][bj][m][1] * alpha;
                    if (out32) { *(GAS f32x4*)(out32 + off) = x0; *(GAS f32x4*)(out32 + off + 4) = x1; }
                    ssq += (x0.x * x0.x + x0.y * x0.y) + (x0.z * x0.z + x0.w * x0.w) + (x1.x * x1.x + x1.y * x1.y) + (x1.z * x1.z + x1.w * x1.w);
                    if (!out32) { u32x4 w; w.x = pk2(x0.x, x0.y); w.y = pk2(x0.z, x0.w); w.z = pk2(x1.x, x1.y); w.w = pk2(x1.z, x1.w);
                        *(GAS u32x4*)(XB + off) = w; } }
                ssq += __shfl_xor(ssq, 16); ssq += __shfl_xor(ssq, 32);
                if (fq == 0) P[(ai * 128 + wr * 64 + m * 16 + fr) * 4 + wc] = ssq; }
        }
        lds_barrier();
        if (wc == 0 && fq == 0) {
#pragma unroll
            for (int ai = 0; ai < 2; ++ai)
#pragma unroll
                for (int m = 0; m < 4; ++m) { const int rl = ai * 128 + wr * 64 + m * 16 + fr; const f32x4 s = *(const LAS f32x4*)(P + rl * 4);
                    ((GAS float*)SS)[(size_t)(u.pm * 256 + rl) * 4 + u.pn] = (s.x + s.y) + (s.z + s.w); }
        }
    }
};
__device__ __forceinline__ void rope4(float pos, const f32x4 inv, f32x4& c, f32x4& s) {
#pragma unroll
    for (int j = 0; j < 4; ++j) { const float rv = (pos * inv[j]) * 0.15915494309189535f; const float fr = rv - floorf(rv); c[j] = __builtin_amdgcn_cosf(fr); s[j] = __builtin_amdgcn_sinf(fr); }
}
struct EpiAQK { static constexpr bool PERM = false;
    bf16_t* Q; bf16_t* Kb; const float* SS; const float* gq; const float* gk; const int* pos; int rowbase;
    __device__ __forceinline__ void operator()(const AccT& acc, const pg8::Unit& u, int wr, int wc, int fr, int fq) const {
        const int isk = u.pn >= 12 ? 1 : 0, hh = (u.pn - 12 * isk) * 4 + wc, g = hh >> 4, h = hh & 15, dsh = 2 * g;
        bf16_t* dst = isk ? Kb : Q; const float* gain = isk ? gk : gq; const float osc = isk ? 1.f : 0.125f * LOG2E;
        f32x4 ga[2][2], inv[2];
#pragma unroll
        for (int bj = 0; bj < 2; ++bj)
#pragma unroll
            for (int n = 0; n < 2; ++n) ga[bj][n] = *(const GAS f32x4*)(gain + 32 * bj + 16 * n + 4 * fq);
#pragma unroll
        for (int n = 0; n < 2; ++n)
#pragma unroll
            for (int j = 0; j < 4; ++j) inv[n][j] = exp2f(-(float)(16 * n + 4 * fq + j) * (13.287712379549449f / 32.f));
        f32x4 ssv[2][4]; float pv[2][4];
#pragma unroll
        for (int ai = 0; ai < 2; ++ai)
#pragma unroll
            for (int m = 0; m < 4; ++m) { const int row = rowbase + u.pm * 256 + ai * 128 + wr * 64 + m * 16 + fr; ssv[ai][m] = *(const GAS f32x4*)(SS + (size_t)row * 4); pv[ai][m] = (float)((const GAS int*)pos)[row]; }
#pragma unroll
        for (int ai = 0; ai < 2; ++ai)
#pragma unroll
            for (int m = 0; m < 4; ++m) { const int rl = u.pm * 256 + ai * 128 + wr * 64 + m * 16 + fr; const float rs = rs_of(ssv[ai][m]);
                f32x4 v[2][2]; float ss = 0.f;
#pragma unroll
                for (int bj = 0; bj < 2; ++bj)
#pragma unroll
                    for (int n = 0; n < 2; ++n) { v[bj][n] = acc[ai][bj][m][n] * rs; ss += (v[bj][n].x * v[bj][n].x + v[bj][n].y * v[bj][n].y) + (v[bj][n].z * v[bj][n].z + v[bj][n].w * v[bj][n].w); }
                ss += __shfl_xor(ss, 16); ss += __shfl_xor(ss, 32);
                const float hs = rsqrtf(ss * (1.f / 64.f) + NORM_EPS) * osc;
                const int bl = rl >> 11, s = rl & 2047, r = s & ((1 << dsh) - 1), j = s >> dsh, tp = r * (2048 >> dsh) + j;
                bf16_t* o = dst + ((size_t)((g * 8 + bl) * 16 + h) * 2048 + tp) * 64;
#pragma unroll
                for (int n = 0; n < 2; ++n) { f32x4 c, sn; rope4(pv[ai][m], inv[n], c, sn);
                    const f32x4 x1 = v[0][n] * ga[0][n] * hs, x2 = v[1][n] * ga[1][n] * hs;
                    const f32x4 o1 = x1 * c - x2 * sn, o2 = x2 * c + x1 * sn;
                    u32x2 w1, w2; w1.x = pk2(o1.x, o1.y); w1.y = pk2(o1.z, o1.w); w2.x = pk2(o2.x, o2.y); w2.y = pk2(o2.z, o2.w);
                    *(GAS u32x2*)(o + 16 * n + 4 * fq) = w1; *(GAS u32x2*)(o + 32 + 16 * n + 4 * fq) = w2; } }
    }
};
struct EpiVT { static constexpr bool PERM = true;
    bf16_t* O; size_t ldo; const float* SS; int sstride, soff, scnt; float sdiv; int mode, dsh, rowtok0; int tiled;
    __device__ __forceinline__ void operator()(const AccT& acc, const pg8::Unit& u, int wr, int wc, int fr, int fq) const {
        int tok0, tstride, thoff;
        if (mode == 1) { const int b = u.pn >> 3, tt = u.pn & 7; int t0;
            if (dsh == 0) { t0 = 256 * tt; tstride = 1; thoff = 128; } else if (dsh == 2) { t0 = 4 * ((tt & 1) * 256) + (tt >> 1); tstride = 4; thoff = 512; } else { t0 = 2 * tt; tstride = 16; thoff = 1; }
            tok0 = rowtok0 + b * SEQ + t0; }
        else { tok0 = u.pn * 256; tstride = 1; thoff = 128; }
        float myv;
        {   const int l = fr + 16 * fq, tok = tok0 + tstride * (32 * wc + (l & 31)) + thoff * (l >> 5); const float* p = SS + (size_t)tok * sstride + soff;
            float s; if (scnt == 4) { const f32x4 q = *(const f32x4*)p; s = (q.x + q.y) + (q.z + q.w); } else s = sum8(p); myv = rsqrtf(s / sdiv + NORM_EPS); }
        float sc[2][8];
#pragma unroll
        for (int bj = 0; bj < 2; ++bj)
#pragma unroll
            for (int e = 0; e < 8; ++e) sc[bj][e] = __shfl(myv, bj * 32 + 8 * fq + e);
#pragma unroll
        for (int ai = 0; ai < 2; ++ai)
#pragma unroll
            for (int m = 0; m < 4; ++m) { const int orow = u.pm * 256 + ai * 128 + wr * 64 + m * 16 + fr;
#pragma unroll
                for (int bj = 0; bj < 2; ++bj) { const f32x4 a0 = acc[ai][bj][m][0], a1 = acc[ai][bj][m][1];
                    u32x4 w; w.x = pk2(a0.x * sc[bj][0], a0.y * sc[bj][1]); w.y = pk2(a0.z * sc[bj][2], a0.w * sc[bj][3]); w.z = pk2(a1.x * sc[bj][4], a1.y * sc[bj][5]); w.w = pk2(a1.z * sc[bj][6], a1.w * sc[bj][7]);
                    const size_t col0 = (size_t)u.pn * 256 + 128 * bj + 32 * wc + 8 * fq;
                    if (tiled) *(GAS u32x4*)(O + ((size_t)(orow >> 5) * (ldo >> 4) + (col0 >> 4)) * 512 + ((((int)col0 >> 3) & 1) * 32 + (orow & 31)) * 8) = w;
                    else *(GAS u32x4*)(O + (size_t)orow * ldo + col0) = w; } }
    }
};
struct EpiBIn { static constexpr bool PERM = true;
    bf16_t* CQ; bf16_t* CKV; float* KR; float* SSB; const float* SS;
    __device__ __forceinline__ void operator()(const AccT& acc, const pg8::Unit& u, int wr, int wc, int fr, int fq) const {
        f32x4 ssv[2][4];
#pragma unroll
        for (int ai = 0; ai < 2; ++ai)
#pragma unroll
            for (int m = 0; m < 4; ++m) ssv[ai][m] = *(const GAS f32x4*)(SS + (size_t)(u.pm * 256 + ai * 128 + wr * 64 + m * 16 + fr) * 4);
#pragma unroll
        for (int ai = 0; ai < 2; ++ai)
#pragma unroll
            for (int m = 0; m < 4; ++m) { const int row = u.pm * 256 + ai * 128 + wr * 64 + m * 16 + fr; const float rs = rs_of(ssv[ai][m]);
#pragma unroll
                for (int bj = 0; bj < 2; ++bj) { const int col = u.pn * 256 + bj * 128 + wc * 32 + 8 * fq;
                    const f32x4 v0 = acc[ai][bj][m][0] * rs, v1 = acc[ai][bj][m][1] * rs;
                    float ss = (v0.x * v0.x + v0.y * v0.y) + (v0.z * v0.z + v0.w * v0.w) + (v1.x * v1.x + v1.y * v1.y) + (v1.z * v1.z + v1.w * v1.w);
                    ss += __shfl_xor(ss, 16); ss += __shfl_xor(ss, 32);
                    if (col < 672) { if (fq == 0) ((GAS float*)SSB)[(size_t)row * 32 + (col >> 5)] = ss;
                        if (col < 640) { u32x4 w; w.x = pk2(v0.x, v0.y); w.y = pk2(v0.z, v0.w); w.z = pk2(v1.x, v1.y); w.w = pk2(v1.z, v1.w);
                            if (col < 384) *(GAS u32x4*)(CQ + (size_t)row * 384 + col) = w; else *(GAS u32x4*)(CKV + (size_t)row * 256 + (col - 384)) = w; }
                        else { *(GAS f32x4*)(KR + (size_t)row * 32 + (col - 640)) = v0; *(GAS f32x4*)(KR + (size_t)row * 32 + (col - 640) + 4) = v1; } } } }
    }
};
struct EpiRowScale { static constexpr bool PERM = true;
    bf16_t* O; int ldo; bf16_t* O2; int ld2; int split; const float* SS; int sstride, soff, scnt; float sdiv; int act;
    __device__ __forceinline__ void operator()(const AccT& acc, const pg8::Unit& u, int wr, int wc, int fr, int fq) const {
#pragma unroll
        for (int ai = 0; ai < 2; ++ai) {
            float rsv[4];
#pragma unroll
            for (int m = 0; m < 4; ++m) { const int row = u.pm * 256 + ai * 128 + wr * 64 + m * 16 + fr;
                const float* p = SS + (size_t)row * sstride + soff; float s; if (scnt == 4) { const f32x4 q = *(const f32x4*)p; s = (q.x + q.y) + (q.z + q.w); } else { s = sum8(p); if (scnt >= 12) s += ((const GAS f32x4*)p)[2].x + ((const GAS f32x4*)p)[2].y + ((const GAS f32x4*)p)[2].z + ((const GAS f32x4*)p)[2].w; }
                rsv[m] = s; }
#pragma unroll
            for (int m = 0; m < 4; ++m) { const int row = u.pm * 256 + ai * 128 + wr * 64 + m * 16 + fr;
                const float rs = rsqrtf(rsv[m] / sdiv + NORM_EPS);
#pragma unroll
                for (int bj = 0; bj < 2; ++bj) { const int col = u.pn * 256 + bj * 128 + wc * 32 + 8 * fq;
                    f32x4 v0 = acc[ai][bj][m][0] * rs, v1 = acc[ai][bj][m][1] * rs;
                    if (act == 1 && col < split) { v0 = (f32x4){gelu_tanh_f(v0.x), gelu_tanh_f(v0.y), gelu_tanh_f(v0.z), gelu_tanh_f(v0.w)}; v1 = (f32x4){gelu_tanh_f(v1.x), gelu_tanh_f(v1.y), gelu_tanh_f(v1.z), gelu_tanh_f(v1.w)}; }
                    u32x4 w; w.x = pk2(v0.x, v0.y); w.y = pk2(v0.z, v0.w); w.z = pk2(v1.x, v1.y); w.w = pk2(v1.z, v1.w);
                    if (col < split) *(GAS u32x4*)(O + (size_t)row * ldo + col) = w; else *(GAS u32x4*)(O2 + (size_t)row * ld2 + (col - split)) = w; } }
        }
    }
};
struct EpiBK { static constexpr bool PERM = false;
    bf16_t* KB; const float* SSB; const float* KR; const float* gk; const float* cosT; const float* sinT;
    __device__ __forceinline__ void operator()(const AccT& acc, const pg8::Unit& u, int wr, int wc, int fr, int fq) const {
        const int h = u.pn * 4 + wc;
        f32x4 ga[2][2];
#pragma unroll
        for (int bj = 0; bj < 2; ++bj)
#pragma unroll
            for (int n = 0; n < 2; ++n) ga[bj][n] = *(const GAS f32x4*)(gk + 32 * bj + 16 * n + 4 * fq);
        const f32x4 gr1 = *(const GAS f32x4*)(gk + 64 + 4 * fq), gr2 = *(const GAS f32x4*)(gk + 80 + 4 * fq);
#pragma unroll
        for (int ai = 0; ai < 2; ++ai)
#pragma unroll
            for (int mh = 0; mh < 2; ++mh) {
                f32x4 s0[2], s1[2], kr1[2], kr2[2], cs[2], sv[2]; float ssr[2];
#pragma unroll
                for (int mm = 0; mm < 2; ++mm) { const int row = u.pm * 256 + ai * 128 + wr * 64 + (2 * mh + mm) * 16 + fr; const float* sp = SSB + (size_t)row * 32;
                    s0[mm] = *(const GAS f32x4*)(sp + 12); s1[mm] = *(const GAS f32x4*)(sp + 16); ssr[mm] = ((const GAS float*)sp)[20];
                    kr1[mm] = *(const GAS f32x4*)(KR + (size_t)row * 32 + 4 * fq); kr2[mm] = *(const GAS f32x4*)(KR + (size_t)row * 32 + 16 + 4 * fq);
                    cs[mm] = *(const GAS f32x4*)(cosT + (size_t)row * 16 + 4 * fq); sv[mm] = *(const GAS f32x4*)(sinT + (size_t)row * 16 + 4 * fq); }
#pragma unroll
                for (int mm = 0; mm < 2; ++mm) { const int m = 2 * mh + mm; const int row = u.pm * 256 + ai * 128 + wr * 64 + m * 16 + fr;
                    const float rkv = rsqrtf((((s0[mm].x + s0[mm].y) + (s0[mm].z + s0[mm].w)) + ((s1[mm].x + s1[mm].y) + (s1[mm].z + s1[mm].w))) * (1.f / 256.f) + NORM_EPS);
                    f32x4 v[2][2]; float ss = 0.f;
#pragma unroll
                    for (int bj = 0; bj < 2; ++bj)
#pragma unroll
                        for (int n = 0; n < 2; ++n) { v[bj][n] = acc[ai][bj][m][n] * rkv; ss += (v[bj][n].x * v[bj][n].x + v[bj][n].y * v[bj][n].y) + (v[bj][n].z * v[bj][n].z + v[bj][n].w * v[bj][n].w); }
                    ss += __shfl_xor(ss, 16); ss += __shfl_xor(ss, 32);
                    const float sk = rsqrtf((ss + ssr[mm]) * (1.f / 96.f) + NORM_EPS);
                    const int b = row >> 11, s = row & 2047;
                    bf16_t* o = KB + ((size_t)(b * 16 + h) * 2048 + s) * 96;
#pragma unroll
                    for (int bj = 0; bj < 2; ++bj)
#pragma unroll
                        for (int n = 0; n < 2; ++n) { const f32x4 y = v[bj][n] * ga[bj][n] * sk; u32x2 w; w.x = pk2(y.x, y.y); w.y = pk2(y.z, y.w); *(GAS u32x2*)(o + 32 * bj + 16 * n + 4 * fq) = w; }
                    const f32x4 k1 = kr1[mm] * gr1 * sk, k2 = kr2[mm] * gr2 * sk;
                    const f32x4 o1 = k1 * cs[mm] - k2 * sv[mm], o2 = k2 * cs[mm] + k1 * sv[mm];
                    u32x2 w1, w2; w1.x = pk2(o1.x, o1.y); w1.y = pk2(o1.z, o1.w); w2.x = pk2(o2.x, o2.y); w2.y = pk2(o2.z, o2.w);
                    *(GAS u32x2*)(o + 64 + 4 * fq) = w1; *(GAS u32x2*)(o + 80 + 4 * fq) = w2; }
            }
    }
};
struct EpiCIn { static constexpr bool PERM = false;
    bf16_t* Q; bf16_t* Kc; bf16_t* G; const float* SS; const int* pos;
    __device__ __forceinline__ void operator()(const AccT& acc, const pg8::Unit& u, int wr, int wc, int fr, int fq) const {
        f32x4 ssv[2][4];
#pragma unroll
        for (int ai = 0; ai < 2; ++ai)
#pragma unroll
            for (int m = 0; m < 4; ++m) ssv[ai][m] = *(const GAS f32x4*)(SS + (size_t)(u.pm * 256 + ai * 128 + wr * 64 + m * 16 + fr) * 4);
        if (u.pn >= 8) {
#pragma unroll
            for (int ai = 0; ai < 2; ++ai)
#pragma unroll
                for (int m = 0; m < 4; ++m) { const int row = u.pm * 256 + ai * 128 + wr * 64 + m * 16 + fr; const float rs = rs_of(ssv[ai][m]);
#pragma unroll
                    for (int bj = 0; bj < 2; ++bj)
#pragma unroll
                        for (int n = 0; n < 2; ++n) { const f32x4 v = acc[ai][bj][m][n] * rs; u32x2 w; w.x = pk2(v.x, v.y); w.y = pk2(v.z, v.w);
                            *(GAS u32x2*)(G + (size_t)row * 2048 + (u.pn - 8) * 256 + bj * 128 + wc * 32 + 16 * n + 4 * fq) = w; } }
            return; }
        const int isk = u.pn >= 4 ? 1 : 0, h = (u.pn & 3) * 2 + (wc >> 1);
        bf16_t* dst = isk ? Kc : Q;
        const float lg = log2f(1.f - exp2f(-5.f - (float)h));
        const float ksc = isk ? 0.08838834764831845f : 1.f;
        float pv[2][4]; f32x4 inv[2];
#pragma unroll
        for (int ai = 0; ai < 2; ++ai)
#pragma unroll
            for (int m = 0; m < 4; ++m) pv[ai][m] = (float)((const GAS int*)pos)[u.pm * 256 + ai * 128 + wr * 64 + m * 16 + fr];
#pragma unroll
        for (int n = 0; n < 2; ++n)
#pragma unroll
            for (int j = 0; j < 4; ++j) inv[n][j] = exp2f(-(float)(32 * (wc & 1) + 16 * n + 4 * fq + j) * (13.287712379549449f / 64.f));
#pragma unroll
        for (int ai = 0; ai < 2; ++ai)
#pragma unroll
            for (int m = 0; m < 4; ++m) { const int row = u.pm * 256 + ai * 128 + wr * 64 + m * 16 + fr; const float rs = rs_of(ssv[ai][m]);
                const int b = row >> 11, s = row & 2047, il = s & 127;
                const float dec = fast_exp2((isk ? -(float)(il + 1) : (float)(il + 1)) * lg) * ksc * rs;
                bf16_t* o = dst + ((size_t)(b * 8 + h) * 2048 + s) * 128;
#pragma unroll
                for (int n = 0; n < 2; ++n) { const int i0 = 32 * (wc & 1) + 16 * n + 4 * fq; f32x4 c, sn; rope4(pv[ai][m], inv[n], c, sn);
                    const f32x4 x1 = acc[ai][0][m][n] * dec, x2 = acc[ai][1][m][n] * dec;
                    const f32x4 o1 = x1 * c - x2 * sn, o2 = x2 * c + x1 * sn;
                    u32x2 w1, w2; w1.x = pk2(o1.x, o1.y); w1.y = pk2(o1.z, o1.w); w2.x = pk2(o2.x, o2.y); w2.y = pk2(o2.z, o2.w);
                    *(GAS u32x2*)(o + i0) = w1; *(GAS u32x2*)(o + 64 + i0) = w2; } }
    }
};
struct EpiDGate { static constexpr bool PERM = true;
    bf16_t* LA; bf16_t* GU; const bf16_t* UC; const float* brg; const float* big; const float* lam;
    __device__ __forceinline__ void operator()(const AccT& acc, const pg8::Unit& u, int wr, int wc, int fr, int fq) const {
        const int ch = u.pn * 128 + wc * 32 + 8 * fq;
        u32x4 ucv[2][4];
#pragma unroll
        for (int ai = 0; ai < 2; ++ai)
#pragma unroll
            for (int m = 0; m < 4; ++m) ucv[ai][m] = *(const GAS u32x4*)(UC + (size_t)(u.pm * 256 + ai * 128 + wr * 64 + m * 16 + fr) * 1024 + ch);
        float b1[8], b2[8], sp[8];
#pragma unroll
        for (int e = 0; e < 8; ++e) { b1[e] = ((const GAS float*)brg)[ch + e]; b2[e] = ((const GAS float*)big)[ch + e]; sp[e] = ((const GAS float*)lam)[ch + e]; }
#pragma unroll
        for (int ai = 0; ai < 2; ++ai)
#pragma unroll
            for (int m = 0; m < 4; ++m) { const int row = u.pm * 256 + ai * 128 + wr * 64 + m * 16 + fr;
                const u32x4 uw = ucv[ai][m];
                float uc[8] = {bflo(uw.x), bfhi(uw.x), bflo(uw.y), bfhi(uw.y), bflo(uw.z), bfhi(uw.z), bflo(uw.w), bfhi(uw.w)};
                float la[8], gu[8];
#pragma unroll
                for (int n = 0; n < 2; ++n)
#pragma unroll
                    for (int j = 0; j < 4; ++j) { const int e = 4 * n + j; const float r = sigmoid_f(acc[ai][0][m][n][j] + b1[e]), ig = sigmoid_f(acc[ai][1][m][n][j] + b2[e]);
                        la[e] = sp[e] * r; gu[e] = ig * uc[e]; }
                { u32x4 wl; wl.x = pk2(la[0], la[1]); wl.y = pk2(la[2], la[3]); wl.z = pk2(la[4], la[5]); wl.w = pk2(la[6], la[7]); *(GAS u32x4*)(LA + (size_t)row * 1024 + ch) = wl; }
                u32x4 w; w.x = pk2(gu[0], gu[1]); w.y = pk2(gu[2], gu[3]); w.z = pk2(gu[4], gu[5]); w.w = pk2(gu[6], gu[7]);
                *(GAS u32x4*)(GU + (size_t)row * 1024 + ch) = w; }
    }
};

#define LDS_WAIT() asm volatile("s_waitcnt lgkmcnt(0)" ::: "memory")
template <class F> __device__ __forceinline__ void prep_matrix(bf16_t* Bt, int N, int K, F src4, LAS float* scr, int gw, int NGW, int lane, int& off) {
    const int nblk = N / 32, items = nblk * (K / 64);
    int first = gw - off; if (first < 0) first += NGW;
    off = (off + items) % NGW;
    for (int it = first; it < items; it += NGW) {
        const int kb = it / nblk, nb = it % nblk, k0 = 64 * kb, n0 = 32 * nb;
        const int n4 = (lane & 7) * 4;
#pragma unroll
        for (int i = 0; i < 8; ++i) { const int kk = (lane >> 3) + 8 * i; const f32x4 v = src4(n0 + n4, k0 + kk); LAS float* d = scr + kk * 33 + n4; d[0] = v.x; d[1] = v.y; d[2] = v.z; d[3] = v.w; }
        LDS_WAIT(); asm volatile("" ::: "memory");
        const int c = lane & 7;
#pragma unroll
        for (int j = 0; j < 4; ++j) { const int n = (lane >> 3) + 8 * j; const LAS float* s = scr + (8 * c) * 33 + n;
            u32x4 o; o.x = pk2(s[0 * 33], s[1 * 33]); o.y = pk2(s[2 * 33], s[3 * 33]); o.z = pk2(s[4 * 33], s[5 * 33]); o.w = pk2(s[6 * 33], s[7 * 33]);
            *(u32x4*)(Bt + (size_t)(n0 + n) * K + k0 + 8 * c) = o; }
        LDS_WAIT(); asm volatile("" ::: "memory");
    }
}
#define LD4(p) (*(const f32x4*)(p))

#define MFMA32(a, b, c) __builtin_amdgcn_mfma_f32_32x32x16_bf16((a), (b), (c), 0, 0, 0)
__device__ __forceinline__ bf16x8 mk8(u32x2 lo, u32x2 hi) { u32x4 v = {lo.x, lo.y, hi.x, hi.y}; return __builtin_bit_cast(bf16x8, v); }
__device__ __forceinline__ bf16x8 pack8(const f32x16& p, int ks) {
    u32x4 v; v.x = pk2(p[8 * ks + 0], p[8 * ks + 1]); v.y = pk2(p[8 * ks + 2], p[8 * ks + 3]); v.z = pk2(p[8 * ks + 4], p[8 * ks + 5]); v.w = pk2(p[8 * ks + 6], p[8 * ks + 7]);
    return __builtin_bit_cast(bf16x8, v);
}

__device__ __forceinline__ void mixA_attn(LAS unsigned char* lds, const bf16_t* QA, const bf16_t* KA, const bf16_t* VT, bf16_t* OA, int half, float shift) {
    const int tid = opaque_tid(), lane = tid & 63, wid = __builtin_amdgcn_readfirstlane(tid >> 6), r32 = lane & 31, hi = lane >> 5;
    LAS float* Ol = (LAS float*)lds; LAS float* Ll = (LAS float*)(lds + LDS_X_OFF);
#pragma unroll 1
    for (int ui = blockIdx.x; ui < 512; ui += gridDim.x) {
        const int blh = (ui & 255) >> 1, k_ = ui >> 8, c = (ui & 1) ? (1 + k_) : (3 * k_);
        const int bl = blh >> 4, h = blh & 15;
#pragma unroll 1
        for (int g = 0; g < 3; ++g) {
            const int dsh = 2 * g, L = 2048 >> dsh, tsh = 4 - dsh;
            const size_t hb = ((size_t)((g * 8 + bl) * 16 + h)) * 2048;
            const bf16_t* vbase = VT + ((size_t)(g * 1024 + h * 64)) * 16384 + (size_t)bl * 2048;
#pragma unroll 1
            for (int tt = 0; tt < 2; ++tt) {
                const int tau = 2 * wid + tt, r = tau >> tsh, a = (c << tsh) + (tau & ((1 << tsh) - 1));
                const size_t rb = hb + (size_t)r * L;
                bf16x8 qf[4];
#pragma unroll
                for (int d0 = 0; d0 < 4; ++d0) qf[d0] = *(const bf16x8*)(QA + (rb + 32 * a + r32) * 64 + 16 * d0 + 8 * hi);
                f32x16 o0 = {}, o1 = {}; float lsum = 0.f;
                const int kb0 = a - 4 < 0 ? 0 : a - 4;
                const bf16_t* kp0 = KA + (rb + r32) * 64 + 8 * hi;
                const bf16_t* vp0 = VT + ((size_t)(g * 32 + 2 * h) * 1024 + (size_t)((bl * 2048 + r * L) >> 4)) * 512 + r32 * 8 + 4 * hi;
                bf16x8 kf[4]; u32x2 vl[2][2][2];
#define A_LOAD(KF, VL, kb_) do { _Pragma("unroll") for (int d0 = 0; d0 < 4; ++d0) KF[d0] = *(const bf16x8*)(kp0 + (size_t)(32 * (kb_)) * 64 + 16 * d0); \
                    _Pragma("unroll") for (int db = 0; db < 2; ++db) _Pragma("unroll") for (int ks = 0; ks < 2; ++ks) { const bf16_t* f_ = vp0 + ((size_t)db * 1024 + 2 * (kb_) + ks) * 512; VL[db][ks][0] = *(const u32x2*)(f_); VL[db][ks][1] = *(const u32x2*)(f_ + 256); } } while (0)
                A_LOAD(kf, vl, kb0);
#pragma unroll 1
                for (int kb = kb0; kb <= a; ++kb) {
                    bf16x8 kfn[4]; u32x2 vln[2][2][2];
                    const int kbn = kb < a ? kb + 1 : kb;
                    A_LOAD(kfn, vln, kbn);
                    f32x16 st = {};
#pragma unroll
                    for (int d0 = 0; d0 < 4; ++d0) st = MFMA32(kf[d0], qf[d0], st);
                    const int thi = ((kb == a) ? r32 : 63) - 4 * hi, tlo = ((kb == a - 4) ? r32 : -1) - 4 * hi;
#pragma unroll
                    for (int rr = 0; rr < 16; ++rr) { const int kc = (rr & 3) + 8 * (rr >> 2); const bool ok = (kc <= thi) && (kc >= tlo);
                        const float p = ok ? fast_exp2(st[rr] - shift) : 0.f; st[rr] = p; lsum += p; }
                    const bf16x8 p0 = pack8(st, 0), p1 = pack8(st, 1);
                    o0 = MFMA32(mk8(vl[0][0][0], vl[0][0][1]), p0, o0); o0 = MFMA32(mk8(vl[0][1][0], vl[0][1][1]), p1, o0);
                    o1 = MFMA32(mk8(vl[1][0][0], vl[1][0][1]), p0, o1); o1 = MFMA32(mk8(vl[1][1][0], vl[1][1][1]), p1, o1);
#pragma unroll
                    for (int d0 = 0; d0 < 4; ++d0) kf[d0] = kfn[d0];
#pragma unroll
                    for (int db = 0; db < 2; ++db)
#pragma unroll
                        for (int ks = 0; ks < 2; ++ks) { vl[db][ks][0] = vln[db][ks][0]; vl[db][ks][1] = vln[db][ks][1]; }
                }
#undef A_LOAD
                lsum += __shfl_xor(lsum, 32);
                const int pp = ((32 * a + r32) << dsh) + r - 512 * c;
#pragma unroll
                for (int db = 0; db < 2; ++db)
#pragma unroll
                    for (int q4 = 0; q4 < 4; ++q4) { const int ch = 2 * q4 + hi + 8 * db; LAS f32x4* ad = (LAS f32x4*)(Ol + pp * 64 + ((ch ^ ((pp ^ (pp >> 4)) & 15)) << 2));
                        const f32x16& o = db ? o1 : o0; f32x4 v = {o[4 * q4], o[4 * q4 + 1], o[4 * q4 + 2], o[4 * q4 + 3]};
                        if (g > 0) v += *ad; *ad = v; }
                if (hi == 0) Ll[pp] = (g > 0 ? Ll[pp] : 0.f) + lsum;
            }
            __syncthreads();
        }
        for (int idx = tid; idx < 4096; idx += 512) { const int pp = idx >> 3, c8 = idx & 7; const float inv = 1.f / Ll[pp];
            const f32x4 a = *(LAS f32x4*)(Ol + pp * 64 + (((2 * c8) ^ ((pp ^ (pp >> 4)) & 15)) << 2)), b = *(LAS f32x4*)(Ol + pp * 64 + (((2 * c8 + 1) ^ ((pp ^ (pp >> 4)) & 15)) << 2));
            u32x4 w; w.x = pk2(a.x * inv, a.y * inv); w.y = pk2(a.z * inv, a.w * inv); w.z = pk2(b.x * inv, b.y * inv); w.w = pk2(b.z * inv, b.w * inv);
            *(u32x4*)(OA + ((size_t)(half * 8 + bl) * 2048 + 512 * c + pp) * 1024 + h * 64 + 8 * c8) = w; }
        __syncthreads();
    }
}

constexpr int BK_STRIDE = 208, BK_TILE = 64 * BK_STRIDE, BV_STRIDE = 144, BV_TILE = 64 * BV_STRIDE;
__device__ __forceinline__ void mixB_attn(LAS unsigned char* lds, const bf16_t* QR, const bf16_t* KB, const bf16_t* VT, bf16_t* OB, const float* gq, const float* cosT, const float* sinT, float shift) {
    const int tid = opaque_tid(), lane = tid & 63, wid = __builtin_amdgcn_readfirstlane(tid >> 6), r32 = lane & 31, hi = lane >> 5;
    const float qsc = 0.10206207261596575f * LOG2E;
    LAS unsigned char* Kl = lds; LAS unsigned char* Vl = lds + 2 * BK_TILE;
    const int c2 = tid + 512;
    const int kdst1 = (tid / 12) * BK_STRIDE + 16 * (tid % 12), kdst2 = (c2 / 12) * BK_STRIDE + 16 * (c2 % 12);
    const int vd = tid >> 3, c8 = tid & 7, vdst = vd * BV_STRIDE + 2 * (16 * (c8 >> 1) + 4 * (c8 & 1));
    const int kfo = r32 * BK_STRIDE + 16 * hi, vfo = r32 * BV_STRIDE + 16 * hi;
#pragma unroll 1
    for (int unit = blockIdx.x; unit < 256; unit += gridDim.x) {
        const int b = unit >> 4, h = unit & 15;
        const bf16_t* kbase = KB + (size_t)(b * 16 + h) * 2048 * 96;
        const bf16_t* vsrc = VT + (size_t)(h * 64 + vd) * MTOK + (size_t)b * 2048 + 8 * c8;
#pragma unroll 1
        for (int qb = 0; qb < 8; ++qb) {
            const int qfirst = 256 * qb + 32 * wid, row = b * 2048 + qfirst + r32;
            bf16x8 qf[6];
            {   float qv[6][8]; float ss = 0.f;
#pragma unroll
                for (int d0 = 0; d0 < 6; ++d0) { const u32x4 w = *(const u32x4*)(QR + (size_t)row * 1536 + h * 96 + 16 * d0 + 8 * hi);
                    qv[d0][0] = bflo(w.x); qv[d0][1] = bfhi(w.x); qv[d0][2] = bflo(w.y); qv[d0][3] = bfhi(w.y); qv[d0][4] = bflo(w.z); qv[d0][5] = bfhi(w.z); qv[d0][6] = bflo(w.w); qv[d0][7] = bfhi(w.w);
#pragma unroll
                    for (int e = 0; e < 8; ++e) ss += qv[d0][e] * qv[d0][e]; }
                ss += __shfl_xor(ss, 32);
                const float sq = rsqrtf(ss * (1.f / 96.f) + NORM_EPS) * qsc;
#pragma unroll
                for (int d0 = 0; d0 < 6; ++d0)
#pragma unroll
                    for (int e = 0; e < 8; ++e) qv[d0][e] *= sq * gq[16 * d0 + 8 * hi + e];
#pragma unroll
                for (int e = 0; e < 8; ++e) { const float c = cosT[(size_t)row * 16 + 8 * hi + e], sn = sinT[(size_t)row * 16 + 8 * hi + e]; const float x1 = qv[4][e], x2 = qv[5][e];
                    qv[4][e] = x1 * c - x2 * sn; qv[5][e] = x2 * c + x1 * sn; }
#pragma unroll
                for (int d0 = 0; d0 < 6; ++d0) { u32x4 w; w.x = pk2(qv[d0][0], qv[d0][1]); w.y = pk2(qv[d0][2], qv[d0][3]); w.z = pk2(qv[d0][4], qv[d0][5]); w.w = pk2(qv[d0][6], qv[d0][7]); qf[d0] = __builtin_bit_cast(bf16x8, w); }
            }
            f32x16 negs;
#pragma unroll
            for (int rr = 0; rr < 16; ++rr) negs[rr] = -shift;
            f32x16 o0 = {}, o1 = {}; float lsum = 0.f;
            const int ntile = 4 * qb + 4;
            {
                const u32x4 k1 = *(const u32x4*)(kbase + 8 * tid); u32x4 k2 = {}; if (tid < 256) k2 = *(const u32x4*)(kbase + 8 * c2);
                const u32x4 v1 = *(const u32x4*)(vsrc);
                *(LAS u32x4*)(Kl + kdst1) = k1; if (tid < 256) *(LAS u32x4*)(Kl + kdst2) = k2;
                *(LAS u32x2*)(Vl + vdst) = (u32x2){v1.x, v1.y}; *(LAS u32x2*)(Vl + vdst + 16) = (u32x2){v1.z, v1.w};
            }
            __syncthreads();
#pragma unroll 1
            for (int t = 0; t < ntile; ++t) {
                const bool more = (t + 1 < ntile);
                u32x4 k1 = {}, k2 = {}, v1 = {};
                if (more) { const bf16_t* kt = kbase + (size_t)(t + 1) * 64 * 96; k1 = *(const u32x4*)(kt + 8 * tid); if (tid < 256) k2 = *(const u32x4*)(kt + 8 * c2); v1 = *(const u32x4*)(vsrc + 64 * (t + 1)); }
                const LAS unsigned char* Kt = Kl + (t & 1) * BK_TILE; const LAS unsigned char* Vt = Vl + (t & 1) * BV_TILE;
#pragma unroll
                for (int kblk = 0; kblk < 2; ++kblk) {
                    const int key0 = 64 * t + 32 * kblk;
                    if (key0 <= qfirst + 31) {
                        f32x16 st = negs;
#pragma unroll
                        for (int d0 = 0; d0 < 6; ++d0) { const bf16x8 kf = *(const LAS bf16x8*)(Kt + kblk * 32 * BK_STRIDE + kfo + 32 * d0); st = MFMA32(kf, qf[d0], st); }
                        if (key0 + 31 > qfirst) {
                            const int thi = (qfirst - key0 + r32) - 4 * hi;
#pragma unroll
                            for (int rr = 0; rr < 16; ++rr) { const int kc = (rr & 3) + 8 * (rr >> 2); const float p = (kc <= thi) ? fast_exp2(st[rr]) : 0.f; st[rr] = p; lsum += p; }
                        } else {
#pragma unroll
                            for (int rr = 0; rr < 16; ++rr) { const float p = fast_exp2(st[rr]); st[rr] = p; lsum += p; }
                        }
                        const bf16x8 p0 = pack8(st, 0), p1 = pack8(st, 1);
                        const LAS unsigned char* vp = Vt + vfo + 2 * (32 * kblk);
                        o0 = MFMA32(*(const LAS bf16x8*)(vp), p0, o0); o0 = MFMA32(*(const LAS bf16x8*)(vp + 32), p1, o0);
                        o1 = MFMA32(*(const LAS bf16x8*)(vp + 32 * BV_STRIDE), p0, o1); o1 = MFMA32(*(const LAS bf16x8*)(vp + 32 * BV_STRIDE + 32), p1, o1);
                    }
                }
                if (more) { LAS unsigned char* Kn = Kl + ((t + 1) & 1) * BK_TILE; LAS unsigned char* Vn = Vl + ((t + 1) & 1) * BV_TILE;
                    *(LAS u32x4*)(Kn + kdst1) = k1; if (tid < 256) *(LAS u32x4*)(Kn + kdst2) = k2;
                    *(LAS u32x2*)(Vn + vdst) = (u32x2){v1.x, v1.y}; *(LAS u32x2*)(Vn + vdst + 16) = (u32x2){v1.z, v1.w}; }
                __syncthreads();
            }
            lsum += __shfl_xor(lsum, 32);
            const float inv = 1.f / lsum;
            bf16_t* op = OB + (size_t)row * 1024 + h * 64;
#pragma unroll
            for (int db = 0; db < 2; ++db)
#pragma unroll
                for (int q4 = 0; q4 < 4; ++q4) { const f32x16& o = db ? o1 : o0; u32x2 w; w.x = pk2(o[4 * q4] * inv, o[4 * q4 + 1] * inv); w.y = pk2(o[4 * q4 + 2] * inv, o[4 * q4 + 3] * inv);
                    *(u32x2*)(op + 32 * db + 8 * q4 + 4 * hi) = w; }
        }
    }
}

constexpr int KT_STRIDE = 272, RT_STRIDE = 272, YS_STRIDE = 528;
constexpr int RET_KR = 0, RET_YS = 128 * KT_STRIDE, RET_RT = 2 * 128 * KT_STRIDE, RET_ST = MISC_OFF + 1024;
static_assert(RET_YS + 64 * YS_STRIDE <= RET_RT && RET_RT + 256 * RT_STRIDE <= MISC_OFF && RET_ST + 2048 <= LDS_BYTES, "retention LDS map");
typedef short v4i16_t __attribute__((ext_vector_type(4)));
__device__ __forceinline__ u32x2 lds_tr(const LAS unsigned char* p) { return __builtin_bit_cast(u32x2, __builtin_amdgcn_ds_read_tr16_b64_v4i16((LAS v4i16_t*)p)); }
__device__ __forceinline__ void mixC_retention(LAS unsigned char* lds, const bf16_t* QC, const bf16_t* KC, const bf16_t* VT, bf16_t* G) {
    const int tid = opaque_tid(), lane = tid & 63, wid = __builtin_amdgcn_readfirstlane(tid >> 6), r32 = lane & 31, hi = lane >> 5;
    LAS unsigned char* KR = lds + RET_KR; LAS unsigned char* YS = lds + RET_YS; LAS unsigned char* RT = lds + RET_RT; LAS float* ST = (LAS float*)(lds + RET_ST);
    const int trb = (8 * hi + ((lane & 15) >> 2)) * KT_STRIDE + (16 * ((lane >> 4) & 1) + 4 * (lane & 3)) * 2;
#pragma unroll 1
    for (int unit = blockIdx.x; unit < 256; unit += gridDim.x) {
        const int b = unit >> 4, h = (unit >> 1) & 7, rh = unit & 1;
        const int ib = wid & 1, gi = ib ? (3 - rh) : rh, vq = wid >> 1;
        const float lg = log2f(1.f - exp2f(-5.f - (float)h)), cd = exp2f(128.f * lg);
        const size_t bh = (size_t)(b * 8 + h) * 2048;
        f32x16 Racc[4];
#pragma unroll
        for (int db = 0; db < 4; ++db) Racc[db] = (f32x16){};
        const bf16_t* qsrc = QC + (bh + 32 * gi + r32) * 128 + 8 * hi;
        const bf16_t* ksrc = KC + bh * 128 + 8 * tid;
        const bf16_t* vin0 = VT + ((size_t)(h * 8 + 2 * vq) * (MTOK / 16) + (size_t)(b * 128)) * 512 + r32 * 8 + 4 * hi;
        const bf16_t* vup0 = VT + ((size_t)(h * 8 + wid) * (MTOK / 16) + (size_t)(b * 128)) * 512 + (hi * 32 + r32) * 8;
        const int orow = tid >> 3, ogi = (orow >> 5) ? (3 - rh) : rh;
        bf16_t* gp0 = G + ((size_t)b * 2048 + 32 * ogi + (orow & 31)) * 2048 + h * 256 + 8 * (tid & 7);
        u32x4 kst[4]; bf16x8 qf[8];
#pragma unroll
        for (int e = 0; e < 4; ++e) kst[e] = *(const u32x4*)(ksrc + 4096 * e);
#pragma unroll
        for (int s = 0; s < 8; ++s) qf[s] = *(const bf16x8*)(qsrc + 16 * s);
#pragma unroll 1
        for (int c = 0; c < 16; ++c) {
            const int cn = c < 15 ? c + 1 : c;
#pragma unroll
            for (int e = 0; e < 4; ++e) { const int id = tid + 512 * e; *(LAS u32x4*)(KR + (id >> 4) * KT_STRIDE + 16 * (id & 15)) = kst[e]; }
            bf16x8 vupd[8];
#pragma unroll
            for (int s = 0; s < 4; ++s) vupd[s] = *(const bf16x8*)(vup0 + (size_t)(8 * c + s) * 512);
            u32x2 vin[8];
#define C_VIN(dst, jb_) do { const bf16_t* vp_ = vin0 + (size_t)(8 * c + 2 * (jb_)) * 512; const bf16_t* vq_ = vp_ + (size_t)(MTOK / 16) * 512; \
                dst[0] = *(const u32x2*)(vp_); dst[1] = *(const u32x2*)(vp_ + 256); dst[2] = *(const u32x2*)(vp_ + 512); dst[3] = *(const u32x2*)(vp_ + 768); \
                dst[4] = *(const u32x2*)(vq_); dst[5] = *(const u32x2*)(vq_ + 256); dst[6] = *(const u32x2*)(vq_ + 512); dst[7] = *(const u32x2*)(vq_ + 768); } while (0)
            C_VIN(vin, 0);
            __syncthreads();
            f32x16 y0 = {}, y1 = {};
            if (c > 0) {
#pragma unroll
                for (int s = 0; s < 8; ++s) { const bf16x8 a0 = *(const LAS bf16x8*)(RT + (64 * vq + r32) * RT_STRIDE + (16 * s + 8 * hi) * 2), a1 = *(const LAS bf16x8*)(RT + (64 * vq + 32 + r32) * RT_STRIDE + (16 * s + 8 * hi) * 2);
                    y0 = MFMA32(a0, qf[s], y0); y1 = MFMA32(a1, qf[s], y1); }
            }
#pragma unroll 1
            for (int jb = 0; jb <= gi; ++jb) {
                u32x2 vnx[8];
                const int jn = jb < gi ? jb + 1 : jb;
                C_VIN(vnx, jn);
                f32x16 st = {};
#pragma unroll
                for (int s = 0; s < 8; ++s) { const bf16x8 kf = *(const LAS bf16x8*)(KR + (32 * jb + r32) * KT_STRIDE + (16 * s + 8 * hi) * 2); st = MFMA32(kf, qf[s], st); }
                {   const int thi = ((jb == gi) ? r32 : 63) - 4 * hi;
#pragma unroll
                    for (int rr = 0; rr < 16; ++rr) { const int kc = (rr & 3) + 8 * (rr >> 2); st[rr] = (kc <= thi) ? st[rr] : 0.f; } }
                const bf16x8 p0 = pack8(st, 0), p1 = pack8(st, 1);
                y0 = MFMA32(mk8(vin[0], vin[1]), p0, y0); y0 = MFMA32(mk8(vin[2], vin[3]), p1, y0); y1 = MFMA32(mk8(vin[4], vin[5]), p0, y1); y1 = MFMA32(mk8(vin[6], vin[7]), p1, y1);
#pragma unroll
                for (int e = 0; e < 8; ++e) vin[e] = vnx[e];
            }
#undef C_VIN
#pragma unroll
            for (int s = 4; s < 8; ++s) vupd[s] = *(const bf16x8*)(vup0 + (size_t)(8 * c + s) * 512);
#pragma unroll
            for (int s = 0; s < 8; ++s) qf[s] = *(const bf16x8*)(qsrc + (size_t)16384 * cn + 16 * s);
            bf16_t* gp = gp0 + (size_t)262144 * c;
            u32x4 gv[4];
#pragma unroll
            for (int k = 0; k < 4; ++k) gv[k] = *(const u32x4*)(gp + 64 * k);
#pragma unroll
            for (int s = 0; s < 8; ++s) {
#pragma unroll
                for (int db = 0; db < 4; ++db) { const LAS unsigned char* ap = KR + trb + (16 * s) * KT_STRIDE + 64 * db;
                    const bf16x8 af = mk8(lds_tr(ap), lds_tr(ap + 4 * KT_STRIDE)); Racc[db] = MFMA32(af, vupd[s], Racc[db]); } }
#pragma unroll
            for (int db = 0; db < 4; ++db) Racc[db] *= cd;
            float s1 = 0.f, s2 = 0.f;
#pragma unroll
            for (int rr = 0; rr < 16; ++rr) { s1 += y0[rr] + y1[rr]; s2 += y0[rr] * y0[rr] + y1[rr] * y1[rr]; }
            s1 += __shfl_xor(s1, 32); s2 += __shfl_xor(s2, 32);
            __syncthreads();
#pragma unroll
            for (int e = 0; e < 4; ++e) kst[e] = *(const u32x4*)(ksrc + (size_t)16384 * cn + 4096 * e);
#pragma unroll
            for (int db = 0; db < 4; ++db)
#pragma unroll
                for (int q4 = 0; q4 < 4; ++q4) { u32x2 w; w.x = pk2(Racc[db][4 * q4], Racc[db][4 * q4 + 1]); w.y = pk2(Racc[db][4 * q4 + 2], Racc[db][4 * q4 + 3]);
                    *(LAS u32x2*)(RT + (32 * wid + r32) * RT_STRIDE + (32 * db + 8 * q4 + 4 * hi) * 2) = w; }
            if (hi == 0) { ST[((ib * 4 + vq) * 32 + r32) * 2] = s1; ST[((ib * 4 + vq) * 32 + r32) * 2 + 1] = s2; }
            __syncthreads();
            float t1 = 0.f, t2 = 0.f;
#pragma unroll
            for (int q = 0; q < 4; ++q) { t1 += ST[((ib * 4 + q) * 32 + r32) * 2]; t2 += ST[((ib * 4 + q) * 32 + r32) * 2 + 1]; }
            const float mu = t1 * (1.f / 256.f), var = fmaxf(t2 * (1.f / 256.f) - mu * mu, 0.f), rstd = rsqrtf(var + GN_EPS);
#pragma unroll
            for (int vb = 0; vb < 2; ++vb)
#pragma unroll
                for (int q4 = 0; q4 < 4; ++q4) { const f32x16& y = vb ? y1 : y0; u32x2 w; w.x = pk2((y[4 * q4] - mu) * rstd, (y[4 * q4 + 1] - mu) * rstd); w.y = pk2((y[4 * q4 + 2] - mu) * rstd, (y[4 * q4 + 3] - mu) * rstd);
                    *(LAS u32x2*)(YS + (32 * ib + r32) * YS_STRIDE + (64 * vq + 32 * vb + 8 * q4 + 4 * hi) * 2) = w; }
            __syncthreads();
#pragma unroll
            for (int k = 0; k < 4; ++k) { const u32x4 yw = *(const LAS u32x4*)(YS + orow * YS_STRIDE + 16 * ((tid & 7) + 8 * k)); const u32x4 gw = gv[k];
                u32x4 o; o.x = pk2(silu_f(bflo(gw.x)) * bflo(yw.x), silu_f(bfhi(gw.x)) * bfhi(yw.x)); o.y = pk2(silu_f(bflo(gw.y)) * bflo(yw.y), silu_f(bfhi(gw.y)) * bfhi(yw.y));
                o.z = pk2(silu_f(bflo(gw.z)) * bflo(yw.z), silu_f(bfhi(gw.z)) * bfhi(yw.z)); o.w = pk2(silu_f(bflo(gw.w)) * bflo(yw.w), silu_f(bfhi(gw.w)) * bfhi(yw.w));
                *(u32x4*)(gp + 64 * k) = o; }
        }
        __syncthreads();
    }
}

__device__ __forceinline__ void mixD_conv(const bf16_t* U, bf16_t* UC, const float* cw, const float* cb) {
    const int gt = blockIdx.x * 512 + opaque_tid(), NT = gridDim.x * 512;
    for (int idx = gt; idx < (MTOK / 4) * 128; idx += NT) { const int row0 = (idx >> 7) * 4, c0 = (idx & 127) * 8, s0 = row0 & 2047;
        u32x4 uw[7];
#pragma unroll
        for (int k = 0; k < 7; ++k) { uw[k] = (u32x4){0u, 0u, 0u, 0u}; if (s0 - 3 + k >= 0) uw[k] = *(const u32x4*)(U + (size_t)(row0 - 3 + k) * 1024 + c0); }
        float wv[4][8], bv[8];
#pragma unroll
        for (int e = 0; e < 8; ++e) { bv[e] = cb[c0 + e];
#pragma unroll
            for (int w = 0; w < 4; ++w) wv[w][e] = cw[w * 1024 + c0 + e]; }
#pragma unroll
        for (int r = 0; r < 4; ++r) { float acc[8];
#pragma unroll
            for (int e = 0; e < 8; ++e) acc[e] = bv[e];
#pragma unroll
            for (int w = 0; w < 4; ++w) { const u32x4 x = uw[r + w]; const float uv[8] = {bflo(x.x), bfhi(x.x), bflo(x.y), bfhi(x.y), bflo(x.z), bfhi(x.z), bflo(x.w), bfhi(x.w)};
#pragma unroll
                for (int e = 0; e < 8; ++e) acc[e] += wv[w][e] * uv[e]; }
            u32x4 o; o.x = pk2(acc[0], acc[1]); o.y = pk2(acc[2], acc[3]); o.z = pk2(acc[4], acc[5]); o.w = pk2(acc[6], acc[7]);
            *(u32x4*)(UC + (size_t)(row0 + r) * 1024 + c0) = o; }
    }
}
__device__ __forceinline__ void mixD_scan(LAS unsigned char* lds, const bf16_t* LA, const bf16_t* GU, bf16_t* GG) {
    const int tid = opaque_tid(), lane = tid & 63, wid = __builtin_amdgcn_readfirstlane(tid >> 6);
    LAS float* CP = (LAS float*)(lds + LDS_X_OFF); LAS float* CH = CP + 512;
#pragma unroll 1
    for (int unit = blockIdx.x; unit < 256; unit += gridDim.x) {
        const int b = unit >> 4, ch = (unit & 15) * 64 + lane;
        float carry = 0.f;
#pragma unroll 1
        for (int rd = 0; rd < 8; ++rd) {
            const size_t base = ((size_t)b * 2048 + 256 * rd + 32 * wid) * 1024 + ch;
            float a[32], bb[32], gg[32];
#pragma unroll
            for (int s = 0; s < 32; ++s) { a[s] = __uint_as_float((unsigned)LA[base + (size_t)s * 1024] << 16); bb[s] = __uint_as_float((unsigned)GU[base + (size_t)s * 1024] << 16); gg[s] = __uint_as_float((unsigned)GG[base + (size_t)s * 1024] << 16); }
            float P = 1.f, H = 0.f;
#pragma unroll
            for (int s = 0; s < 32; ++s) { const float av = fast_exp2(a[s] * LOG2E); a[s] = av; bb[s] = sqrtf(fmaxf(1.f - av * av, 0.f)) * bb[s]; H = av * H + bb[s]; P *= av; }
            CP[wid * 64 + lane] = P; CH[wid * 64 + lane] = H;
            __syncthreads();
            float h = carry, hin = 0.f;
#pragma unroll
            for (int w = 0; w < 8; ++w) { if (w == wid) hin = h; h = CP[w * 64 + lane] * h + CH[w * 64 + lane]; }
            carry = h;
            h = hin;
#pragma unroll
            for (int s = 0; s < 32; ++s) { h = a[s] * h + bb[s]; GG[base + (size_t)s * 1024] = (bf16_t)(pk2(gg[s] * h, 0.f) & 0xffff); }
            __syncthreads();
        }
    }
}

constexpr int NWAVES = 8;
__device__ __forceinline__ const void* ldptr(int i) {
    const unsigned long long v = ((volatile LAS unsigned long long*)(LDS_BASE() + PT_OFF))[i];
    const unsigned lo = __builtin_amdgcn_readfirstlane((unsigned)v), hi = __builtin_amdgcn_readfirstlane((unsigned)(v >> 32));
    return (const void*)(((unsigned long long)hi << 32) | lo);
}
#define INF(i) ((const float*)ldptr(i))
#define WSP() ((unsigned char*)ldptr(29))
#define XOUT() ((float*)ldptr(28))
#define RSBUF(ws_, par_) ((float*)((ws_) + WS_SS))
#define GSZ ((int)gridDim.x)
#define BX ((int)blockIdx.x)
__device__ __forceinline__ void grid_bar() {
    XcdBarrier b; b.bar = (unsigned*)(WSP() + WS_CTL) + 1024; b.x = xb_xcc_id(); b.st = (volatile LAS unsigned*)(LDS_BASE() + MISC_OFF) + 8;
    xcd_barrier(b);
}
#define GRID_BAR() grid_bar()

__device__ __forceinline__ void phase_prologue() {
    LAS unsigned char* lds = LDS_BASE();
    const int tid = opaque_tid(), lane = tid & 63, wave = __builtin_amdgcn_readfirstlane(tid >> 6);
    const int gw = BX * NWAVES + wave, NGW = GSZ * NWAVES;
    unsigned char* ws = WSP();
    const float* norm_g = INF(2);
    LAS float* scr = (LAS float*)(lds + wave * 16384); int poff = 0;
    {   const float* ffn_w_in = INF(3); const float* ffn_w_out = INF(4);
        for (int lw = 0; lw < 8; ++lw) {
            const float* g = norm_g + (size_t)((lw >> 1) * 3 + ((lw & 1) ? 2 : 0)) * 1024;
            const float* wi = ffn_w_in + (size_t)lw * 1024 * 5632; const float* wo = ffn_w_out + (size_t)lw * 2816 * 1024;
            prep_matrix((bf16_t*)(ws + W_FUP + lw * SZ_FUP), 5632, 1024, [=](int n, int k) { const int p = n & 255, col = (p >> 7) * 2816 + (n >> 8) * 128 + (p & 127); return LD4(wi + (size_t)k * 5632 + col) * g[k]; }, scr, gw, NGW, lane, poff);
            prep_matrix((bf16_t*)(ws + W_FDN + lw * SZ_FDN), 1024, 2816, [=](int n, int k) { return LD4(wo + (size_t)k * 1024 + n); }, scr, gw, NGW, lane, poff);
        } }
    {
        const float* g = norm_g + (size_t)(0 * 3 + 1) * 1024; const float* w = INF(5); const float* wo = INF(8);
        prep_matrix((bf16_t*)(ws + W_AQK), 6144, 1024, [=](int n, int k) { const int pn = n >> 8, p = n & 255, bj = p >> 7, wc = (p >> 5) & 3, dd = p & 31, isk = pn >= 12 ? 1 : 0;
            const int col = isk * 3072 + (((pn - 12 * isk) * 4 + wc) * 64) + dd + 32 * bj; return LD4(w + (size_t)k * 9216 + col) * g[k]; }, scr, gw, NGW, lane, poff);
        prep_matrix((bf16_t*)(ws + W_AV), 3072, 1024, [=](int n, int k) { return LD4(w + (size_t)k * 9216 + 6144 + n) * g[k]; }, scr, gw, NGW, lane, poff);
        prep_matrix((bf16_t*)(ws + W_AO), 1024, 1024, [=](int n, int k) { return LD4(wo + (size_t)k * 1024 + n); }, scr, gw, NGW, lane, poff);
    }
    {
        const float* g = norm_g + (size_t)(1 * 3 + 1) * 1024; const float* w = INF(9); const float* qag = INF(10); const float* wq = INF(11);
        const float* kvg = INF(12); const float* wkv = INF(13); const float* wo = INF(16);
        prep_matrix((bf16_t*)(ws + W_BIN), 768, 1024, [=](int n, int k) { return n < 672 ? LD4(w + (size_t)k * 672 + n) * g[k] : (f32x4){0.f, 0.f, 0.f, 0.f}; }, scr, gw, NGW, lane, poff);
        prep_matrix((bf16_t*)(ws + W_BQ), 1536, 384, [=](int n, int k) { return LD4(wq + (size_t)k * 1536 + n) * qag[k]; }, scr, gw, NGW, lane, poff);
        prep_matrix((bf16_t*)(ws + W_BK), 1024, 256, [=](int n, int k) { const int pn = n >> 8, p = n & 255, bj = p >> 7, wc = (p >> 5) & 3, dd = p & 31;
            return LD4(wkv + (size_t)k * 2048 + (pn * 4 + wc) * 128 + dd + 32 * bj) * kvg[k]; }, scr, gw, NGW, lane, poff);
        prep_matrix((bf16_t*)(ws + W_BV), 1024, 256, [=](int n, int k) { return LD4(wkv + (size_t)k * 2048 + (n >> 6) * 128 + 64 + (n & 63)) * kvg[k]; }, scr, gw, NGW, lane, poff);
        prep_matrix((bf16_t*)(ws + W_BO), 1024, 1024, [=](int n, int k) { return LD4(wo + (size_t)k * 1024 + n); }, scr, gw, NGW, lane, poff);
    }
    {
        const float* g = norm_g + (size_t)(2 * 3 + 1) * 1024; const float* w = INF(17); const float* wo = INF(18);
        prep_matrix((bf16_t*)(ws + W_CIN), 4096, 1024, [=](int n, int k) { const int pn = n >> 8, p = n & 255; int col;
            if (pn >= 8) col = 4096 + (n - 2048);
            else { const int bj = p >> 7, wc = (p >> 5) & 3, dd = p & 31, isk = pn >> 2, hd = (pn & 3) * 2 + (wc >> 1); col = isk * 1024 + hd * 128 + 32 * (wc & 1) + dd + 64 * bj; }
            return LD4(w + (size_t)k * 6144 + col) * g[k]; }, scr, gw, NGW, lane, poff);
        prep_matrix((bf16_t*)(ws + W_CV), 2048, 1024, [=](int n, int k) { return LD4(w + (size_t)k * 6144 + 2048 + n) * g[k]; }, scr, gw, NGW, lane, poff);
        prep_matrix((bf16_t*)(ws + W_CO), 1024, 2048, [=](int n, int k) { return LD4(wo + (size_t)k * 1024 + n); }, scr, gw, NGW, lane, poff);
    }
    {
        const float* g = norm_g + (size_t)(3 * 3 + 1) * 1024; const float* w = INF(19); const float* wrg = INF(22); const float* wig = INF(24); const float* wo = INF(27);
        prep_matrix((bf16_t*)(ws + W_DIN), 2048, 1024, [=](int n, int k) { return LD4(w + (size_t)k * 2048 + n) * g[k]; }, scr, gw, NGW, lane, poff);
        prep_matrix((bf16_t*)(ws + W_DG), 2048, 256, [=](int n, int k) { const int pn = n >> 8, p = n & 255, bj = p >> 7, chn = pn * 128 + (p & 127), blk = chn >> 8, d = chn & 255;
            const float* src = bj ? wig : wrg; return LD4(src + ((size_t)blk * 256 + k) * 256 + d); }, scr, gw, NGW, lane, poff);
        prep_matrix((bf16_t*)(ws + W_DO), 1024, 1024, [=](int n, int k) { return LD4(wo + (size_t)k * 1024 + n); }, scr, gw, NGW, lane, poff);
    }
    {
        const float* x_in = INF(0); bf16_t* XB = (bf16_t*)(ws + WS_XB); float* SS = (float*)(ws + WS_SS);
        for (int m = gw; m < MTOK; m += NGW) { const f32x4* xr = (const f32x4*)(x_in + (size_t)m * DM) + lane; float s = 0.f;
            unsigned long long* o8 = (unsigned long long*)(XB + (size_t)m * DM) + lane;
#pragma unroll
            for (int j = 0; j < 4; ++j) { const f32x4 v = xr[64 * j]; s += (v.x * v.x + v.y * v.y) + (v.z * v.z + v.w * v.w); o8[64 * j] = (unsigned long long)pk2(v.x, v.y) | ((unsigned long long)pk2(v.z, v.w) << 32); }
            s = wave_sum(s);
            if (lane == 0) *(f32x4*)(SS + (size_t)m * 4) = (f32x4){s, 0.f, 0.f, 0.f}; } }
    {
        const float* lamp = INF(26); float* spt = (float*)(ws + WS_SPD);
        for (int i = BX * 512 + tid; i < 1024; i += GSZ * 512) spt[i] = -8.f * log1pf(expf(-lamp[i]));
    }
    {
        const int* positions = (const int*)ldptr(1);
        float* TAc = (float*)(ws + WS_TA); float* TAs = TAc + (size_t)MTOK * 32;
        float* TBc = (float*)(ws + WS_TB); float* TBs = TBc + (size_t)MTOK * 16;
        float* TCc = (float*)(ws + WS_TC); float* TCs = TCc + (size_t)MTOK * 64;
#define FAST_SC(a_, c_, s_) do { const float rv_ = (a_) * 0.15915494309189535f; const float fr_ = rv_ - floorf(rv_); c_ = __builtin_amdgcn_cosf(fr_); s_ = __builtin_amdgcn_sinf(fr_); } while (0)
        for (int idx = BX * 512 + tid; idx < MTOK * 16; idx += GSZ * 512) { const int row = idx >> 4, i = idx & 15; const float pos = (float)positions[row]; float cv, sv;
            const float inv = exp2f(-(float)i * (13.287712379549449f / 16.f)); FAST_SC(pos * inv, cv, sv); TBc[(size_t)row * 16 + i] = cv; TBs[(size_t)row * 16 + i] = sv; } }
#undef FAST_SC
}

#ifndef DIAG
#define DIAG 0
#endif
#define TIMED(mask, ...) do { if (DIAG & (mask)) { const unsigned long long t0_ = __builtin_amdgcn_s_memrealtime(); __VA_ARGS__; const unsigned long long t1_ = __builtin_amdgcn_s_memrealtime(); \
    while (__builtin_amdgcn_s_memrealtime() - t1_ < t1_ - t0_) __builtin_amdgcn_s_sleep(8); } else { __VA_ARGS__; } } while (0)
__device__ __forceinline__ void phase_ffn(int lw, bool from_input, bool last, int par) {
    TIMED(2,
    {   unsigned char* ws = WSP();
        pg8::Prob g = pg8::make_prob(ws + WS_XB, 1024, ws + W_FUP + (size_t)lw * SZ_FUP, 1024, 1024); pg8::StaticOrder SO; SO.init(MTOK / 256, 22, GSZ, BX);
        EpiSwiGLU E{(bf16_t*)(ws + WS_R), RSBUF(ws, par)};
        pg8::gemm_phase<EpiSwiGLU, true, true>(LDS_BASE(), g, SO, E); }
    GRID_BAR(););
    TIMED(32,
    {   unsigned char* ws = WSP(); float* X = XOUT();
        pg8::Prob g = pg8::make_prob(ws + WS_R, DFF, ws + W_FDN + (size_t)lw * SZ_FDN, DFF, DFF); pg8::StaticOrder SO; SO.init(MTOK / 256, 4, GSZ, BX);
        EpiRes E{from_input ? INF(0) : (const float*)nullptr, last ? X : (float*)nullptr, (bf16_t*)(ws + WS_XB), RSBUF(ws, par), 0.5f};
        pg8::gemm_phase<EpiRes, true, true>(LDS_BASE(), g, SO, E); }
    GRID_BAR(););
}
__device__ __forceinline__ void phase_outproj(size_t a_off, int Kdim, size_t w_off, int par) {
    {   unsigned char* ws = WSP();
        pg8::Prob g = pg8::make_prob(ws + a_off, Kdim, ws + w_off, Kdim, Kdim); pg8::StaticOrder SO; SO.init(MTOK / 256, 4, GSZ, BX);
        EpiRes E{(const float*)nullptr, (float*)nullptr, (bf16_t*)(ws + WS_XB), RSBUF(ws, par), 1.0f};
        pg8::gemm_phase<EpiRes, true, true>(LDS_BASE(), g, SO, E); }
    GRID_BAR();
}

#ifndef TS
#define TS 0
#endif
#define SUBOK(n) (TS == 0 || TS == (n))
__device__ __forceinline__ void phase_mixA(int par) {
    for (int half = 0; half < 2; ++half) {
        const int rowbase = half * 16384;
        if (SUBOK(1)) {   unsigned char* ws = WSP();
            pg8::Prob g = pg8::make_prob(ws + WS_XB + (size_t)rowbase * 2048, 1024, ws + W_AQK, 1024, 1024); pg8::StaticOrder SO; SO.init(64, 24, GSZ, BX);
            EpiAQK E{(bf16_t*)(ws + RA_Q), (bf16_t*)(ws + RA_K), RSBUF(ws, par), INF(6), INF(7), (const int*)ldptr(1), rowbase};
            pg8::gemm_phase<EpiAQK, true, true>(LDS_BASE(), g, SO, E); }
        if (SUBOK(2)) for (int gI = 0; gI < 3; ++gI) {
            unsigned char* ws = WSP();
            const int dsh = 2 * gI, dil = 1 << dsh;
            pg8::Prob g = pg8::make_prob(ws + W_AV + (size_t)gI * 1024 * 1024 * 2, 1024, ws + WS_XB + (size_t)rowbase * 2048, dil * 1024, 1024);
            g.mode = 1; g.dsh = dsh; g.hsB = (dsh == 4) ? (long)1024 * 2 : (long)128 * dil * 1024 * 2;
            pg8::StaticOrder SO; SO.init(4, 64, GSZ, BX);
            EpiVT E{(bf16_t*)(ws + RA_V) + (size_t)gI * 1024 * 16384, (size_t)16384, RSBUF(ws, par), 4, 0, 4, 1024.f, 1, dsh, rowbase, 1};
            pg8::gemm_phase<EpiVT, true, true>(LDS_BASE(), g, SO, E);
        }
        GRID_BAR();
        if (SUBOK(3)) {   unsigned char* ws = WSP(); const float* gq = INF(6); const float* gk = INF(7); const int lane = opaque_tid() & 63;
            const float shift = 11.541560327111707f * wave_max(fabsf(gq[lane])) * wave_max(fabsf(gk[lane]));
            mixA_attn(LDS_BASE(), (const bf16_t*)(ws + RA_Q), (const bf16_t*)(ws + RA_K), (const bf16_t*)(ws + RA_V), (bf16_t*)(ws + RA_O), half, shift); }
        GRID_BAR();
    }
    phase_outproj(RA_O, 1024, W_AO, par);
}

__device__ __forceinline__ void phase_mixB(int par) {
    if (SUBOK(1)) {   unsigned char* ws = WSP();
        pg8::Prob g = pg8::make_prob(ws + WS_XB, 1024, ws + W_BIN, 1024, 1024); pg8::StaticOrder SO; SO.init(MTOK / 256, 3, GSZ, BX);
        EpiBIn E{(bf16_t*)(ws + RB_CQ), (bf16_t*)(ws + RB_CKV), (float*)(ws + RB_KR), (float*)(ws + RB_SS), RSBUF(ws, par)};
        pg8::gemm_phase<EpiBIn, true, true>(LDS_BASE(), g, SO, E); }
    GRID_BAR();
    if (SUBOK(2)) {   unsigned char* ws = WSP();
        pg8::Prob g = pg8::make_prob(ws + RB_CQ, 384, ws + W_BQ, 384, 384); pg8::StaticOrder SO; SO.init(MTOK / 256, 6, GSZ, BX);
        EpiRowScale E{(bf16_t*)(ws + RB_QR), 1536, (bf16_t*)(ws + RB_QR), 1536, 1 << 30, (const float*)(ws + RB_SS), 32, 0, 12, 384.f, 0};
        pg8::gemm_phase<EpiRowScale, true, true>(LDS_BASE(), g, SO, E); }
    if (SUBOK(3)) {   unsigned char* ws = WSP();
        pg8::Prob g = pg8::make_prob(ws + RB_CKV, 256, ws + W_BK, 256, 256); pg8::StaticOrder SO; SO.init(MTOK / 256, 4, GSZ, BX);
        EpiBK E{(bf16_t*)(ws + RB_KB), (const float*)(ws + RB_SS), (const float*)(ws + RB_KR), INF(15), (const float*)(ws + WS_TB), (const float*)(ws + WS_TB) + (size_t)MTOK * 16};
        pg8::gemm_phase<EpiBK, true, true>(LDS_BASE(), g, SO, E); }
    if (SUBOK(4)) {   unsigned char* ws = WSP();
        pg8::Prob g = pg8::make_prob(ws + W_BV, 256, ws + RB_CKV, 256, 256); pg8::StaticOrder SO; SO.init(4, MTOK / 256, GSZ, BX);
        EpiVT E{(bf16_t*)(ws + RB_VT), (size_t)MTOK, (const float*)(ws + RB_SS), 32, 12, 8, 256.f, 0, 0, 0, 0};
        pg8::gemm_phase<EpiVT, true, true>(LDS_BASE(), g, SO, E); }
    GRID_BAR();
    if (SUBOK(5)) {   unsigned char* ws = WSP(); const float* gq = INF(14); const float* gk = INF(15); const int lane = opaque_tid() & 63;
        const float mq = wave_max(fmaxf(fabsf(gq[lane]), fabsf(gq[64 + (lane & 31)]))), mk = wave_max(fmaxf(fabsf(gk[lane]), fabsf(gk[64 + (lane & 31)])));
        const float shift = 14.134834215227234f * mq * mk;
        mixB_attn(LDS_BASE(), (const bf16_t*)(ws + RB_QR), (const bf16_t*)(ws + RB_KB), (const bf16_t*)(ws + RB_VT), (bf16_t*)(ws + RB_O), gq, (const float*)(ws + WS_TB), (const float*)(ws + WS_TB) + (size_t)MTOK * 16, shift); }
    GRID_BAR();
    phase_outproj(RB_O, 1024, W_BO, par);
}

__device__ __forceinline__ void phase_mixC(int par) {
    if (SUBOK(1)) {   unsigned char* ws = WSP();
        pg8::Prob g = pg8::make_prob(ws + WS_XB, 1024, ws + W_CIN, 1024, 1024); pg8::StaticOrder SO; SO.init(MTOK / 256, 16, GSZ, BX);
        EpiCIn E{(bf16_t*)(ws + RC_Q), (bf16_t*)(ws + RC_K), (bf16_t*)(ws + RC_G), RSBUF(ws, par), (const int*)ldptr(1)};
        pg8::gemm_phase<EpiCIn, true, true>(LDS_BASE(), g, SO, E); }
    if (SUBOK(2)) {   unsigned char* ws = WSP();
        pg8::Prob g = pg8::make_prob(ws + W_CV, 1024, ws + WS_XB, 1024, 1024); pg8::StaticOrder SO; SO.init(8, MTOK / 256, GSZ, BX);
        EpiVT E{(bf16_t*)(ws + RC_VT), (size_t)MTOK, RSBUF(ws, par), 4, 0, 4, 1024.f, 0, 0, 0, 1};
        pg8::gemm_phase<EpiVT, true, true>(LDS_BASE(), g, SO, E); }
    GRID_BAR();
    if (SUBOK(3)) {   unsigned char* ws = WSP();
        mixC_retention(LDS_BASE(), (const bf16_t*)(ws + RC_Q), (const bf16_t*)(ws + RC_K), (const bf16_t*)(ws + RC_VT), (bf16_t*)(ws + RC_G)); }
    GRID_BAR();
    phase_outproj(RC_G, 2048, W_CO, par);
}

__device__ __forceinline__ void phase_mixD(int par) {
    {   unsigned char* ws = WSP();
        pg8::Prob g = pg8::make_prob(ws + WS_XB, 1024, ws + W_DIN, 1024, 1024); pg8::StaticOrder SO; SO.init(MTOK / 256, 8, GSZ, BX);
        EpiRowScale E{(bf16_t*)(ws + RD_GG), 1024, (bf16_t*)(ws + RD_U), 1024, 1024, RSBUF(ws, par), 4, 0, 4, 1024.f, 1};
        pg8::gemm_phase<EpiRowScale, true, true>(LDS_BASE(), g, SO, E); }
    GRID_BAR();
    {   unsigned char* ws = WSP(); mixD_conv((const bf16_t*)(ws + RD_U), (bf16_t*)(ws + RD_UC), INF(20), INF(21)); }
    GRID_BAR();
    {   unsigned char* ws = WSP();
        pg8::Prob g = pg8::make_prob(ws + RD_UC, 1024, ws + W_DG, 256, 256); g.mode = 2; pg8::StaticOrder SO; SO.init(MTOK / 256, 8, GSZ, BX);
        EpiDGate E{(bf16_t*)(ws + RD_LA), (bf16_t*)(ws + RD_GU), (const bf16_t*)(ws + RD_UC), INF(23), INF(25), (const float*)(ws + WS_SPD)};
        pg8::gemm_phase<EpiDGate, true, true>(LDS_BASE(), g, SO, E); }
    GRID_BAR();
    {   unsigned char* ws = WSP(); mixD_scan(LDS_BASE(), (const bf16_t*)(ws + RD_LA), (const bf16_t*)(ws + RD_GU), (bf16_t*)(ws + RD_GG)); }
    GRID_BAR();
    phase_outproj(RD_GG, 1024, W_DO, par);
}

__global__ void __launch_bounds__(NWAVES * 64, 2) fwd_kernel(Args args) {
    {
        LAS unsigned char* lds = LDS_BASE();
        const int tid = threadIdx.x;
        for (int u = tid; u < (LDS_BYTES - MISC_OFF) / 4; u += NWAVES * 64) ((LAS unsigned*)(lds + MISC_OFF))[u] = 0u;
        __syncthreads();
        const unsigned long long* ka = (const unsigned long long*)__builtin_amdgcn_kernarg_segment_ptr();
        if (tid < 30) ((LAS unsigned long long*)(lds + PT_OFF))[tid] = ka[tid];
        __syncthreads();
        (void)xcd_barrier_post((unsigned*)(WSP() + WS_CTL) + 1024, (volatile LAS unsigned*)(lds + MISC_OFF) + 8);
    }
#ifndef TP
#define TP 0
#endif
    if (TP == 0 || TP == 1) { TIMED(1, phase_prologue(); GRID_BAR();); }
    if (TP == 0 || TP == 2) phase_ffn(0, true, false, 0);
    if (TP == 0 || TP == 3) { TIMED(4, phase_mixA(1);); }
    if (TP == 0) { phase_ffn(1, false, false, 0); phase_ffn(2, false, false, 1); }
    if (TP == 0 || TP == 4) { TIMED(8, phase_mixB(0);); }
    if (TP == 0) { phase_ffn(3, false, false, 1); phase_ffn(4, false, false, 0); }
    if (TP == 0 || TP == 5) { TIMED(16, phase_mixC(1);); }
    if (TP == 0) { phase_ffn(5, false, false, 0); phase_ffn(6, false, false, 1); }
    if (TP == 0 || TP == 6) { TIMED(64, phase_mixD(0);); }
    if (TP == 0) phase_ffn(7, false, true, 1);
}

extern "C" void kernel_launch(void* const* d_in, const int* in_sizes, int n_in, void* d_out, int out_size, void* d_ws, size_t ws_size, hipStream_t stream) {
    static int grid = 0;
    if (grid == 0) {
        if (n_in != 28 || out_size != MTOK * DM || ws_size < WS_NEED) { fprintf(stderr, "kernel_launch: unexpected shapes: n_in %d out %d ws %zu (need %zu)\n", n_in, out_size, ws_size, (size_t)WS_NEED); grid = -1; return; }
        int dev = 0, cus = 0, per_cu = 0;
        if (hipGetDevice(&dev) != hipSuccess || hipDeviceGetAttribute(&cus, hipDeviceAttributeMultiprocessorCount, dev) != hipSuccess) { grid = -1; return; }
        if (hipFuncSetAttribute((const void*)fwd_kernel, hipFuncAttributeMaxDynamicSharedMemorySize, LDS_BYTES) != hipSuccess) { fprintf(stderr, "kernel_launch: hipFuncSetAttribute failed\n"); grid = -1; return; }
        if (hipOccupancyMaxActiveBlocksPerMultiprocessor(&per_cu, (const void*)fwd_kernel, NWAVES * 64, LDS_BYTES) != hipSuccess || per_cu < 1) fprintf(stderr, "kernel_launch: occupancy query says %d\n", per_cu);
        (void)hipGetLastError();
        grid = cus;
    }
    if (grid < 0) return;
    (void)hipMemsetAsync((char*)d_ws + WS_CTL, 0, CTL_ZERO_BYTES, stream);
    Args a{};
    for (int i = 0; i < 28; ++i) a.in[i] = d_in[i];
    a.out = (float*)d_out; a.ws = (unsigned char*)d_ws;
    hipLaunchKernelGGL(fwd_kernel, dim3(grid), dim3(NWAVES * 64), LDS_BYTES, stream, a);
    const hipError_t le = hipPeekAtLastError();
    if (le != hipSuccess) fprintf(stderr, "kernel_launch: launch failed: %s\n", hipGetErrorName(le));
}
```

```cpp
#include <hip/hip_runtime.h>
#include <cstdio>
#include <cstdint>
#include <cmath>

#define LAS __attribute__((address_space(3)))
#define GAS __attribute__((address_space(1)))
typedef unsigned short bf16_t;
typedef short bf16x8 __attribute__((ext_vector_type(8)));
typedef float f32x4 __attribute__((ext_vector_type(4)));
typedef float f32x16 __attribute__((ext_vector_type(16)));
typedef unsigned u32x4 __attribute__((ext_vector_type(4)));
typedef unsigned u32x2 __attribute__((ext_vector_type(2)));
typedef float f32x2_t __attribute__((ext_vector_type(2)));
typedef __bf16 bf16x2_t __attribute__((ext_vector_type(2)));

constexpr int DM = 1024, NB = 16, SEQ = 2048, MTOK = NB * SEQ, DFF = 2816;
constexpr float NORM_EPS = 1e-6f, GN_EPS = 1e-5f;
constexpr float LOG2E = 1.4426950408889634f;

__device__ __forceinline__ unsigned pk2(float lo, float hi) { f32x2_t v = {lo, hi}; bf16x2_t b = __builtin_convertvector(v, bf16x2_t); return __builtin_bit_cast(unsigned, b); }
__device__ __forceinline__ float bflo(unsigned w) { return __uint_as_float(w << 16); }
__device__ __forceinline__ float bfhi(unsigned w) { return __uint_as_float(w & 0xffff0000u); }
__device__ __forceinline__ float fast_exp2(float x) { return __builtin_amdgcn_exp2f(x); }
__device__ __forceinline__ float fast_rcp(float x) { return __builtin_amdgcn_rcpf(x); }
__device__ __forceinline__ float silu_f(float g) { return g * fast_rcp(1.f + fast_exp2(-g * LOG2E)); }
__device__ __forceinline__ float sigmoid_f(float g) { return fast_rcp(1.f + fast_exp2(-g * LOG2E)); }
__device__ __forceinline__ float gelu_tanh_f(float x) {
    const float z = 0.7978845608028654f * (x + 0.044715f * x * x * x);
    const float e = fast_exp2(2.f * LOG2E * z);
    return x * (1.f - fast_rcp(1.f + e));
}
__device__ __forceinline__ float wave_sum(float v) {
#pragma unroll
    for (int o = 1; o < 64; o <<= 1) v += __shfl_xor(v, o);
    return v;
}
__device__ __forceinline__ float wave_max(float v) {
#pragma unroll
    for (int o = 1; o < 64; o <<= 1) v = fmaxf(v, __shfl_xor(v, o));
    return v;
}
__device__ __forceinline__ int opaque_tid() { int t = threadIdx.x; asm volatile("" : "+v"(t)); return t; }
__device__ __forceinline__ void lds_barrier() { asm volatile("s_waitcnt lgkmcnt(0)\n\ts_barrier" ::: "memory"); }
__device__ __forceinline__ int crow(int r, int hi) { return (r & 3) + 8 * (r >> 2) + 4 * hi; }

namespace pg8 {
constexpr int BM = 256, BK = 64, HALF = 128, HTB = HALF * BK * 2, STAGE_BYTES = 8 * HTB, NXCD = 8, WGM = 8;
__host__ __device__ __forceinline__ int lds_byte(int r, int c) { const int st = (r >> 4) * 2 + (c >> 5), rr = r & 15, cc = c & 31, ob = rr * 64 + cc * 2; return st * 1024 + (ob ^ (((ob >> 9) & 1) << 5)); }
__host__ __device__ __forceinline__ void stage_rc(int b, int& R, int& C) { const int st = b / 1024, sb = b % 1024, swz = sb ^ (((sb >> 9) & 1) << 5); R = (st >> 1) * 16 + swz / 64; C = (st & 1) * 32 + (swz % 64) / 2; }
__host__ __device__ __forceinline__ int perm32(int rho) { const int n = rho >> 4, i = rho & 15; return 8 * (i >> 2) + 4 * n + (i & 3); }
struct Unit { int pm, pn; };
struct StaticOrder {
    int nM, nN, nwg, G, c;
    __device__ void init(int nM_, int nN_, int G_, int c_) { nM = nM_; nN = nN_; nwg = nM * nN; G = G_; c = c_; }
    __device__ bool next(int i, Unit& u) const {
        const long L = (long)i * G + c; if (L >= nwg) return false;
        int wgid = (int)L; { const int q = nwg / NXCD, r = nwg % NXCD, xcd = wgid % NXCD, off = wgid / NXCD; wgid = (xcd < r ? xcd * (q + 1) : r * (q + 1) + (xcd - r) * q) + off; }
        const int nig = WGM * nN, gid = wgid / nig, fm = gid * WGM, gsz = (nM - fm) < WGM ? (nM - fm) : WGM;
        u.pm = fm + ((wgid % nig) % gsz); u.pn = (wgid % nig) / gsz; return true;
    }
};
struct Prob {
    const char* A; const char* B; int K, lda, ldb; long hsA, hsB, tsA, tsB; int mode, dsh;
    __device__ __forceinline__ const char* a_ptr(const Unit& u) const { const char* p = A + (long)u.pm * tsA; if (mode == 2) p += (long)(u.pn >> 1) * 512; return p; }
    __device__ __forceinline__ const char* b_ptr(const Unit& u) const {
        if (mode == 1) { const int b = u.pn >> 3, tt = u.pn & 7; int tok0;
            if (dsh == 0) tok0 = 256 * tt; else if (dsh == 2) tok0 = 4 * ((tt & 1) * 256) + (tt >> 1); else tok0 = 2 * tt;
            return B + ((long)b * SEQ + tok0) * (DM * 2); }
        return B + (long)u.pn * tsB; }
};
__device__ __forceinline__ Prob make_prob(const void* A, int lda, const void* B, int ldb, int K) {
    Prob p; p.A = (const char*)A; p.B = (const char*)B; p.K = K; p.lda = lda; p.ldb = ldb; p.hsA = (long)HALF * lda * 2; p.hsB = (long)HALF * ldb * 2; p.tsA = 2 * p.hsA; p.tsB = 2 * p.hsB; p.mode = 0; p.dsh = 0; return p;
}

template <class Epi, bool ALIGN_EPI, bool SP2>
__device__ __forceinline__ void gemm_phase(LAS unsigned char* lds, const Prob g, const StaticOrder& S, const Epi& E) {
    const int tid = opaque_tid(), wid = __builtin_amdgcn_readfirstlane(tid >> 6), lane = tid & 63, wr = wid >> 2, wc = wid & 3, fr = lane & 15, fq = lane >> 4;
    const int K = g.K, nt = K / BK;
    unsigned voffA[2], voffB[2];
#pragma unroll
    for (int i = 0; i < 2; ++i) { int R, C; stage_rc(tid * 16 + i * 8192, R, C); const int Rb = Epi::PERM ? ((R & ~31) + perm32(R & 31)) : R;
        voffA[i] = (unsigned)(R * g.lda + C) * 2u; voffB[i] = (unsigned)(Rb * g.ldb + C) * 2u; }
    const size_t kstep = (size_t)(BK * 2);
    const long hsA = g.hsA, hsB = g.hsB;
    const unsigned ldsw = (unsigned)wid * 1024u;
    const int aoff = lds_byte(wr * 64 + fr, fq * 8), boff = lds_byte(wc * 32 + fr, fq * 8);
#define PG8_SA(b, h) (((b) * 2 + (h)) * HTB)
#define PG8_SB(b, h) ((4 + (b) * 2 + (h)) * HTB)
#define PG8_STAGE(bufoff, gbase, voff) do { _Pragma("unroll") for (int _i = 0; _i < 2; ++_i) \
        __builtin_amdgcn_global_load_lds((const unsigned*)((const char*)(gbase) + (voff)[_i]), (LAS unsigned*)(lds + (bufoff) + ldsw + _i * 8192), 16, 0, 0); } while (0)
#define PG8_LDA(dst, b, h) do { _Pragma("unroll") for (int m = 0; m < 4; ++m) _Pragma("unroll") for (int k = 0; k < 2; ++k) dst[m][k] = *(const LAS bf16x8*)(lds + PG8_SA(b, h) + aoff + m * 2048 + k * 1024); } while (0)
#define PG8_LDB(dst, b, h) do { _Pragma("unroll") for (int n = 0; n < 2; ++n) _Pragma("unroll") for (int k = 0; k < 2; ++k) dst[n][k] = *(const LAS bf16x8*)(lds + PG8_SB(b, h) + boff + n * 2048 + k * 1024); } while (0)
#define PG8_MMA(ai, bj, At, Bt) do { __builtin_amdgcn_s_setprio(1); _Pragma("unroll") for (int m = 0; m < 4; ++m) _Pragma("unroll") for (int n = 0; n < 2; ++n) _Pragma("unroll") for (int k = 0; k < 2; ++k) \
        acc[ai][bj][m][n] = __builtin_amdgcn_mfma_f32_16x16x32_bf16(Bt[n][k], At[m][k], acc[ai][bj][m][n], 0, 0, 0); __builtin_amdgcn_s_setprio(0); } while (0)
#define PG8_WAIT_V(n) asm volatile("s_waitcnt vmcnt(" #n ")" ::: "memory")
#define PG8_WAIT_L(n) asm volatile("s_waitcnt lgkmcnt(" #n ")" ::: "memory")
#define PG8_BAR __builtin_amdgcn_s_barrier()
#define PG8_SCHED __builtin_amdgcn_sched_barrier(0)
    Unit cur, nxt; int ui = 0;
    if (!S.next(0, cur)) return;
    f32x4 acc[2][2][4][2];
#pragma unroll
    for (int a = 0; a < 2; ++a)
#pragma unroll
        for (int b = 0; b < 2; ++b)
#pragma unroll
            for (int m = 0; m < 4; ++m)
#pragma unroll
                for (int n = 0; n < 2; ++n) acc[a][b][m][n] = (f32x4){0.f, 0.f, 0.f, 0.f};
    bf16x8 At[4][2], B0[2][2], B1[2][2];
    const char* cA = g.a_ptr(cur); const char* cB = g.b_ptr(cur);
    if constexpr (SP2) {
        PG8_STAGE(PG8_SB(0, 0), cB, voffB); PG8_STAGE(PG8_SB(0, 1), cB + hsB, voffB); PG8_STAGE(PG8_SA(0, 0), cA, voffA); PG8_STAGE(PG8_SA(0, 1), cA + hsA, voffA);
        if (wr == 1) PG8_BAR;
        PG8_WAIT_V(2); PG8_BAR;
        PG8_STAGE(PG8_SB(1, 0), cB + kstep, voffB); PG8_STAGE(PG8_SA(1, 0), cA + kstep, voffA); PG8_STAGE(PG8_SB(1, 1), cB + hsB + kstep, voffB);
        PG8_WAIT_V(6); PG8_BAR;
    } else {
        PG8_STAGE(PG8_SB(0, 0), cB, voffB); PG8_STAGE(PG8_SA(0, 0), cA, voffA); PG8_STAGE(PG8_SB(0, 1), cB + hsB, voffB); PG8_STAGE(PG8_SA(0, 1), cA + hsA, voffA);
        if (wr == 1) PG8_BAR;
        PG8_WAIT_V(4); PG8_BAR;
        PG8_STAGE(PG8_SB(1, 0), cB + kstep, voffB); PG8_STAGE(PG8_SA(1, 0), cA + kstep, voffA); PG8_STAGE(PG8_SB(1, 1), cB + hsB + kstep, voffB);
        PG8_WAIT_V(6); PG8_BAR;
    }
    for (;;) {
        const bool has_next = S.next(ui + 1, nxt);
        const char* nA = has_next ? g.a_ptr(nxt) : cA; const char* nB = has_next ? g.b_ptr(nxt) : cB;
        for (int t = 0; t < nt; t += 2) {
            const bool last = (t == nt - 2);
            const char* a1 = cA + (size_t)(t + 1) * kstep;
            const char* a2 = last ? nA : cA + (size_t)(t + 2) * kstep; const char* b2 = last ? nB : cB + (size_t)(t + 2) * kstep;
            const char* a3 = a2 + kstep; const char* b3 = b2 + kstep;
            if constexpr (SP2) {
            PG8_LDB(B0, 0, 0); PG8_LDB(B1, 0, 1); PG8_SCHED; PG8_LDA(At, 0, 0); PG8_STAGE(PG8_SA(1, 1), a1 + hsA, voffA);
            PG8_WAIT_V(8); PG8_WAIT_L(0); PG8_BAR; PG8_MMA(0, 0, At, B0); PG8_MMA(0, 1, At, B1); PG8_BAR; PG8_SCHED;
            PG8_LDA(At, 0, 1); PG8_STAGE(PG8_SB(0, 0), b2, voffB); PG8_STAGE(PG8_SB(0, 1), b2 + hsB, voffB); PG8_STAGE(PG8_SA(0, 0), a2, voffA);
            PG8_WAIT_V(8); PG8_WAIT_L(0); PG8_BAR; PG8_MMA(1, 0, At, B0); PG8_MMA(1, 1, At, B1); PG8_BAR; PG8_SCHED;
            PG8_LDB(B0, 1, 0); PG8_LDB(B1, 1, 1); PG8_SCHED; PG8_LDA(At, 1, 0); PG8_STAGE(PG8_SA(0, 1), a2 + hsA, voffA);
            PG8_WAIT_V(8); PG8_WAIT_L(0); PG8_BAR; PG8_MMA(0, 0, At, B0); PG8_MMA(0, 1, At, B1); PG8_BAR; PG8_SCHED;
            PG8_LDA(At, 1, 1); PG8_STAGE(PG8_SB(1, 0), b3, voffB); PG8_STAGE(PG8_SB(1, 1), b3 + hsB, voffB); PG8_STAGE(PG8_SA(1, 0), a3, voffA);
            PG8_WAIT_V(8); PG8_WAIT_L(0); PG8_BAR; PG8_MMA(1, 0, At, B0); PG8_MMA(1, 1, At, B1); PG8_BAR; PG8_SCHED;
            } else {
            PG8_LDB(B0, 0, 0); PG8_SCHED; PG8_LDA(At, 0, 0); PG8_STAGE(PG8_SA(1, 1), a1 + hsA, voffA);
            PG8_WAIT_L(8); PG8_BAR; PG8_WAIT_L(0); PG8_MMA(0, 0, At, B0); PG8_BAR; PG8_SCHED;
            PG8_LDB(B1, 0, 1); PG8_STAGE(PG8_SB(0, 0), b2, voffB);
            PG8_BAR; PG8_WAIT_L(0); PG8_MMA(0, 1, At, B1); PG8_BAR;
            PG8_LDA(At, 0, 1); PG8_STAGE(PG8_SA(0, 0), a2, voffA);
            PG8_BAR; PG8_WAIT_L(0); PG8_MMA(1, 0, At, B0); PG8_BAR; PG8_SCHED;
            PG8_STAGE(PG8_SB(0, 1), b2 + hsB, voffB);
            PG8_WAIT_V(6); PG8_BAR; PG8_MMA(1, 1, At, B1); PG8_BAR;
            PG8_LDB(B0, 1, 0); PG8_SCHED; PG8_LDA(At, 1, 0); PG8_STAGE(PG8_SA(0, 1), a2 + hsA, voffA);
            PG8_WAIT_L(8); PG8_BAR; PG8_WAIT_L(0); PG8_MMA(0, 0, At, B0); PG8_BAR; PG8_SCHED;
            PG8_LDB(B1, 1, 1); PG8_STAGE(PG8_SB(1, 0), b3, voffB);
            PG8_BAR; PG8_WAIT_L(0); PG8_MMA(0, 1, At, B1); PG8_BAR;
            PG8_LDA(At, 1, 1); PG8_STAGE(PG8_SA(1, 0), a3, voffA);
            PG8_BAR; PG8_WAIT_L(0); PG8_MMA(1, 0, At, B0); PG8_BAR; PG8_SCHED;
            PG8_STAGE(PG8_SB(1, 1), b3 + hsB, voffB);
            PG8_WAIT_V(6); PG8_BAR; PG8_MMA(1, 1, At, B1); PG8_BAR;
            }
        }
        if constexpr (ALIGN_EPI) { if (wr == 0) PG8_BAR; }
        E(acc, cur, wr, wc, fr, fq);
        if (!has_next) break;
#pragma unroll
        for (int a = 0; a < 2; ++a)
#pragma unroll
            for (int b = 0; b < 2; ++b)
#pragma unroll
                for (int m = 0; m < 4; ++m)
#pragma unroll
                    for (int n = 0; n < 2; ++n) acc[a][b][m][n] = (f32x4){0.f, 0.f, 0.f, 0.f};
        cur = nxt; cA = nA; cB = nB; ++ui;
        if constexpr (ALIGN_EPI) { if (wr == 1) PG8_BAR; }
    }
    PG8_WAIT_V(0);
    if constexpr (!ALIGN_EPI) { if (wr == 0) PG8_BAR; }
    PG8_BAR;
#undef PG8_SA
#undef PG8_SB
#undef PG8_STAGE
#undef PG8_LDA
#undef PG8_LDB
#undef PG8_MMA
#undef PG8_WAIT_V
#undef PG8_WAIT_L
#undef PG8_BAR
#undef PG8_SCHED
}
}
typedef f32x4 AccT[2][2][4][2];

#define XB_TMO      128
#define XB_XCNT(j)  (256  + 64 * (j))
#define XB_XSUB(j)  (1280 + 64 * (j))
#define XB_XGEN(j)  (2304 + 64 * (j))
#define XB_TOP      3328
#define XB_TOPGEN   3392
#define XCD_BAR_WORDS 3456
#define XB_SPIN_CAP (1u << 18)
__device__ __forceinline__ unsigned xb_ld(unsigned* p)              { return __hip_atomic_load(p, __ATOMIC_RELAXED, __HIP_MEMORY_SCOPE_AGENT); }
__device__ __forceinline__ unsigned xb_add(unsigned* p, unsigned v) { return __hip_atomic_fetch_add(p, v, __ATOMIC_RELAXED, __HIP_MEMORY_SCOPE_AGENT); }
__device__ __forceinline__ unsigned xb_xcc_id() { return (unsigned)__builtin_amdgcn_s_getreg((3 << 11) | 20) & 0xFu; }
#define XB_SPIN(cond, bar) do { unsigned _sp = 0; while (cond) { __builtin_amdgcn_s_sleep(1); \
    if ((++_sp & 255u) == 0u) { if (xb_ld(&(bar)[XB_TMO])) break; if (_sp > XB_SPIN_CAP) { atomicAdd(&(bar)[XB_TMO], 1u); break; } } } } while (0)
struct XcdBarrier { unsigned* bar; unsigned x; volatile LAS unsigned* st; };
__device__ __forceinline__ XcdBarrier xcd_barrier_post(unsigned* bar, volatile LAS unsigned* st) {
    XcdBarrier b; b.bar = bar; b.x = xb_xcc_id(); b.st = st;
    if (threadIdx.x == 0) (void)xb_add(&bar[XB_XCNT(b.x)], 1u);
    return b;
}
__device__ __forceinline__ void xcd_barrier_complete(unsigned* bar, unsigned x, unsigned& nloc, unsigned& nx) {
    const unsigned G = gridDim.x * gridDim.y * gridDim.z;
    unsigned sum, cnt, mine, sp = 0u;
    for (;;) {
        sum = 0u; cnt = 0u; mine = 0u;
#pragma unroll
        for (unsigned j = 0; j < 16; ++j) { const unsigned c = xb_ld(&bar[XB_XCNT(j)]); sum += c; cnt += (c > 0u) ? 1u : 0u; mine = (j == x) ? c : mine; }
        if (sum == G) break;
        __builtin_amdgcn_s_sleep(1);
        if ((++sp & 255u) == 0u) { if (xb_ld(&bar[XB_TMO])) break; if (sp > XB_SPIN_CAP) { atomicAdd(&bar[XB_TMO], 1u); break; } }
    }
    nloc = mine > 0u ? mine : 1u; nx = cnt > 0u ? cnt : 1u;
}
__device__ __forceinline__ void xcd_barrier(const XcdBarrier& b) {
    asm volatile("s_waitcnt vmcnt(0)" ::: "memory");
    __syncthreads();
    if (threadIdx.x == 0) {
        unsigned* bar = b.bar;
        __builtin_amdgcn_s_waitcnt(0);
        unsigned nloc = b.st[0], nx = b.st[1];
        if (nloc == 0u) { xcd_barrier_complete(bar, b.x, nloc, nx); b.st[0] = nloc; b.st[1] = nx; }
        const unsigned old = xb_add(&bar[XB_XSUB(b.x)], 1u);
        const unsigned gen = old / nloc;
        if (old + 1u == (gen + 1u) * nloc) {
            __builtin_amdgcn_fence(__ATOMIC_RELEASE, "agent");
            asm volatile("s_waitcnt vmcnt(0)" ::: "memory");
            const unsigned og = xb_add(&bar[XB_TOP], 1u);
            const unsigned tg = og / nx;
            if (og + 1u == (tg + 1u) * nx) xb_add(&bar[XB_TOPGEN], 1u);
            else XB_SPIN(xb_ld(&bar[XB_TOPGEN]) == tg, bar);
            __builtin_amdgcn_fence(__ATOMIC_ACQUIRE, "agent");
            xb_add(&bar[XB_XGEN(b.x)], 1u);
            asm volatile("s_waitcnt vmcnt(0)" ::: "memory");
        } else {
            XB_SPIN(xb_ld(&bar[XB_XGEN(b.x)]) == gen, bar);
            __builtin_amdgcn_fence(__ATOMIC_ACQUIRE, "agent");
            asm volatile("s_waitcnt vmcnt(0)" ::: "memory");
        }
    }
    __syncthreads();
}

constexpr size_t MiB = 1u << 20;
constexpr size_t WS_CTL = 0, CTL_ZERO_BYTES = 64 * 1024, WS_SPD = 128 * 1024;
constexpr size_t SZ_FUP = (size_t)5632 * 1024 * 2, SZ_FDN = (size_t)1024 * 2816 * 2;
constexpr size_t WS_W = 1 * MiB;
constexpr size_t W_FUP = WS_W;
constexpr size_t W_FDN = W_FUP + 8 * SZ_FUP;
constexpr size_t W_AQK = W_FDN + 8 * SZ_FDN;
constexpr size_t W_AV  = W_AQK + (size_t)6144 * 1024 * 2;
constexpr size_t W_AO  = W_AV + (size_t)3072 * 1024 * 2;
constexpr size_t W_BIN = W_AO + (size_t)1024 * 1024 * 2;
constexpr size_t W_BQ  = W_BIN + (size_t)768 * 1024 * 2;
constexpr size_t W_BK  = W_BQ + (size_t)1536 * 384 * 2;
constexpr size_t W_BV  = W_BK + (size_t)1024 * 256 * 2;
constexpr size_t W_BO  = W_BV + (size_t)1024 * 256 * 2;
constexpr size_t W_CIN = W_BO + (size_t)1024 * 1024 * 2;
constexpr size_t W_CV  = W_CIN + (size_t)4096 * 1024 * 2;
constexpr size_t W_CO  = W_CV + (size_t)2048 * 1024 * 2;
constexpr size_t W_DIN = W_CO + (size_t)1024 * 2048 * 2;
constexpr size_t W_DG  = W_DIN + (size_t)2048 * 1024 * 2;
constexpr size_t W_DO  = W_DG + (size_t)2048 * 256 * 2;
constexpr size_t W_END = W_DO + (size_t)1024 * 1024 * 2;
constexpr size_t WS_XB = ((W_END + MiB - 1) / MiB) * MiB;
constexpr size_t WS_SS = WS_XB + (size_t)MTOK * DM * 2;
constexpr size_t WS_TA = WS_SS + (size_t)MTOK * 16 * 4;
constexpr size_t WS_TB = WS_TA + (size_t)MTOK * 32 * 4 * 2;
constexpr size_t WS_TC = WS_TB + (size_t)MTOK * 16 * 4 * 2;
constexpr size_t WS_R  = WS_TC + (size_t)MTOK * 64 * 4 * 2;
constexpr size_t SZ_AH = (size_t)3 * 8 * 16 * 2048 * 64 * 2;
constexpr size_t RA_Q = WS_R, RA_K = RA_Q + SZ_AH, RA_V = RA_K + SZ_AH, RA_O = RA_V + SZ_AH, RA_END = RA_O + (size_t)MTOK * DM * 2;
constexpr size_t RB_CQ = WS_R, RB_CKV = RB_CQ + (size_t)MTOK * 384 * 2, RB_KR = RB_CKV + (size_t)MTOK * 256 * 2, RB_SS = RB_KR + (size_t)MTOK * 32 * 4,
                 RB_QR = RB_SS + (size_t)MTOK * 32 * 4, RB_KB = RB_QR + (size_t)MTOK * 1536 * 2, RB_VT = RB_KB + (size_t)MTOK * 1536 * 2, RB_O = RB_VT + (size_t)MTOK * 1024 * 2, RB_END = RB_O + (size_t)MTOK * 1024 * 2;
constexpr size_t RC_Q = WS_R, RC_K = RC_Q + (size_t)MTOK * 1024 * 2, RC_G = RC_K + (size_t)MTOK * 1024 * 2, RC_VT = RC_G + (size_t)MTOK * 2048 * 2, RC_END = RC_VT + (size_t)MTOK * 2048 * 2;
constexpr size_t RD_GG = WS_R, RD_U = RD_GG + (size_t)MTOK * 1024 * 2, RD_UC = RD_U + (size_t)MTOK * 1024 * 2, RD_LA = RD_UC + (size_t)MTOK * 1024 * 2, RD_GU = RD_LA + (size_t)MTOK * 1024 * 4, RD_END = RD_GU + (size_t)MTOK * 1024 * 2;
constexpr size_t WS_NEED = RC_END > RA_END ? (RC_END > RB_END ? RC_END : RB_END) : (RA_END > RB_END ? RA_END : RB_END);
static_assert(RD_END <= WS_NEED && WS_R + (size_t)MTOK * DFF * 2 <= WS_NEED, "ws map");
static_assert(WS_NEED <= (size_t)738197504, "workspace must fit 4x the largest input");

constexpr int RING_BYTES = 131072, LDS_X_OFF = RING_BYTES, LDS_X_BYTES = 8192, MISC_OFF = LDS_X_OFF + LDS_X_BYTES, PT_OFF = MISC_OFF + 256, LDS_BYTES = 147456;

struct Args { const void* in[28]; float* out; unsigned char* ws; };

extern __shared__ __attribute__((aligned(16))) unsigned char lds_dyn[];
#define LDS_BASE() ((LAS unsigned char*)lds_dyn)
__device__ __forceinline__ float sum16(const float* p) {
    const f32x4 a = ((const GAS f32x4*)p)[0], b = ((const GAS f32x4*)p)[1], c = ((const GAS f32x4*)p)[2], d = ((const GAS f32x4*)p)[3];
    return ((a.x + a.y) + (a.z + a.w)) + ((b.x + b.y) + (b.z + b.w)) + ((c.x + c.y) + (c.z + c.w)) + ((d.x + d.y) + (d.z + d.w));
}
__device__ __forceinline__ float sum8(const float* p) {
    const f32x4 a = ((const GAS f32x4*)p)[0], b = ((const GAS f32x4*)p)[1];
    return ((a.x + a.y) + (a.z + a.w)) + ((b.x + b.y) + (b.z + b.w));
}
__device__ __forceinline__ float rs_of(const f32x4 s) { return rsqrtf(((s.x + s.y) + (s.z + s.w)) * (1.f / 1024.f) + NORM_EPS); }
__device__ __forceinline__ float row_rs(const float* SS, int row) { return rs_of(*(const GAS f32x4*)(SS + (size_t)row * 4)); }

#define NOPACK(x_) ((void)0)
struct EpiSwiGLU { static constexpr bool PERM = true;
    bf16_t* H; const float* SS;
    __device__ __forceinline__ void operator()(const AccT& acc, const pg8::Unit& u, int wr, int wc, int fr, int fq) const {
        const int row0 = u.pm * 256 + wr * 64 + fr, hcol = u.pn * 128 + wc * 32 + 8 * fq;
        f32x4 ssv[2][4];
#pragma unroll
        for (int ai = 0; ai < 2; ++ai)
#pragma unroll
            for (int m = 0; m < 4; ++m) ssv[ai][m] = *(const GAS f32x4*)(SS + (size_t)(row0 + ai * 128 + m * 16) * 4);
#pragma unroll
        for (int ai = 0; ai < 2; ++ai)
#pragma unroll
            for (int m = 0; m < 4; ++m) { const int row = row0 + ai * 128 + m * 16; const f32x4 s4 = ssv[ai][m];
                const float ms = ((s4.x + s4.y) + (s4.z + s4.w)) * (1.f / 1024.f) + NORM_EPS; const float rsn = -LOG2E * __builtin_amdgcn_rsqf(ms);
                float h[8];
#pragma unroll
                for (int n = 0; n < 2; ++n)
#pragma unroll
                    for (int j = 0; j < 4; ++j) { const float ga = acc[ai][0][m][n][j], ua = acc[ai][1][m][n][j];
                        float arg = ga * rsn; NOPACK(arg);
                        const float e = fast_exp2(arg);
                        float d = __builtin_fmaf(e, ms, ms); NOPACK(d);
                        const float r = fast_rcp(d);
                        float pr = ga * ua; NOPACK(pr);
                        float hh = pr * r; NOPACK(hh);
                        h[4 * n + j] = hh; }
                u32x4 w; w.x = pk2(h[0], h[1]); w.y = pk2(h[2], h[3]); w.z = pk2(h[4], h[5]); w.w = pk2(h[6], h[7]);
                *(GAS u32x4*)(H + (size_t)row * DFF + hcol) = w; }
    }
};
struct EpiRes { static constexpr bool PERM = true;
    const float* base32; float* out32; bf16_t* XB; float* SS; float alpha;
    __device__ __forceinline__ void operator()(const AccT& acc, const pg8::Unit& u, int wr, int wc, int fr, int fq) const {
        const int row0 = u.pm * 256 + wr * 64 + fr, col0 = u.pn * 256 + wc * 32 + 8 * fq;
        LAS float* P = (LAS float*)(LDS_BASE() + LDS_X_OFF);
#pragma unroll
        for (int ai = 0; ai < 2; ++ai) {
            u32x4 xw[4][2];
            if (!base32) {
#pragma unroll
                for (int m = 0; m < 4; ++m)
#pragma unroll
                    for (int bj = 0; bj < 2; ++bj) xw[m][bj] = *(const GAS u32x4*)(XB + (size_t)(row0 + ai * 128 + m * 16) * DM + col0 + bj * 128);
            }
#pragma unroll
            for (int m = 0; m < 4; ++m) { const int row = row0 + ai * 128 + m * 16; f32x2_t ss2 = {0.f, 0.f};
#pragma unroll
                for (int bj = 0; bj < 2; ++bj) { const size_t off = (size_t)row * DM + col0 + bj * 128;
                    f32x4 b0, b1;
                    if (base32) { b0 = *(const GAS f32x4*)(base32 + off); b1 = *(const GAS f32x4*)(base32 + off + 4); }
                    else { const u32x4 x_ = xw[m][bj]; b0 = (f32x4){bflo(x_.x), bfhi(x_.x), bflo(x_.y), bfhi(x_.y)}; b1 = (f32x4){bflo(x_.z), bfhi(x_.z), bflo(x_.w), bfhi(x_.w)}; }
                    const f32x4 x0 = b0 + acc[ai][bj][m][0] * alpha, x1 = b1 + acc[ai][bj][m][1] * alpha;
                    if (out32) { *(GAS f32x4*)(out32 + off) = x0; *(GAS f32x4*)(out32 + off + 4) = x1; }
                    { const f32x2_t p0 = {x0.x, x0.y}, p1 = {x0.z, x0.w}, p2 = {x1.x, x1.y}, p3 = {x1.z, x1.w}; ss2 = p0 * p0 + ss2; ss2 = p1 * p1 + ss2; ss2 = p2 * p2 + ss2; ss2 = p3 * p3 + ss2; }
                    if (!out32) { u32x4 w; w.x = pk2(x0.x, x0.y); w.y = pk2(x0.z, x0.w); w.z = pk2(x1.x, x1.y); w.w = pk2(x1.z, x1.w);
                        *(GAS u32x4*)(XB + off) = w; } }
                float ssq = ss2.x + ss2.y; ssq += __shfl_xor(ssq, 16); ssq += __shfl_xor(ssq, 32);
                if (fq == 0) P[(ai * 128 + wr * 64 + m * 16 + fr) * 4 + wc] = ssq; }
        }
        lds_barrier();
        if (wc == 0 && fq == 0) {
#pragma unroll
            for (int ai = 0; ai < 2; ++ai)
#pragma unroll
                for (int m = 0; m < 4; ++m) { const int rl = ai * 128 + wr * 64 + m * 16 + fr; const f32x4 s = *(const LAS f32x4*)(P + rl * 4);
                    ((GAS float*)SS)[(size_t)(u.pm * 256 + rl) * 4 + u.pn] = (s.x + s.y) + (s.z + s.w); }
        }
    }
};
__device__ __forceinline__ void rope4(float pos, const f32x4 inv, f32x4& c, f32x4& s) {
#pragma unroll
    for (int j = 0; j < 4; ++j) { const float rv = (pos * inv[j]) * 0.15915494309189535f; const float fr = rv - floorf(rv); c[j] = __builtin_amdgcn_cosf(fr); s[j] = __builtin_amdgcn_sinf(fr); }
}
struct EpiAQK { static constexpr bool PERM = false;
    bf16_t* Q; bf16_t* Kb; const float* SS; const float* gq; const float* gk; const int* pos; int rowbase;
    __device__ __forceinline__ void operator()(const AccT& acc, const pg8::Unit& u, int wr, int wc, int fr, int fq) const {
        const int isk = u.pn >= 12 ? 1 : 0, hh = (u.pn - 12 * isk) * 4 + wc, g = hh >> 4, h = hh & 15, dsh = 2 * g;
        bf16_t* dst = isk ? Kb : Q; const float* gain = isk ? gk : gq; const float osc = isk ? 1.f : 0.125f * LOG2E;
        f32x4 ga[2][2], inv[2];
#pragma unroll
        for (int bj = 0; bj < 2; ++bj)
#pragma unroll
            for (int n = 0; n < 2; ++n) ga[bj][n] = *(const GAS f32x4*)(gain + 32 * bj + 16 * n + 4 * fq);
#pragma unroll
        for (int n = 0; n < 2; ++n)
#pragma unroll
            for (int j = 0; j < 4; ++j) inv[n][j] = exp2f(-(float)(16 * n + 4 * fq + j) * (13.287712379549449f / 32.f));
        f32x4 ssv[2][4]; float pv[2][4];
#pragma unroll
        for (int ai = 0; ai < 2; ++ai)
#pragma unroll
            for (int m = 0; m < 4; ++m) { const int row = rowbase + u.pm * 256 + ai * 128 + wr * 64 + m * 16 + fr; ssv[ai][m] = *(const GAS f32x4*)(SS + (size_t)row * 4); pv[ai][m] = (float)((const GAS int*)pos)[row]; }
#pragma unroll
        for (int ai = 0; ai < 2; ++ai)
#pragma unroll
            for (int m = 0; m < 4; ++m) { const int rl = u.pm * 256 + ai * 128 + wr * 64 + m * 16 + fr; const float rs = rs_of(ssv[ai][m]);
                f32x4 v[2][2]; float ss = 0.f;
#pragma unroll
                for (int bj = 0; bj < 2; ++bj)
#pragma unroll
                    for (int n = 0; n < 2; ++n) { v[bj][n] = acc[ai][bj][m][n] * rs; ss += (v[bj][n].x * v[bj][n].x + v[bj][n].y * v[bj][n].y) + (v[bj][n].z * v[bj][n].z + v[bj][n].w * v[bj][n].w); }
                ss += __shfl_xor(ss, 16); ss += __shfl_xor(ss, 32);
                const float hs = rsqrtf(ss * (1.f / 64.f) + NORM_EPS) * osc;
                const int bl = rl >> 11, s = rl & 2047, r = s & ((1 << dsh) - 1), j = s >> dsh, tp = r * (2048 >> dsh) + j;
                bf16_t* o = dst + ((size_t)((g * 8 + bl) * 16 + h) * 2048 + tp) * 64;
#pragma unroll
                for (int n = 0; n < 2; ++n) { f32x4 c, sn; rope4(pv[ai][m], inv[n], c, sn);
                    const f32x4 x1 = v[0][n] * ga[0][n] * hs, x2 = v[1][n] * ga[1][n] * hs;
                    const f32x4 o1 = x1 * c - x2 * sn, o2 = x2 * c + x1 * sn;
                    u32x2 w1, w2; w1.x = pk2(o1.x, o1.y); w1.y = pk2(o1.z, o1.w); w2.x = pk2(o2.x, o2.y); w2.y = pk2(o2.z, o2.w);
                    *(GAS u32x2*)(o + 16 * n + 4 * fq) = w1; *(GAS u32x2*)(o + 32 + 16 * n + 4 * fq) = w2; } }
    }
};
struct EpiVT { static constexpr bool PERM = true;
    bf16_t* O; size_t ldo; const float* SS; int sstride, soff, scnt; float sdiv; int mode, dsh, rowtok0; int tiled;
    __device__ __forceinline__ void operator()(const AccT& acc, const pg8::Unit& u, int wr, int wc, int fr, int fq) const {
        int tok0, tstride, thoff;
        if (mode == 1) { const int b = u.pn >> 3, tt = u.pn & 7; int t0;
            if (dsh == 0) { t0 = 256 * tt; tstride = 1; thoff = 128; } else if (dsh == 2) { t0 = 4 * ((tt & 1) * 256) + (tt >> 1); tstride = 4; thoff = 512; } else { t0 = 2 * tt; tstride = 16; thoff = 1; }
            tok0 = rowtok0 + b * SEQ + t0; }
        else { tok0 = u.pn * 256; tstride = 1; thoff = 128; }
        float myv;
        {   const int l = fr + 16 * fq, tok = tok0 + tstride * (32 * wc + (l & 31)) + thoff * (l >> 5); const float* p = SS + (size_t)tok * sstride + soff;
            float s; if (scnt == 4) { const f32x4 q = *(const f32x4*)p; s = (q.x + q.y) + (q.z + q.w); } else s = sum8(p); myv = rsqrtf(s / sdiv + NORM_EPS); }
        float sc[2][8];
#pragma unroll
        for (int bj = 0; bj < 2; ++bj)
#pragma unroll
            for (int e = 0; e < 8; ++e) sc[bj][e] = __shfl(myv, bj * 32 + 8 * fq + e);
#pragma unroll
        for (int ai = 0; ai < 2; ++ai)
#pragma unroll
            for (int m = 0; m < 4; ++m) { const int orow = u.pm * 256 + ai * 128 + wr * 64 + m * 16 + fr;
#pragma unroll
                for (int bj = 0; bj < 2; ++bj) { const f32x4 a0 = acc[ai][bj][m][0], a1 = acc[ai][bj][m][1];
                    u32x4 w; w.x = pk2(a0.x * sc[bj][0], a0.y * sc[bj][1]); w.y = pk2(a0.z * sc[bj][2], a0.w * sc[bj][3]); w.z = pk2(a1.x * sc[bj][4], a1.y * sc[bj][5]); w.w = pk2(a1.z * sc[bj][6], a1.w * sc[bj][7]);
                    const size_t col0 = (size_t)u.pn * 256 + 128 * bj + 32 * wc + 8 * fq;
                    if (tiled) *(GAS u32x4*)(O + ((size_t)(orow >> 5) * (ldo >> 4) + (col0 >> 4)) * 512 + ((((int)col0 >> 3) & 1) * 32 + (orow & 31)) * 8) = w;
                    else *(GAS u32x4*)(O + (size_t)orow * ldo + col0) = w; } }
    }
};
struct EpiBIn { static constexpr bool PERM = true;
    bf16_t* CQ; bf16_t* CKV; float* KR; float* SSB; const float* SS;
    __device__ __forceinline__ void operator()(const AccT& acc, const pg8::Unit& u, int wr, int wc, int fr, int fq) const {
        f32x4 ssv[2][4];
#pragma unroll
        for (int ai = 0; ai < 2; ++ai)
#pragma unroll
            for (int m = 0; m < 4; ++m) ssv[ai][m] = *(const GAS f32x4*)(SS + (size_t)(u.pm * 256 + ai * 128 + wr * 64 + m * 16 + fr) * 4);
#pragma unroll
        for (int ai = 0; ai < 2; ++ai)
#pragma unroll
            for (int m = 0; m < 4; ++m) { const int row = u.pm * 256 + ai * 128 + wr * 64 + m * 16 + fr; const float rs = rs_of(ssv[ai][m]);
#pragma unroll
                for (int bj = 0; bj < 2; ++bj) { const int col = u.pn * 256 + bj * 128 + wc * 32 + 8 * fq;
                    const f32x4 v0 = acc[ai][bj][m][0] * rs, v1 = acc[ai][bj][m][1] * rs;
                    float ss = (v0.x * v0.x + v0.y * v0.y) + (v0.z * v0.z + v0.w * v0.w) + (v1.x * v1.x + v1.y * v1.y) + (v1.z * v1.z + v1.w * v1.w);
                    ss += __shfl_xor(ss, 16); ss += __shfl_xor(ss, 32);
                    if (col < 672) { if (fq == 0) ((GAS float*)SSB)[(size_t)row * 32 + (col >> 5)] = ss;
                        if (col < 640) { u32x4 w; w.x = pk2(v0.x, v0.y); w.y = pk2(v0.z, v0.w); w.z = pk2(v1.x, v1.y); w.w = pk2(v1.z, v1.w);
                            if (col < 384) *(GAS u32x4*)(CQ + (size_t)row * 384 + col) = w; else *(GAS u32x4*)(CKV + (size_t)row * 256 + (col - 384)) = w; }
                        else { *(GAS f32x4*)(KR + (size_t)row * 32 + (col - 640)) = v0; *(GAS f32x4*)(KR + (size_t)row * 32 + (col - 640) + 4) = v1; } } } }
    }
};
struct EpiRowScale { static constexpr bool PERM = true;
    bf16_t* O; int ldo; bf16_t* O2; int ld2; int split; const float* SS; int sstride, soff, scnt; float sdiv; int act;
    __device__ __forceinline__ void operator()(const AccT& acc, const pg8::Unit& u, int wr, int wc, int fr, int fq) const {
#pragma unroll
        for (int ai = 0; ai < 2; ++ai) {
            float rsv[4];
#pragma unroll
            for (int m = 0; m < 4; ++m) { const int row = u.pm * 256 + ai * 128 + wr * 64 + m * 16 + fr;
                const float* p = SS + (size_t)row * sstride + soff; float s; if (scnt == 4) { const f32x4 q = *(const f32x4*)p; s = (q.x + q.y) + (q.z + q.w); } else { s = sum8(p); if (scnt >= 12) s += ((const GAS f32x4*)p)[2].x + ((const GAS f32x4*)p)[2].y + ((const GAS f32x4*)p)[2].z + ((const GAS f32x4*)p)[2].w; }
                rsv[m] = s; }
#pragma unroll
            for (int m = 0; m < 4; ++m) { const int row = u.pm * 256 + ai * 128 + wr * 64 + m * 16 + fr;
                const float rs = rsqrtf(rsv[m] / sdiv + NORM_EPS);
#pragma unroll
                for (int bj = 0; bj < 2; ++bj) { const int col = u.pn * 256 + bj * 128 + wc * 32 + 8 * fq;
                    f32x4 v0 = acc[ai][bj][m][0] * rs, v1 = acc[ai][bj][m][1] * rs;
                    if (act == 1 && col < split) { v0 = (f32x4){gelu_tanh_f(v0.x), gelu_tanh_f(v0.y), gelu_tanh_f(v0.z), gelu_tanh_f(v0.w)}; v1 = (f32x4){gelu_tanh_f(v1.x), gelu_tanh_f(v1.y), gelu_tanh_f(v1.z), gelu_tanh_f(v1.w)}; }
                    u32x4 w; w.x = pk2(v0.x, v0.y); w.y = pk2(v0.z, v0.w); w.z = pk2(v1.x, v1.y); w.w = pk2(v1.z, v1.w);
                    if (col < split) *(GAS u32x4*)(O + (size_t)row * ldo + col) = w; else *(GAS u32x4*)(O2 + (size_t)row * ld2 + (col - split)) = w; } }
        }
    }
};
struct EpiBK { static constexpr bool PERM = false;
    bf16_t* KB; const float* SSB; const float* KR; const float* gk; const float* cosT; const float* sinT;
    __device__ __forceinline__ void operator()(const AccT& acc, const pg8::Unit& u, int wr, int wc, int fr, int fq) const {
        const int h = u.pn * 4 + wc;
        f32x4 ga[2][2];
#pragma unroll
        for (int bj = 0; bj < 2; ++bj)
#pragma unroll
            for (int n = 0; n < 2; ++n) ga[bj][n] = *(const GAS f32x4*)(gk + 32 * bj + 16 * n + 4 * fq);
        const f32x4 gr1 = *(const GAS f32x4*)(gk + 64 + 4 * fq), gr2 = *(const GAS f32x4*)(gk + 80 + 4 * fq);
#pragma unroll
        for (int ai = 0; ai < 2; ++ai)
#pragma unroll
            for (int mh = 0; mh < 2; ++mh) {
                f32x4 s0[2], s1[2], kr1[2], kr2[2], cs[2], sv[2]; float ssr[2];
#pragma unroll
                for (int mm = 0; mm < 2; ++mm) { const int row = u.pm * 256 + ai * 128 + wr * 64 + (2 * mh + mm) * 16 + fr; const float* sp = SSB + (size_t)row * 32;
                    s0[mm] = *(const GAS f32x4*)(sp + 12); s1[mm] = *(const GAS f32x4*)(sp + 16); ssr[mm] = ((const GAS float*)sp)[20];
                    kr1[mm] = *(const GAS f32x4*)(KR + (size_t)row * 32 + 4 * fq); kr2[mm] = *(const GAS f32x4*)(KR + (size_t)row * 32 + 16 + 4 * fq);
                    cs[mm] = *(const GAS f32x4*)(cosT + (size_t)row * 16 + 4 * fq); sv[mm] = *(const GAS f32x4*)(sinT + (size_t)row * 16 + 4 * fq); }
#pragma unroll
                for (int mm = 0; mm < 2; ++mm) { const int m = 2 * mh + mm; const int row = u.pm * 256 + ai * 128 + wr * 64 + m * 16 + fr;
                    const float rkv = rsqrtf((((s0[mm].x + s0[mm].y) + (s0[mm].z + s0[mm].w)) + ((s1[mm].x + s1[mm].y) + (s1[mm].z + s1[mm].w))) * (1.f / 256.f) + NORM_EPS);
                    f32x4 v[2][2]; float ss = 0.f;
#pragma unroll
                    for (int bj = 0; bj < 2; ++bj)
#pragma unroll
                        for (int n = 0; n < 2; ++n) { v[bj][n] = acc[ai][bj][m][n] * rkv; ss += (v[bj][n].x * v[bj][n].x + v[bj][n].y * v[bj][n].y) + (v[bj][n].z * v[bj][n].z + v[bj][n].w * v[bj][n].w); }
                    ss += __shfl_xor(ss, 16); ss += __shfl_xor(ss, 32);
                    const float sk = rsqrtf((ss + ssr[mm]) * (1.f / 96.f) + NORM_EPS);
                    const int b = row >> 11, s = row & 2047;
                    bf16_t* o = KB + ((size_t)(b * 16 + h) * 2048 + s) * 96;
#pragma unroll
                    for (int bj = 0; bj < 2; ++bj)
#pragma unroll
                        for (int n = 0; n < 2; ++n) { const f32x4 y = v[bj][n] * ga[bj][n] * sk; u32x2 w; w.x = pk2(y.x, y.y); w.y = pk2(y.z, y.w); *(GAS u32x2*)(o + 32 * bj + 16 * n + 4 * fq) = w; }
                    const f32x4 k1 = kr1[mm] * gr1 * sk, k2 = kr2[mm] * gr2 * sk;
                    const f32x4 o1 = k1 * cs[mm] - k2 * sv[mm], o2 = k2 * cs[mm] + k1 * sv[mm];
                    u32x2 w1, w2; w1.x = pk2(o1.x, o1.y); w1.y = pk2(o1.z, o1.w); w2.x = pk2(o2.x, o2.y); w2.y = pk2(o2.z, o2.w);
                    *(GAS u32x2*)(o + 64 + 4 * fq) = w1; *(GAS u32x2*)(o + 80 + 4 * fq) = w2; }
            }
    }
};
struct EpiCIn { static constexpr bool PERM = false;
    bf16_t* Q; bf16_t* Kc; bf16_t* G; const float* SS; const int* pos;
    __device__ __forceinline__ void operator()(const AccT& acc, const pg8::Unit& u, int wr, int wc, int fr, int fq) const {
        f32x4 ssv[2][4];
#pragma unroll
        for (int ai = 0; ai < 2; ++ai)
#pragma unroll
            for (int m = 0; m < 4; ++m) ssv[ai][m] = *(const GAS f32x4*)(SS + (size_t)(u.pm * 256 + ai * 128 + wr * 64 + m * 16 + fr) * 4);
        if (u.pn >= 8) {
#pragma unroll
            for (int ai = 0; ai < 2; ++ai)
#pragma unroll
                for (int m = 0; m < 4; ++m) { const int row = u.pm * 256 + ai * 128 + wr * 64 + m * 16 + fr; const float rs = rs_of(ssv[ai][m]);
#pragma unroll
                    for (int bj = 0; bj < 2; ++bj)
#pragma unroll
                        for (int n = 0; n < 2; ++n) { const f32x4 v = acc[ai][bj][m][n] * rs; u32x2 w; w.x = pk2(v.x, v.y); w.y = pk2(v.z, v.w);
                            *(GAS u32x2*)(G + (size_t)row * 2048 + (u.pn - 8) * 256 + bj * 128 + wc * 32 + 16 * n + 4 * fq) = w; } }
            return; }
        const int isk = u.pn >= 4 ? 1 : 0, h = (u.pn & 3) * 2 + (wc >> 1);
        bf16_t* dst = isk ? Kc : Q;
        const float lg = log2f(1.f - exp2f(-5.f - (float)h));
        const float ksc = isk ? 0.08838834764831845f : 1.f;
        float pv[2][4]; f32x4 inv[2];
#pragma unroll
        for (int ai = 0; ai < 2; ++ai)
#pragma unroll
            for (int m = 0; m < 4; ++m) pv[ai][m] = (float)((const GAS int*)pos)[u.pm * 256 + ai * 128 + wr * 64 + m * 16 + fr];
#pragma unroll
        for (int n = 0; n < 2; ++n)
#pragma unroll
            for (int j = 0; j < 4; ++j) inv[n][j] = exp2f(-(float)(32 * (wc & 1) + 16 * n + 4 * fq + j) * (13.287712379549449f / 64.f));
#pragma unroll
        for (int ai = 0; ai < 2; ++ai)
#pragma unroll
            for (int m = 0; m < 4; ++m) { const int row = u.pm * 256 + ai * 128 + wr * 64 + m * 16 + fr; const float rs = rs_of(ssv[ai][m]);
                const int b = row >> 11, s = row & 2047, il = s & 127;
                const float dec = fast_exp2((isk ? -(float)(il + 1) : (float)(il + 1)) * lg) * ksc * rs;
                bf16_t* o = dst + ((size_t)(b * 8 + h) * 2048 + s) * 128;
#pragma unroll
                for (int n = 0; n < 2; ++n) { const int i0 = 32 * (wc & 1) + 16 * n + 4 * fq; f32x4 c, sn; rope4(pv[ai][m], inv[n], c, sn);
                    const f32x4 x1 = acc[ai][0][m][n] * dec, x2 = acc[ai][1][m][n] * dec;
                    const f32x4 o1 = x1 * c - x2 * sn, o2 = x2 * c + x1 * sn;
                    u32x2 w1, w2; w1.x = pk2(o1.x, o1.y); w1.y = pk2(o1.z, o1.w); w2.x = pk2(o2.x, o2.y); w2.y = pk2(o2.z, o2.w);
                    *(GAS u32x2*)(o + i0) = w1; *(GAS u32x2*)(o + 64 + i0) = w2; } }
    }
};
struct EpiDGate { static constexpr bool PERM = true;
    bf16_t* LA; bf16_t* GU; const bf16_t* UC; const float* brg; const float* big; const float* lam;
    __device__ __forceinline__ void operator()(const AccT& acc, const pg8::Unit& u, int wr, int wc, int fr, int fq) const {
        const int ch = u.pn * 128 + wc * 32 + 8 * fq;
        u32x4 ucv[2][4];
#pragma unroll
        for (int ai = 0; ai < 2; ++ai)
#pragma unroll
            for (int m = 0; m < 4; ++m) ucv[ai][m] = *(const GAS u32x4*)(UC + (size_t)(u.pm * 256 + ai * 128 + wr * 64 + m * 16 + fr) * 1024 + ch);
        float b1[8], b2[8], sp[8];
#pragma unroll
        for (int e = 0; e < 8; ++e) { b1[e] = ((const GAS float*)brg)[ch + e]; b2[e] = ((const GAS float*)big)[ch + e]; sp[e] = ((const GAS float*)lam)[ch + e]; }
#pragma unroll
        for (int ai = 0; ai < 2; ++ai)
#pragma unroll
            for (int m = 0; m < 4; ++m) { const int row = u.pm * 256 + ai * 128 + wr * 64 + m * 16 + fr;
                const u32x4 uw = ucv[ai][m];
                float uc[8] = {bflo(uw.x), bfhi(uw.x), bflo(uw.y), bfhi(uw.y), bflo(uw.z), bfhi(uw.z), bflo(uw.w), bfhi(uw.w)};
                float la[8], gu[8];
#pragma unroll
                for (int n = 0; n < 2; ++n)
#pragma unroll
                    for (int j = 0; j < 4; ++j) { const int e = 4 * n + j; const float r = sigmoid_f(acc[ai][0][m][n][j] + b1[e]), ig = sigmoid_f(acc[ai][1][m][n][j] + b2[e]);
                        la[e] = sp[e] * r; gu[e] = ig * uc[e]; }
                { u32x4 wl; wl.x = pk2(la[0], la[1]); wl.y = pk2(la[2], la[3]); wl.z = pk2(la[4], la[5]); wl.w = pk2(la[6], la[7]); *(GAS u32x4*)(LA + (size_t)row * 1024 + ch) = wl; }
                u32x4 w; w.x = pk2(gu[0], gu[1]); w.y = pk2(gu[2], gu[3]); w.z = pk2(gu[4], gu[5]); w.w = pk2(gu[6], gu[7]);
                *(GAS u32x4*)(GU + (size_t)row * 1024 + ch) = w; }
    }
};

#define LDS_WAIT() asm volatile("s_waitcnt lgkmcnt(0)" ::: "memory")
template <class F> __device__ __forceinline__ void prep_matrix(bf16_t* Bt, int N, int K, F src4, LAS float* scr, int gw, int NGW, int lane, int& off) {
    const int nblk = N / 32, items = nblk * (K / 64);
    int first = gw - off; if (first < 0) first += NGW;
    off = (off + items) % NGW;
    for (int it = first; it < items; it += NGW) {
        const int kb = it / nblk, nb = it % nblk, k0 = 64 * kb, n0 = 32 * nb;
        const int n4 = (lane & 7) * 4;
#pragma unroll
        for (int i = 0; i < 8; ++i) { const int kk = (lane >> 3) + 8 * i; const f32x4 v = src4(n0 + n4, k0 + kk); LAS float* d = scr + kk * 33 + n4; d[0] = v.x; d[1] = v.y; d[2] = v.z; d[3] = v.w; }
        LDS_WAIT(); asm volatile("" ::: "memory");
        const int c = lane & 7;
#pragma unroll
        for (int j = 0; j < 4; ++j) { const int n = (lane >> 3) + 8 * j; const LAS float* s = scr + (8 * c) * 33 + n;
            u32x4 o; o.x = pk2(s[0 * 33], s[1 * 33]); o.y = pk2(s[2 * 33], s[3 * 33]); o.z = pk2(s[4 * 33], s[5 * 33]); o.w = pk2(s[6 * 33], s[7 * 33]);
            *(u32x4*)(Bt + (size_t)(n0 + n) * K + k0 + 8 * c) = o; }
        LDS_WAIT(); asm volatile("" ::: "memory");
    }
}
#define LD4(p) (*(const f32x4*)(p))

#define MFMA32(a, b, c) __builtin_amdgcn_mfma_f32_32x32x16_bf16((a), (b), (c), 0, 0, 0)
__device__ __forceinline__ bf16x8 mk8(u32x2 lo, u32x2 hi) { u32x4 v = {lo.x, lo.y, hi.x, hi.y}; return __builtin_bit_cast(bf16x8, v); }
__device__ __forceinline__ bf16x8 pack8(const f32x16& p, int ks) {
    u32x4 v; v.x = pk2(p[8 * ks + 0], p[8 * ks + 1]); v.y = pk2(p[8 * ks + 2], p[8 * ks + 3]); v.z = pk2(p[8 * ks + 4], p[8 * ks + 5]); v.w = pk2(p[8 * ks + 6], p[8 * ks + 7]);
    return __builtin_bit_cast(bf16x8, v);
}

__device__ __forceinline__ void mixA_attn(LAS unsigned char* lds, const bf16_t* QA, const bf16_t* KA, const bf16_t* VT, bf16_t* OA, int half, float shift) {
    const int tid = opaque_tid(), lane = tid & 63, wid = __builtin_amdgcn_readfirstlane(tid >> 6), r32 = lane & 31, hi = lane >> 5;
    LAS float* Ol = (LAS float*)lds; LAS float* Ll = (LAS float*)(lds + LDS_X_OFF);
#pragma unroll 1
    for (int ui = blockIdx.x; ui < 512; ui += gridDim.x) {
        const int blh = (ui & 255) >> 1, k_ = ui >> 8, c = (ui & 1) ? (1 + k_) : (3 * k_);
        const int bl = blh >> 4, h = blh & 15;
#pragma unroll 1
        for (int g = 0; g < 3; ++g) {
            const int dsh = 2 * g, L = 2048 >> dsh, tsh = 4 - dsh;
            const size_t hb = ((size_t)((g * 8 + bl) * 16 + h)) * 2048;
            const bf16_t* vbase = VT + ((size_t)(g * 1024 + h * 64)) * 16384 + (size_t)bl * 2048;
#pragma unroll 1
            for (int tt = 0; tt < 2; ++tt) {
                const int tau = 2 * wid + tt, r = tau >> tsh, a = (c << tsh) + (tau & ((1 << tsh) - 1));
                const size_t rb = hb + (size_t)r * L;
                bf16x8 qf[4];
#pragma unroll
                for (int d0 = 0; d0 < 4; ++d0) qf[d0] = *(const bf16x8*)(QA + (rb + 32 * a + r32) * 64 + 16 * d0 + 8 * hi);
                f32x16 o0 = {}, o1 = {}; float lsum = 0.f;
                f32x16 negs;
#pragma unroll
                for (int rr = 0; rr < 16; ++rr) negs[rr] = -shift;
                const int kb0 = a - 4 < 0 ? 0 : a - 4;
                const bf16_t* kp0 = KA + (rb + r32) * 64 + 8 * hi;
                const bf16_t* vp0 = VT + ((size_t)(g * 32 + 2 * h) * 1024 + (size_t)((bl * 2048 + r * L) >> 4)) * 512 + r32 * 8 + 4 * hi;
                bf16x8 kf[4]; u32x2 vl[2][2][2];
#define A_LOAD(KF, VL, kb_) do { _Pragma("unroll") for (int d0 = 0; d0 < 4; ++d0) KF[d0] = *(const bf16x8*)(kp0 + (size_t)(32 * (kb_)) * 64 + 16 * d0); \
                    _Pragma("unroll") for (int db = 0; db < 2; ++db) _Pragma("unroll") for (int ks = 0; ks < 2; ++ks) { const bf16_t* f_ = vp0 + ((size_t)db * 1024 + 2 * (kb_) + ks) * 512; VL[db][ks][0] = *(const u32x2*)(f_); VL[db][ks][1] = *(const u32x2*)(f_ + 256); } } while (0)
                A_LOAD(kf, vl, kb0);
#pragma unroll 1
                for (int kb = kb0; kb <= a; ++kb) {
                    bf16x8 kfn[4]; u32x2 vln[2][2][2];
                    const int kbn = kb < a ? kb + 1 : kb;
                    A_LOAD(kfn, vln, kbn);
                    f32x16 st = negs;
#pragma unroll
                    for (int d0 = 0; d0 < 4; ++d0) st = MFMA32(kf[d0], qf[d0], st);
                    if (kb == a || kb == a - 4) {
                        const int thi = ((kb == a) ? r32 : 63) - 4 * hi, tlo = ((kb == a - 4) ? r32 : -1) - 4 * hi;
#pragma unroll
                        for (int rr = 0; rr < 16; ++rr) { const int kc = (rr & 3) + 8 * (rr >> 2); const bool ok = (kc <= thi) && (kc >= tlo);
                            const float p = ok ? fast_exp2(st[rr]) : 0.f; st[rr] = p; lsum += p; }
                    } else {
#pragma unroll
                        for (int rr = 0; rr < 16; ++rr) { const float p = fast_exp2(st[rr]); st[rr] = p; lsum += p; }
                    }
                    const bf16x8 p0 = pack8(st, 0), p1 = pack8(st, 1);
                    o0 = MFMA32(mk8(vl[0][0][0], vl[0][0][1]), p0, o0); o0 = MFMA32(mk8(vl[0][1][0], vl[0][1][1]), p1, o0);
                    o1 = MFMA32(mk8(vl[1][0][0], vl[1][0][1]), p0, o1); o1 = MFMA32(mk8(vl[1][1][0], vl[1][1][1]), p1, o1);
#pragma unroll
                    for (int d0 = 0; d0 < 4; ++d0) kf[d0] = kfn[d0];
#pragma unroll
                    for (int db = 0; db < 2; ++db)
#pragma unroll
                        for (int ks = 0; ks < 2; ++ks) { vl[db][ks][0] = vln[db][ks][0]; vl[db][ks][1] = vln[db][ks][1]; }
                }
#undef A_LOAD
                lsum += __shfl_xor(lsum, 32);
                const int pp = ((32 * a + r32) << dsh) + r - 512 * c;
#pragma unroll
                for (int db = 0; db < 2; ++db)
#pragma unroll
                    for (int q4 = 0; q4 < 4; ++q4) { const int ch = 2 * q4 + hi + 8 * db; LAS f32x4* ad = (LAS f32x4*)(Ol + pp * 64 + ((ch ^ ((pp ^ (pp >> 4)) & 15)) << 2));
                        const f32x16& o = db ? o1 : o0; f32x4 v = {o[4 * q4], o[4 * q4 + 1], o[4 * q4 + 2], o[4 * q4 + 3]};
                        if (g > 0) v += *ad; *ad = v; }
                if (hi == 0) Ll[pp] = (g > 0 ? Ll[pp] : 0.f) + lsum;
            }
            __syncthreads();
        }
        for (int idx = tid; idx < 4096; idx += 512) { const int pp = idx >> 3, c8 = idx & 7; const float inv = 1.f / Ll[pp];
            const f32x4 a = *(LAS f32x4*)(Ol + pp * 64 + (((2 * c8) ^ ((pp ^ (pp >> 4)) & 15)) << 2)), b = *(LAS f32x4*)(Ol + pp * 64 + (((2 * c8 + 1) ^ ((pp ^ (pp >> 4)) & 15)) << 2));
            u32x4 w; w.x = pk2(a.x * inv, a.y * inv); w.y = pk2(a.z * inv, a.w * inv); w.z = pk2(b.x * inv, b.y * inv); w.w = pk2(b.z * inv, b.w * inv);
            *(u32x4*)(OA + ((size_t)(half * 8 + bl) * 2048 + 512 * c + pp) * 1024 + h * 64 + 8 * c8) = w; }
        __syncthreads();
    }
}

constexpr int BK_STRIDE = 208, BK_TILE = 64 * BK_STRIDE, BV_STRIDE = 144, BV_TILE = 64 * BV_STRIDE;
__device__ __forceinline__ void mixB_attn(LAS unsigned char* lds, const bf16_t* QR, const bf16_t* KB, const bf16_t* VT, bf16_t* OB, const float* gq, const float* cosT, const float* sinT, float shift) {
    const int tid = opaque_tid(), lane = tid & 63, wid = __builtin_amdgcn_readfirstlane(tid >> 6), r32 = lane & 31, hi = lane >> 5;
    const float qsc = 0.10206207261596575f * LOG2E;
    LAS unsigned char* Kl = lds; LAS unsigned char* Vl = lds + 2 * BK_TILE;
    const int c2 = tid + 512;
    const int kdst1 = (tid / 12) * BK_STRIDE + 16 * (tid % 12), kdst2 = (c2 / 12) * BK_STRIDE + 16 * (c2 % 12);
    const int vd = tid >> 3, c8 = tid & 7, vdst = vd * BV_STRIDE + 2 * (16 * (c8 >> 1) + 4 * (c8 & 1));
    const int kfo = r32 * BK_STRIDE + 16 * hi, vfo = r32 * BV_STRIDE + 16 * hi;
#pragma unroll 1
    for (int unit = blockIdx.x; unit < 256; unit += gridDim.x) {
        const int b = unit >> 4, h = unit & 15;
        const bf16_t* kbase = KB + (size_t)(b * 16 + h) * 2048 * 96;
        const bf16_t* vsrc = VT + (size_t)(h * 64 + vd) * MTOK + (size_t)b * 2048 + 8 * c8;
#pragma unroll 1
        for (int qb = 0; qb < 8; ++qb) {
            const int qfirst = 256 * qb + 32 * wid, row = b * 2048 + qfirst + r32;
            bf16x8 qf[6];
            {   float qv[6][8]; float ss = 0.f;
#pragma unroll
                for (int d0 = 0; d0 < 6; ++d0) { const u32x4 w = *(const u32x4*)(QR + (size_t)row * 1536 + h * 96 + 16 * d0 + 8 * hi);
                    qv[d0][0] = bflo(w.x); qv[d0][1] = bfhi(w.x); qv[d0][2] = bflo(w.y); qv[d0][3] = bfhi(w.y); qv[d0][4] = bflo(w.z); qv[d0][5] = bfhi(w.z); qv[d0][6] = bflo(w.w); qv[d0][7] = bfhi(w.w);
#pragma unroll
                    for (int e = 0; e < 8; ++e) ss += qv[d0][e] * qv[d0][e]; }
                ss += __shfl_xor(ss, 32);
                const float sq = rsqrtf(ss * (1.f / 96.f) + NORM_EPS) * qsc;
#pragma unroll
                for (int d0 = 0; d0 < 6; ++d0)
#pragma unroll
                    for (int e = 0; e < 8; ++e) qv[d0][e] *= sq * gq[16 * d0 + 8 * hi + e];
#pragma unroll
                for (int e = 0; e < 8; ++e) { const float c = cosT[(size_t)row * 16 + 8 * hi + e], sn = sinT[(size_t)row * 16 + 8 * hi + e]; const float x1 = qv[4][e], x2 = qv[5][e];
                    qv[4][e] = x1 * c - x2 * sn; qv[5][e] = x2 * c + x1 * sn; }
#pragma unroll
                for (int d0 = 0; d0 < 6; ++d0) { u32x4 w; w.x = pk2(qv[d0][0], qv[d0][1]); w.y = pk2(qv[d0][2], qv[d0][3]); w.z = pk2(qv[d0][4], qv[d0][5]); w.w = pk2(qv[d0][6], qv[d0][7]); qf[d0] = __builtin_bit_cast(bf16x8, w); }
            }
            f32x16 negs;
#pragma unroll
            for (int rr = 0; rr < 16; ++rr) negs[rr] = -shift;
            f32x16 o0 = {}, o1 = {}; float lsum = 0.f;
            const int ntile = 4 * qb + 4;
            {
                const u32x4 k1 = *(const u32x4*)(kbase + 8 * tid); u32x4 k2 = {}; if (tid < 256) k2 = *(const u32x4*)(kbase + 8 * c2);
                const u32x4 v1 = *(const u32x4*)(vsrc);
                *(LAS u32x4*)(Kl + kdst1) = k1; if (tid < 256) *(LAS u32x4*)(Kl + kdst2) = k2;
                *(LAS u32x2*)(Vl + vdst) = (u32x2){v1.x, v1.y}; *(LAS u32x2*)(Vl + vdst + 16) = (u32x2){v1.z, v1.w};
            }
            __syncthreads();
#pragma unroll 1
            for (int t = 0; t < ntile; ++t) {
                const bool more = (t + 1 < ntile);
                u32x4 k1 = {}, k2 = {}, v1 = {};
                if (more) { const bf16_t* kt = kbase + (size_t)(t + 1) * 64 * 96; k1 = *(const u32x4*)(kt + 8 * tid); if (tid < 256) k2 = *(const u32x4*)(kt + 8 * c2); v1 = *(const u32x4*)(vsrc + 64 * (t + 1)); }
                const LAS unsigned char* Kt = Kl + (t & 1) * BK_TILE; const LAS unsigned char* Vt = Vl + (t & 1) * BV_TILE;
#pragma unroll
                for (int kblk = 0; kblk < 2; ++kblk) {
                    const int key0 = 64 * t + 32 * kblk;
                    if (key0 <= qfirst + 31) {
                        f32x16 st = negs;
#pragma unroll
                        for (int d0 = 0; d0 < 6; ++d0) { const bf16x8 kf = *(const LAS bf16x8*)(Kt + kblk * 32 * BK_STRIDE + kfo + 32 * d0); st = MFMA32(kf, qf[d0], st); }
                        if (key0 + 31 > qfirst) {
                            const int thi = (qfirst - key0 + r32) - 4 * hi;
#pragma unroll
                            for (int rr = 0; rr < 16; ++rr) { const int kc = (rr & 3) + 8 * (rr >> 2); const float p = (kc <= thi) ? fast_exp2(st[rr]) : 0.f; st[rr] = p; lsum += p; }
                        } else {
#pragma unroll
                            for (int rr = 0; rr < 16; ++rr) { const float p = fast_exp2(st[rr]); st[rr] = p; lsum += p; }
                        }
                        const bf16x8 p0 = pack8(st, 0), p1 = pack8(st, 1);
                        const LAS unsigned char* vp = Vt + vfo + 2 * (32 * kblk);
                        o0 = MFMA32(*(const LAS bf16x8*)(vp), p0, o0); o0 = MFMA32(*(const LAS bf16x8*)(vp + 32), p1, o0);
                        o1 = MFMA32(*(const LAS bf16x8*)(vp + 32 * BV_STRIDE), p0, o1); o1 = MFMA32(*(const LAS bf16x8*)(vp + 32 * BV_STRIDE + 32), p1, o1);
                    }
                }
                if (more) { LAS unsigned char* Kn = Kl + ((t + 1) & 1) * BK_TILE; LAS unsigned char* Vn = Vl + ((t + 1) & 1) * BV_TILE;
                    *(LAS u32x4*)(Kn + kdst1) = k1; if (tid < 256) *(LAS u32x4*)(Kn + kdst2) = k2;
                    *(LAS u32x2*)(Vn + vdst) = (u32x2){v1.x, v1.y}; *(LAS u32x2*)(Vn + vdst + 16) = (u32x2){v1.z, v1.w}; }
                __syncthreads();
            }
            lsum += __shfl_xor(lsum, 32);
            const float inv = 1.f / lsum;
            bf16_t* op = OB + (size_t)row * 1024 + h * 64;
#pragma unroll
            for (int db = 0; db < 2; ++db)
#pragma unroll
                for (int q4 = 0; q4 < 4; ++q4) { const f32x16& o = db ? o1 : o0; u32x2 w; w.x = pk2(o[4 * q4] * inv, o[4 * q4 + 1] * inv); w.y = pk2(o[4 * q4 + 2] * inv, o[4 * q4 + 3] * inv);
                    *(u32x2*)(op + 32 * db + 8 * q4 + 4 * hi) = w; }
        }
    }
}

constexpr int KT_STRIDE = 272, RT_STRIDE = 272, YS_STRIDE = 528;
constexpr int RET_KR = 0, RET_YS = 128 * KT_STRIDE, RET_RT = 2 * 128 * KT_STRIDE, RET_ST = MISC_OFF + 1024;
static_assert(RET_YS + 64 * YS_STRIDE <= RET_RT && RET_RT + 256 * RT_STRIDE <= MISC_OFF && RET_ST + 2048 <= LDS_BYTES, "retention LDS map");
typedef short v4i16_t __attribute__((ext_vector_type(4)));
__device__ __forceinline__ u32x2 lds_tr(const LAS unsigned char* p) { return __builtin_bit_cast(u32x2, __builtin_amdgcn_ds_read_tr16_b64_v4i16((LAS v4i16_t*)p)); }
__device__ __forceinline__ void mixC_retention(LAS unsigned char* lds, const bf16_t* QC, const bf16_t* KC, const bf16_t* VT, bf16_t* G) {
    const int tid = opaque_tid(), lane = tid & 63, wid = __builtin_amdgcn_readfirstlane(tid >> 6), r32 = lane & 31, hi = lane >> 5;
    LAS unsigned char* KR = lds + RET_KR; LAS unsigned char* YS = lds + RET_YS; LAS unsigned char* RT = lds + RET_RT; LAS float* ST = (LAS float*)(lds + RET_ST);
    const int trb = (8 * hi + ((lane & 15) >> 2)) * KT_STRIDE + (16 * ((lane >> 4) & 1) + 4 * (lane & 3)) * 2;
#pragma unroll 1
    for (int unit = blockIdx.x; unit < 256; unit += gridDim.x) {
        const int b = unit >> 4, h = (unit >> 1) & 7, rh = unit & 1;
        const int ib = wid & 1, gi = ib ? (3 - rh) : rh, vq = wid >> 1;
        const float lg = log2f(1.f - exp2f(-5.f - (float)h)), cd = exp2f(128.f * lg);
        const size_t bh = (size_t)(b * 8 + h) * 2048;
        f32x16 Racc[4];
#pragma unroll
        for (int db = 0; db < 4; ++db) Racc[db] = (f32x16){};
        const bf16_t* qsrc = QC + (bh + 32 * gi + r32) * 128 + 8 * hi;
        const bf16_t* ksrc = KC + bh * 128 + 8 * tid;
        const bf16_t* vin0 = VT + ((size_t)(h * 8 + 2 * vq) * (MTOK / 16) + (size_t)(b * 128)) * 512 + r32 * 8 + 4 * hi;
        const bf16_t* vup0 = VT + ((size_t)(h * 8 + wid) * (MTOK / 16) + (size_t)(b * 128)) * 512 + (hi * 32 + r32) * 8;
        const int orow = tid >> 3, ogi = (orow >> 5) ? (3 - rh) : rh;
        bf16_t* gp0 = G + ((size_t)b * 2048 + 32 * ogi + (orow & 31)) * 2048 + h * 256 + 8 * (tid & 7);
        u32x4 kst[4]; bf16x8 qf[8];
#pragma unroll
        for (int e = 0; e < 4; ++e) kst[e] = *(const u32x4*)(ksrc + 4096 * e);
#pragma unroll
        for (int s = 0; s < 8; ++s) qf[s] = *(const bf16x8*)(qsrc + 16 * s);
#pragma unroll 1
        for (int c = 0; c < 16; ++c) {
            const int cn = c < 15 ? c + 1 : c;
#pragma unroll
            for (int e = 0; e < 4; ++e) { const int id = tid + 512 * e; *(LAS u32x4*)(KR + (id >> 4) * KT_STRIDE + 16 * (id & 15)) = kst[e]; }
            bf16x8 vupd[8];
#pragma unroll
            for (int s = 0; s < 4; ++s) vupd[s] = *(const bf16x8*)(vup0 + (size_t)(8 * c + s) * 512);
            u32x2 vin[8];
#define C_VIN(dst, jb_) do { const bf16_t* vp_ = vin0 + (size_t)(8 * c + 2 * (jb_)) * 512; const bf16_t* vq_ = vp_ + (size_t)(MTOK / 16) * 512; \
                dst[0] = *(const u32x2*)(vp_); dst[1] = *(const u32x2*)(vp_ + 256); dst[2] = *(const u32x2*)(vp_ + 512); dst[3] = *(const u32x2*)(vp_ + 768); \
                dst[4] = *(const u32x2*)(vq_); dst[5] = *(const u32x2*)(vq_ + 256); dst[6] = *(const u32x2*)(vq_ + 512); dst[7] = *(const u32x2*)(vq_ + 768); } while (0)
            C_VIN(vin, 0);
            __syncthreads();
            f32x16 y0 = {}, y1 = {};
            if (c > 0) {
#pragma unroll
                for (int s = 0; s < 8; ++s) { const bf16x8 a0 = *(const LAS bf16x8*)(RT + (64 * vq + r32) * RT_STRIDE + (16 * s + 8 * hi) * 2), a1 = *(const LAS bf16x8*)(RT + (64 * vq + 32 + r32) * RT_STRIDE + (16 * s + 8 * hi) * 2);
                    y0 = MFMA32(a0, qf[s], y0); y1 = MFMA32(a1, qf[s], y1); }
            }
#pragma unroll 1
            for (int jb = 0; jb <= gi; ++jb) {
                u32x2 vnx[8];
                const int jn = jb < gi ? jb + 1 : jb;
                C_VIN(vnx, jn);
                f32x16 st = {};
#pragma unroll
                for (int s = 0; s < 8; ++s) { const bf16x8 kf = *(const LAS bf16x8*)(KR + (32 * jb + r32) * KT_STRIDE + (16 * s + 8 * hi) * 2); st = MFMA32(kf, qf[s], st); }
                {   const int thi = ((jb == gi) ? r32 : 63) - 4 * hi;
#pragma unroll
                    for (int rr = 0; rr < 16; ++rr) { const int kc = (rr & 3) + 8 * (rr >> 2); st[rr] = (kc <= thi) ? st[rr] : 0.f; } }
                const bf16x8 p0 = pack8(st, 0), p1 = pack8(st, 1);
                y0 = MFMA32(mk8(vin[0], vin[1]), p0, y0); y0 = MFMA32(mk8(vin[2], vin[3]), p1, y0); y1 = MFMA32(mk8(vin[4], vin[5]), p0, y1); y1 = MFMA32(mk8(vin[6], vin[7]), p1, y1);
#pragma unroll
                for (int e = 0; e < 8; ++e) vin[e] = vnx[e];
            }
#undef C_VIN
#pragma unroll
            for (int s = 4; s < 8; ++s) vupd[s] = *(const bf16x8*)(vup0 + (size_t)(8 * c + s) * 512);
#pragma unroll
            for (int s = 0; s < 8; ++s) qf[s] = *(const bf16x8*)(qsrc + (size_t)16384 * cn + 16 * s);
            bf16_t* gp = gp0 + (size_t)262144 * c;
            u32x4 gv[4];
#pragma unroll
            for (int k = 0; k < 4; ++k) gv[k] = *(const u32x4*)(gp + 64 * k);
#pragma unroll
            for (int s = 0; s < 8; ++s) {
#pragma unroll
                for (int db = 0; db < 4; ++db) { const LAS unsigned char* ap = KR + trb + (16 * s) * KT_STRIDE + 64 * db;
                    const bf16x8 af = mk8(lds_tr(ap), lds_tr(ap + 4 * KT_STRIDE)); Racc[db] = MFMA32(af, vupd[s], Racc[db]); } }
#pragma unroll
            for (int db = 0; db < 4; ++db) Racc[db] *= cd;
            float s1 = 0.f, s2 = 0.f;
#pragma unroll
            for (int rr = 0; rr < 16; ++rr) { s1 += y0[rr] + y1[rr]; s2 += y0[rr] * y0[rr] + y1[rr] * y1[rr]; }
            s1 += __shfl_xor(s1, 32); s2 += __shfl_xor(s2, 32);
            __syncthreads();
#pragma unroll
            for (int e = 0; e < 4; ++e) kst[e] = *(const u32x4*)(ksrc + (size_t)16384 * cn + 4096 * e);
#pragma unroll
            for (int db = 0; db < 4; ++db)
#pragma unroll
                for (int q4 = 0; q4 < 4; ++q4) { u32x2 w; w.x = pk2(Racc[db][4 * q4], Racc[db][4 * q4 + 1]); w.y = pk2(Racc[db][4 * q4 + 2], Racc[db][4 * q4 + 3]);
                    *(LAS u32x2*)(RT + (32 * wid + r32) * RT_STRIDE + (32 * db + 8 * q4 + 4 * hi) * 2) = w; }
            if (hi == 0) { ST[((ib * 4 + vq) * 32 + r32) * 2] = s1; ST[((ib * 4 + vq) * 32 + r32) * 2 + 1] = s2; }
            __syncthreads();
            float t1 = 0.f, t2 = 0.f;
#pragma unroll
            for (int q = 0; q < 4; ++q) { t1 += ST[((ib * 4 + q) * 32 + r32) * 2]; t2 += ST[((ib * 4 + q) * 32 + r32) * 2 + 1]; }
            const float mu = t1 * (1.f / 256.f), var = fmaxf(t2 * (1.f / 256.f) - mu * mu, 0.f), rstd = rsqrtf(var + GN_EPS);
#pragma unroll
            for (int vb = 0; vb < 2; ++vb)
#pragma unroll
                for (int q4 = 0; q4 < 4; ++q4) { const f32x16& y = vb ? y1 : y0; const float nb = -mu * rstd; u32x2 w; w.x = pk2(__builtin_fmaf(y[4 * q4], rstd, nb), __builtin_fmaf(y[4 * q4 + 1], rstd, nb)); w.y = pk2(__builtin_fmaf(y[4 * q4 + 2], rstd, nb), __builtin_fmaf(y[4 * q4 + 3], rstd, nb));
                    *(LAS u32x2*)(YS + (32 * ib + r32) * YS_STRIDE + (64 * vq + 32 * vb + 8 * q4 + 4 * hi) * 2) = w; }
            __syncthreads();
#pragma unroll
            for (int k = 0; k < 4; ++k) { const u32x4 yw = *(const LAS u32x4*)(YS + orow * YS_STRIDE + 16 * ((tid & 7) + 8 * k)); const u32x4 gw = gv[k];
                u32x4 o; o.x = pk2(silu_f(bflo(gw.x)) * bflo(yw.x), silu_f(bfhi(gw.x)) * bfhi(yw.x)); o.y = pk2(silu_f(bflo(gw.y)) * bflo(yw.y), silu_f(bfhi(gw.y)) * bfhi(yw.y));
                o.z = pk2(silu_f(bflo(gw.z)) * bflo(yw.z), silu_f(bfhi(gw.z)) * bfhi(yw.z)); o.w = pk2(silu_f(bflo(gw.w)) * bflo(yw.w), silu_f(bfhi(gw.w)) * bfhi(yw.w));
                *(u32x4*)(gp + 64 * k) = o; }
        }
        __syncthreads();
    }
}

__device__ __forceinline__ void mixD_conv(const bf16_t* U, bf16_t* UC, const float* cw, const float* cb) {
    const int gt = blockIdx.x * 512 + opaque_tid(), NT = gridDim.x * 512;
    for (int idx = gt; idx < (MTOK / 4) * 128; idx += NT) { const int row0 = (idx >> 7) * 4, c0 = (idx & 127) * 8, s0 = row0 & 2047;
        u32x4 uw[7];
#pragma unroll
        for (int k = 0; k < 7; ++k) { uw[k] = (u32x4){0u, 0u, 0u, 0u}; if (s0 - 3 + k >= 0) uw[k] = *(const u32x4*)(U + (size_t)(row0 - 3 + k) * 1024 + c0); }
        float wv[4][8], bv[8];
#pragma unroll
        for (int e = 0; e < 8; ++e) { bv[e] = cb[c0 + e];
#pragma unroll
            for (int w = 0; w < 4; ++w) wv[w][e] = cw[w * 1024 + c0 + e]; }
#pragma unroll
        for (int r = 0; r < 4; ++r) { float acc[8];
#pragma unroll
            for (int e = 0; e < 8; ++e) acc[e] = bv[e];
#pragma unroll
            for (int w = 0; w < 4; ++w) { const u32x4 x = uw[r + w]; const float uv[8] = {bflo(x.x), bfhi(x.x), bflo(x.y), bfhi(x.y), bflo(x.z), bfhi(x.z), bflo(x.w), bfhi(x.w)};
#pragma unroll
                for (int e = 0; e < 8; ++e) acc[e] += wv[w][e] * uv[e]; }
            u32x4 o; o.x = pk2(acc[0], acc[1]); o.y = pk2(acc[2], acc[3]); o.z = pk2(acc[4], acc[5]); o.w = pk2(acc[6], acc[7]);
            *(u32x4*)(UC + (size_t)(row0 + r) * 1024 + c0) = o; }
    }
}
__device__ __forceinline__ void mixD_scan(LAS unsigned char* lds, const bf16_t* LA, const bf16_t* GU, bf16_t* GG) {
    const int tid = opaque_tid(), lane = tid & 63, wid = __builtin_amdgcn_readfirstlane(tid >> 6);
    LAS float* CP = (LAS float*)(lds + LDS_X_OFF); LAS float* CH = CP + 512;
#pragma unroll 1
    for (int unit = blockIdx.x; unit < 256; unit += gridDim.x) {
        const int b = unit >> 4, ch = (unit & 15) * 64 + lane;
        float carry = 0.f;
#pragma unroll 1
        for (int rd = 0; rd < 8; ++rd) {
            const size_t base = ((size_t)b * 2048 + 256 * rd + 32 * wid) * 1024 + ch;
            float a[32], bb[32], gg[32];
#pragma unroll
            for (int s = 0; s < 32; ++s) { a[s] = __uint_as_float((unsigned)LA[base + (size_t)s * 1024] << 16); bb[s] = __uint_as_float((unsigned)GU[base + (size_t)s * 1024] << 16); gg[s] = __uint_as_float((unsigned)GG[base + (size_t)s * 1024] << 16); }
            float P = 1.f, H = 0.f;
#pragma unroll
            for (int s = 0; s < 32; ++s) { const float av = fast_exp2(a[s] * LOG2E); a[s] = av; bb[s] = sqrtf(fmaxf(1.f - av * av, 0.f)) * bb[s]; H = av * H + bb[s]; P *= av; }
            CP[wid * 64 + lane] = P; CH[wid * 64 + lane] = H;
            __syncthreads();
            float h = carry, hin = 0.f;
#pragma unroll
            for (int w = 0; w < 8; ++w) { if (w == wid) hin = h; h = CP[w * 64 + lane] * h + CH[w * 64 + lane]; }
            carry = h;
            h = hin;
#pragma unroll
            for (int s = 0; s < 32; ++s) { h = a[s] * h + bb[s]; GG[base + (size_t)s * 1024] = (bf16_t)(pk2(gg[s] * h, 0.f) & 0xffff); }
            __syncthreads();
        }
    }
}

constexpr int NWAVES = 8;
__device__ __forceinline__ const void* ldptr(int i) {
    const unsigned long long v = ((volatile LAS unsigned long long*)(LDS_BASE() + PT_OFF))[i];
    const unsigned lo = __builtin_amdgcn_readfirstlane((unsigned)v), hi = __builtin_amdgcn_readfirstlane((unsigned)(v >> 32));
    return (const void*)(((unsigned long long)hi << 32) | lo);
}
#define INF(i) ((const float*)ldptr(i))
#define WSP() ((unsigned char*)ldptr(29))
#define XOUT() ((float*)ldptr(28))
#define RSBUF(ws_, par_) ((float*)((ws_) + WS_SS))
#define GSZ ((int)gridDim.x)
#define BX ((int)blockIdx.x)
__device__ __forceinline__ void grid_bar() {
    XcdBarrier b; b.bar = (unsigned*)(WSP() + WS_CTL) + 1024; b.x = xb_xcc_id(); b.st = (volatile LAS unsigned*)(LDS_BASE() + MISC_OFF) + 8;
    xcd_barrier(b);
}
#define GRID_BAR() grid_bar()

__device__ __forceinline__ void phase_prologue() {
    LAS unsigned char* lds = LDS_BASE();
    const int tid = opaque_tid(), lane = tid & 63, wave = __builtin_amdgcn_readfirstlane(tid >> 6);
    const int gw = BX * NWAVES + wave, NGW = GSZ * NWAVES;
    unsigned char* ws = WSP();
    const float* norm_g = INF(2);
    LAS float* scr = (LAS float*)(lds + wave * 16384); int poff = 0;
    {   const float* ffn_w_in = INF(3); const float* ffn_w_out = INF(4);
        for (int lw = 0; lw < 8; ++lw) {
            const float* g = norm_g + (size_t)((lw >> 1) * 3 + ((lw & 1) ? 2 : 0)) * 1024;
            const float* wi = ffn_w_in + (size_t)lw * 1024 * 5632; const float* wo = ffn_w_out + (size_t)lw * 2816 * 1024;
            prep_matrix((bf16_t*)(ws + W_FUP + lw * SZ_FUP), 5632, 1024, [=](int n, int k) { const int p = n & 255, col = (p >> 7) * 2816 + (n >> 8) * 128 + (p & 127); return LD4(wi + (size_t)k * 5632 + col) * g[k]; }, scr, gw, NGW, lane, poff);
            prep_matrix((bf16_t*)(ws + W_FDN + lw * SZ_FDN), 1024, 2816, [=](int n, int k) { return LD4(wo + (size_t)k * 1024 + n); }, scr, gw, NGW, lane, poff);
        } }
    {
        const float* g = norm_g + (size_t)(0 * 3 + 1) * 1024; const float* w = INF(5); const float* wo = INF(8);
        prep_matrix((bf16_t*)(ws + W_AQK), 6144, 1024, [=](int n, int k) { const int pn = n >> 8, p = n & 255, bj = p >> 7, wc = (p >> 5) & 3, dd = p & 31, isk = pn >= 12 ? 1 : 0;
            const int col = isk * 3072 + (((pn - 12 * isk) * 4 + wc) * 64) + dd + 32 * bj; return LD4(w + (size_t)k * 9216 + col) * g[k]; }, scr, gw, NGW, lane, poff);
        prep_matrix((bf16_t*)(ws + W_AV), 3072, 1024, [=](int n, int k) { return LD4(w + (size_t)k * 9216 + 6144 + n) * g[k]; }, scr, gw, NGW, lane, poff);
        prep_matrix((bf16_t*)(ws + W_AO), 1024, 1024, [=](int n, int k) { return LD4(wo + (size_t)k * 1024 + n); }, scr, gw, NGW, lane, poff);
    }
    {
        const float* g = norm_g + (size_t)(1 * 3 + 1) * 1024; const float* w = INF(9); const float* qag = INF(10); const float* wq = INF(11);
        const float* kvg = INF(12); const float* wkv = INF(13); const float* wo = INF(16);
        prep_matrix((bf16_t*)(ws + W_BIN), 768, 1024, [=](int n, int k) { return n < 672 ? LD4(w + (size_t)k * 672 + n) * g[k] : (f32x4){0.f, 0.f, 0.f, 0.f}; }, scr, gw, NGW, lane, poff);
        prep_matrix((bf16_t*)(ws + W_BQ), 1536, 384, [=](int n, int k) { return LD4(wq + (size_t)k * 1536 + n) * qag[k]; }, scr, gw, NGW, lane, poff);
        prep_matrix((bf16_t*)(ws + W_BK), 1024, 256, [=](int n, int k) { const int pn = n >> 8, p = n & 255, bj = p >> 7, wc = (p >> 5) & 3, dd = p & 31;
            return LD4(wkv + (size_t)k * 2048 + (pn * 4 + wc) * 128 + dd + 32 * bj) * kvg[k]; }, scr, gw, NGW, lane, poff);
        prep_matrix((bf16_t*)(ws + W_BV), 1024, 256, [=](int n, int k) { return LD4(wkv + (size_t)k * 2048 + (n >> 6) * 128 + 64 + (n & 63)) * kvg[k]; }, scr, gw, NGW, lane, poff);
        prep_matrix((bf16_t*)(ws + W_BO), 1024, 1024, [=](int n, int k) { return LD4(wo + (size_t)k * 1024 + n); }, scr, gw, NGW, lane, poff);
    }
    {
        const float* g = norm_g + (size_t)(2 * 3 + 1) * 1024; const float* w = INF(17); const float* wo = INF(18);
        prep_matrix((bf16_t*)(ws + W_CIN), 4096, 1024, [=](int n, int k) { const int pn = n >> 8, p = n & 255; int col;
            if (pn >= 8) col = 4096 + (n - 2048);
            else { const int bj = p >> 7, wc = (p >> 5) & 3, dd = p & 31, isk = pn >> 2, hd = (pn & 3) * 2 + (wc >> 1); col = isk * 1024 + hd * 128 + 32 * (wc & 1) + dd + 64 * bj; }
            return LD4(w + (size_t)k * 6144 + col) * g[k]; }, scr, gw, NGW, lane, poff);
        prep_matrix((bf16_t*)(ws + W_CV), 2048, 1024, [=](int n, int k) { return LD4(w + (size_t)k * 6144 + 2048 + n) * g[k]; }, scr, gw, NGW, lane, poff);
        prep_matrix((bf16_t*)(ws + W_CO), 1024, 2048, [=](int n, int k) { return LD4(wo + (size_t)k * 1024 + n); }, scr, gw, NGW, lane, poff);
    }
    {
        const float* g = norm_g + (size_t)(3 * 3 + 1) * 1024; const float* w = INF(19); const float* wrg = INF(22); const float* wig = INF(24); const float* wo = INF(27);
        prep_matrix((bf16_t*)(ws + W_DIN), 2048, 1024, [=](int n, int k) { return LD4(w + (size_t)k * 2048 + n) * g[k]; }, scr, gw, NGW, lane, poff);
        prep_matrix((bf16_t*)(ws + W_DG), 2048, 256, [=](int n, int k) { const int pn = n >> 8, p = n & 255, bj = p >> 7, chn = pn * 128 + (p & 127), blk = chn >> 8, d = chn & 255;
            const float* src = bj ? wig : wrg; return LD4(src + ((size_t)blk * 256 + k) * 256 + d); }, scr, gw, NGW, lane, poff);
        prep_matrix((bf16_t*)(ws + W_DO), 1024, 1024, [=](int n, int k) { return LD4(wo + (size_t)k * 1024 + n); }, scr, gw, NGW, lane, poff);
    }
    {
        const float* x_in = INF(0); bf16_t* XB = (bf16_t*)(ws + WS_XB); float* SS = (float*)(ws + WS_SS);
        for (int m = gw; m < MTOK; m += NGW) { const f32x4* xr = (const f32x4*)(x_in + (size_t)m * DM) + lane; float s = 0.f;
            unsigned long long* o8 = (unsigned long long*)(XB + (size_t)m * DM) + lane;
#pragma unroll
            for (int j = 0; j < 4; ++j) { const f32x4 v = xr[64 * j]; s += (v.x * v.x + v.y * v.y) + (v.z * v.z + v.w * v.w); o8[64 * j] = (unsigned long long)pk2(v.x, v.y) | ((unsigned long long)pk2(v.z, v.w) << 32); }
            s = wave_sum(s);
            if (lane == 0) *(f32x4*)(SS + (size_t)m * 4) = (f32x4){s, 0.f, 0.f, 0.f}; } }
    {
        const float* lamp = INF(26); float* spt = (float*)(ws + WS_SPD);
        for (int i = BX * 512 + tid; i < 1024; i += GSZ * 512) spt[i] = -8.f * log1pf(expf(-lamp[i]));
    }
    {
        const int* positions = (const int*)ldptr(1);
        float* TAc = (float*)(ws + WS_TA); float* TAs = TAc + (size_t)MTOK * 32;
        float* TBc = (float*)(ws + WS_TB); float* TBs = TBc + (size_t)MTOK * 16;
        float* TCc = (float*)(ws + WS_TC); float* TCs = TCc + (size_t)MTOK * 64;
#define FAST_SC(a_, c_, s_) do { const float rv_ = (a_) * 0.15915494309189535f; const float fr_ = rv_ - floorf(rv_); c_ = __builtin_amdgcn_cosf(fr_); s_ = __builtin_amdgcn_sinf(fr_); } while (0)
        for (int idx = BX * 512 + tid; idx < MTOK * 16; idx += GSZ * 512) { const int row = idx >> 4, i = idx & 15; const float pos = (float)positions[row]; float cv, sv;
            const float inv = exp2f(-(float)i * (13.287712379549449f / 16.f)); FAST_SC(pos * inv, cv, sv); TBc[(size_t)row * 16 + i] = cv; TBs[(size_t)row * 16 + i] = sv; } }
#undef FAST_SC
}

#ifndef DIAG
#define DIAG 0
#endif
#define TIMED(mask, ...) do { if (DIAG & (mask)) { const unsigned long long t0_ = __builtin_amdgcn_s_memrealtime(); __VA_ARGS__; const unsigned long long t1_ = __builtin_amdgcn_s_memrealtime(); \
    while (__builtin_amdgcn_s_memrealtime() - t1_ < t1_ - t0_) __builtin_amdgcn_s_sleep(8); } else { __VA_ARGS__; } } while (0)
__device__ __forceinline__ void phase_ffn(int lw, bool from_input, bool last, int par) {
    TIMED(2,
    {   unsigned char* ws = WSP();
        pg8::Prob g = pg8::make_prob(ws + WS_XB, 1024, ws + W_FUP + (size_t)lw * SZ_FUP, 1024, 1024); pg8::StaticOrder SO; SO.init(MTOK / 256, 22, GSZ, BX);
        EpiSwiGLU E{(bf16_t*)(ws + WS_R), RSBUF(ws, par)};
        pg8::gemm_phase<EpiSwiGLU, true, true>(LDS_BASE(), g, SO, E); }
    GRID_BAR(););
    TIMED(32,
    {   unsigned char* ws = WSP(); float* X = XOUT();
        pg8::Prob g = pg8::make_prob(ws + WS_R, DFF, ws + W_FDN + (size_t)lw * SZ_FDN, DFF, DFF); pg8::StaticOrder SO; SO.init(MTOK / 256, 4, GSZ, BX);
        EpiRes E{from_input ? INF(0) : (const float*)nullptr, last ? X : (float*)nullptr, (bf16_t*)(ws + WS_XB), RSBUF(ws, par), 0.5f};
        pg8::gemm_phase<EpiRes, true, true>(LDS_BASE(), g, SO, E); }
    GRID_BAR(););
}
__device__ __forceinline__ void phase_outproj(size_t a_off, int Kdim, size_t w_off, int par) {
    {   unsigned char* ws = WSP();
        pg8::Prob g = pg8::make_prob(ws + a_off, Kdim, ws + w_off, Kdim, Kdim); pg8::StaticOrder SO; SO.init(MTOK / 256, 4, GSZ, BX);
        EpiRes E{(const float*)nullptr, (float*)nullptr, (bf16_t*)(ws + WS_XB), RSBUF(ws, par), 1.0f};
        pg8::gemm_phase<EpiRes, true, true>(LDS_BASE(), g, SO, E); }
    GRID_BAR();
}

#ifndef TS
#define TS 0
#endif
#define SUBOK(n) (TS == 0 || TS == (n))
__device__ __forceinline__ void phase_mixA(int par) {
    for (int half = 0; half < 2; ++half) {
        const int rowbase = half * 16384;
        if (SUBOK(1)) {   unsigned char* ws = WSP();
            pg8::Prob g = pg8::make_prob(ws + WS_XB + (size_t)rowbase * 2048, 1024, ws + W_AQK, 1024, 1024); pg8::StaticOrder SO; SO.init(64, 24, GSZ, BX);
            EpiAQK E{(bf16_t*)(ws + RA_Q), (bf16_t*)(ws + RA_K), RSBUF(ws, par), INF(6), INF(7), (const int*)ldptr(1), rowbase};
            pg8::gemm_phase<EpiAQK, true, true>(LDS_BASE(), g, SO, E); }
        if (SUBOK(2)) for (int gI = 0; gI < 3; ++gI) {
            unsigned char* ws = WSP();
            const int dsh = 2 * gI, dil = 1 << dsh;
            pg8::Prob g = pg8::make_prob(ws + W_AV + (size_t)gI * 1024 * 1024 * 2, 1024, ws + WS_XB + (size_t)rowbase * 2048, dil * 1024, 1024);
            g.mode = 1; g.dsh = dsh; g.hsB = (dsh == 4) ? (long)1024 * 2 : (long)128 * dil * 1024 * 2;
            pg8::StaticOrder SO; SO.init(4, 64, GSZ, BX);
            EpiVT E{(bf16_t*)(ws + RA_V) + (size_t)gI * 1024 * 16384, (size_t)16384, RSBUF(ws, par), 4, 0, 4, 1024.f, 1, dsh, rowbase, 1};
            pg8::gemm_phase<EpiVT, true, true>(LDS_BASE(), g, SO, E);
        }
        GRID_BAR();
        if (SUBOK(3)) {   unsigned char* ws = WSP(); const float* gq = INF(6); const float* gk = INF(7); const int lane = opaque_tid() & 63;
            const float shift = 11.541560327111707f * wave_max(fabsf(gq[lane])) * wave_max(fabsf(gk[lane]));
            mixA_attn(LDS_BASE(), (const bf16_t*)(ws + RA_Q), (const bf16_t*)(ws + RA_K), (const bf16_t*)(ws + RA_V), (bf16_t*)(ws + RA_O), half, shift); }
        GRID_BAR();
    }
    phase_outproj(RA_O, 1024, W_AO, par);
}

__device__ __forceinline__ void phase_mixB(int par) {
    if (SUBOK(1)) {   unsigned char* ws = WSP();
        pg8::Prob g = pg8::make_prob(ws + WS_XB, 1024, ws + W_BIN, 1024, 1024); pg8::StaticOrder SO; SO.init(MTOK / 256, 3, GSZ, BX);
        EpiBIn E{(bf16_t*)(ws + RB_CQ), (bf16_t*)(ws + RB_CKV), (float*)(ws + RB_KR), (float*)(ws + RB_SS), RSBUF(ws, par)};
        pg8::gemm_phase<EpiBIn, true, true>(LDS_BASE(), g, SO, E); }
    GRID_BAR();
    if (SUBOK(2)) {   unsigned char* ws = WSP();
        pg8::Prob g = pg8::make_prob(ws + RB_CQ, 384, ws + W_BQ, 384, 384); pg8::StaticOrder SO; SO.init(MTOK / 256, 6, GSZ, BX);
        EpiRowScale E{(bf16_t*)(ws + RB_QR), 1536, (bf16_t*)(ws + RB_QR), 1536, 1 << 30, (const float*)(ws + RB_SS), 32, 0, 12, 384.f, 0};
        pg8::gemm_phase<EpiRowScale, true, true>(LDS_BASE(), g, SO, E); }
    if (SUBOK(3)) {   unsigned char* ws = WSP();
        pg8::Prob g = pg8::make_prob(ws + RB_CKV, 256, ws + W_BK, 256, 256); pg8::StaticOrder SO; SO.init(MTOK / 256, 4, GSZ, BX);
        EpiBK E{(bf16_t*)(ws + RB_KB), (const float*)(ws + RB_SS), (const float*)(ws + RB_KR), INF(15), (const float*)(ws + WS_TB), (const float*)(ws + WS_TB) + (size_t)MTOK * 16};
        pg8::gemm_phase<EpiBK, true, true>(LDS_BASE(), g, SO, E); }
    if (SUBOK(4)) {   unsigned char* ws = WSP();
        pg8::Prob g = pg8::make_prob(ws + W_BV, 256, ws + RB_CKV, 256, 256); pg8::StaticOrder SO; SO.init(4, MTOK / 256, GSZ, BX);
        EpiVT E{(bf16_t*)(ws + RB_VT), (size_t)MTOK, (const float*)(ws + RB_SS), 32, 12, 8, 256.f, 0, 0, 0, 0};
        pg8::gemm_phase<EpiVT, true, true>(LDS_BASE(), g, SO, E); }
    GRID_BAR();
    if (SUBOK(5)) {   unsigned char* ws = WSP(); const float* gq = INF(14); const float* gk = INF(15); const int lane = opaque_tid() & 63;
        const float mq = wave_max(fmaxf(fabsf(gq[lane]), fabsf(gq[64 + (lane & 31)]))), mk = wave_max(fmaxf(fabsf(gk[lane]), fabsf(gk[64 + (lane & 31)])));
        const float shift = 14.134834215227234f * mq * mk;
        mixB_attn(LDS_BASE(), (const bf16_t*)(ws + RB_QR), (const bf16_t*)(ws + RB_KB), (const bf16_t*)(ws + RB_VT), (bf16_t*)(ws + RB_O), gq, (const float*)(ws + WS_TB), (const float*)(ws + WS_TB) + (size_t)MTOK * 16, shift); }
    GRID_BAR();
    phase_outproj(RB_O, 1024, W_BO, par);
}

__device__ __forceinline__ void phase_mixC(int par) {
    if (SUBOK(1)) {   unsigned char* ws = WSP();
        pg8::Prob g = pg8::make_prob(ws + WS_XB, 1024, ws + W_CIN, 1024, 1024); pg8::StaticOrder SO; SO.init(MTOK / 256, 16, GSZ, BX);
        EpiCIn E{(bf16_t*)(ws + RC_Q), (bf16_t*)(ws + RC_K), (bf16_t*)(ws + RC_G), RSBUF(ws, par), (const int*)ldptr(1)};
        pg8::gemm_phase<EpiCIn, true, true>(LDS_BASE(), g, SO, E); }
    if (SUBOK(2)) {   unsigned char* ws = WSP();
        pg8::Prob g = pg8::make_prob(ws + W_CV, 1024, ws + WS_XB, 1024, 1024); pg8::StaticOrder SO; SO.init(8, MTOK / 256, GSZ, BX);
        EpiVT E{(bf16_t*)(ws + RC_VT), (size_t)MTOK, RSBUF(ws, par), 4, 0, 4, 1024.f, 0, 0, 0, 1};
        pg8::gemm_phase<EpiVT, true, true>(LDS_BASE(), g, SO, E); }
    GRID_BAR();
    if (SUBOK(3)) {   unsigned char* ws = WSP();
        mixC_retention(LDS_BASE(), (const bf16_t*)(ws + RC_Q), (const bf16_t*)(ws + RC_K), (const bf16_t*)(ws + RC_VT), (bf16_t*)(ws + RC_G)); }
    GRID_BAR();
    phase_outproj(RC_G, 2048, W_CO, par);
}

__device__ __forceinline__ void phase_mixD(int par) {
    {   unsigned char* ws = WSP();
        pg8::Prob g = pg8::make_prob(ws + WS_XB, 1024, ws + W_DIN, 1024, 1024); pg8::StaticOrder SO; SO.init(MTOK / 256, 8, GSZ, BX);
        EpiRowScale E{(bf16_t*)(ws + RD_GG), 1024, (bf16_t*)(ws + RD_U), 1024, 1024, RSBUF(ws, par), 4, 0, 4, 1024.f, 1};
        pg8::gemm_phase<EpiRowScale, true, true>(LDS_BASE(), g, SO, E); }
    GRID_BAR();
    {   unsigned char* ws = WSP(); mixD_conv((const bf16_t*)(ws + RD_U), (bf16_t*)(ws + RD_UC), INF(20), INF(21)); }
    GRID_BAR();
    {   unsigned char* ws = WSP();
        pg8::Prob g = pg8::make_prob(ws + RD_UC, 1024, ws + W_DG, 256, 256); g.mode = 2; pg8::StaticOrder SO; SO.init(MTOK / 256, 8, GSZ, BX);
        EpiDGate E{(bf16_t*)(ws + RD_LA), (bf16_t*)(ws + RD_GU), (const bf16_t*)(ws + RD_UC), INF(23), INF(25), (const float*)(ws + WS_SPD)};
        pg8::gemm_phase<EpiDGate, true, true>(LDS_BASE(), g, SO, E); }
    GRID_BAR();
    {   unsigned char* ws = WSP(); mixD_scan(LDS_BASE(), (const bf16_t*)(ws + RD_LA), (const bf16_t*)(ws + RD_GU), (bf16_t*)(ws + RD_GG)); }
    GRID_BAR();
    phase_outproj(RD_GG, 1024, W_DO, par);
}

__global__ void __launch_bounds__(NWAVES * 64, 2) fwd_kernel(Args args) {
    {
        LAS unsigned char* lds = LDS_BASE();
        const int tid = threadIdx.x;
        for (int u = tid; u < (LDS_BYTES - MISC_OFF) / 4; u += NWAVES * 64) ((LAS unsigned*)(lds + MISC_OFF))[u] = 0u;
        __syncthreads();
        const unsigned long long* ka = (const unsigned long long*)__builtin_amdgcn_kernarg_segment_ptr();
        if (tid < 30) ((LAS unsigned long long*)(lds + PT_OFF))[tid] = ka[tid];
        __syncthreads();
        (void)xcd_barrier_post((unsigned*)(WSP() + WS_CTL) + 1024, (volatile LAS unsigned*)(lds + MISC_OFF) + 8);
    }
#ifndef TP
#define TP 0
#endif
    if (TP == 0 || TP == 1) { TIMED(1, phase_prologue(); GRID_BAR();); }
    if (TP == 0 || TP == 2) phase_ffn(0, true, false, 0);
    if (TP == 0 || TP == 3) { TIMED(4, phase_mixA(1);); }
    if (TP == 0) { phase_ffn(1, false, false, 0); phase_ffn(2, false, false, 1); }
    if (TP == 0 || TP == 4) { TIMED(8, phase_mixB(0);); }
    if (TP == 0) { phase_ffn(3, false, false, 1); phase_ffn(4, false, false, 0); }
    if (TP == 0 || TP == 5) { TIMED(16, phase_mixC(1);); }
    if (TP == 0) { phase_ffn(5, false, false, 0); phase_ffn(6, false, false, 1); }
    if (TP == 0 || TP == 6) { TIMED(64, phase_mixD(0);); }
    if (TP == 0) phase_ffn(7, false, true, 1);
}

extern "C" void kernel_launch(void* const* d_in, const int* in_sizes, int n_in, void* d_out, int out_size, void* d_ws, size_t ws_size, hipStream_t stream) {
    static int grid = 0;
    if (grid == 0) {
        if (n_in != 28 || out_size != MTOK * DM || ws_size < WS_NEED) { fprintf(stderr, "kernel_launch: unexpected shapes: n_in %d out %d ws %zu (need %zu)\n", n_in, out_size, ws_size, (size_t)WS_NEED); grid = -1; return; }
        int dev = 0, cus = 0, per_cu = 0;
        if (hipGetDevice(&dev) != hipSuccess || hipDeviceGetAttribute(&cus, hipDeviceAttributeMultiprocessorCount, dev) != hipSuccess) { grid = -1; return; }
        if (hipFuncSetAttribute((const void*)fwd_kernel, hipFuncAttributeMaxDynamicSharedMemorySize, LDS_BYTES) != hipSuccess) { fprintf(stderr, "kernel_launch: hipFuncSetAttribute failed\n"); grid = -1; return; }
        if (hipOccupancyMaxActiveBlocksPerMultiprocessor(&per_cu, (const void*)fwd_kernel, NWAVES * 64, LDS_BYTES) != hipSuccess || per_cu < 1) fprintf(stderr, "kernel_launch: occupancy query says %d\n", per_cu);
        (void)hipGetLastError();
        grid = cus;
    }
    if (grid < 0) return;
    (void)hipMemsetAsync((char*)d_ws + WS_CTL, 0, CTL_ZERO_BYTES, stream);
    Args a{};
    for (int i = 0; i < 28; ++i) a.in[i] = d_in[i];
    a.out = (float*)d_out; a.ws = (unsigned char*)d_ws;
    hipLaunchKernelGGL(fwd_kernel, dim3(grid), dim3(NWAVES * 64), LDS_BYTES, stream, a);
    const hipError_t le = hipPeekAtLastError();
    if (le != hipSuccess) fprintf(stderr, "kernel_launch: launch failed: %s\n", hipGetErrorName(le));
}
```
